# Optimizing an MI355X kernel written in HIP

```python
import math
import jax, jax.numpy as jnp
from jax import lax
import numpy as np

D_MODEL = 1024
BATCH = 2
SEQ = 8192
DEPTH = 1

MIX_WIDTH = D_MODEL
MLA_WIDTH = MIX_WIDTH // 2
HYENA_WIDTH = MIX_WIDTH - MLA_WIDTH
MLA_HEADS = 8
MLA_V_DIM = MLA_WIDTH // MLA_HEADS
MLA_NOPE_DIM = 64
MLA_ROPE_DIM = 32
Q_LORA_RANK = D_MODEL // 4
KV_LORA_RANK = D_MODEL // 8
ROPE_THETA = 10000.0
Q_BLOCK = 128
HYENA_ORDER = 2
SHORT_CONV = 3
FILTER_EMB = 33
FILTER_ORDER = 64
DECAY_TARGET = 1e-2
FAST_DECAY_PCT = 0.3
SLOW_DECAY_PCT = 1.5
Q_A_COLS = Q_LORA_RANK
KV_A_COLS = KV_LORA_RANK + MLA_ROPE_DIM
HY_COLS = (HYENA_ORDER + 1) * HYENA_WIDTH
IN_COLS = Q_A_COLS + KV_A_COLS + HY_COLS
N_EXPERTS = 16
EC_FACTOR = 2
EXPERT_FF = D_MODEL
DN_ALPHA = (2.0 * DEPTH) ** 0.25
DN_BETA = (8.0 * DEPTH) ** -0.25
EPS = 1e-5

kernel_name = "hybrid_mla_hyena_ecmoe_deepnorm_adaln"


def layer_norm(x, g, b):
    xf = x.astype(jnp.float32)
    mu = jnp.mean(xf, axis=-1, keepdims=True)
    var = jnp.mean(jnp.square(xf - mu), axis=-1, keepdims=True)
    return ((xf - mu) * lax.rsqrt(var + EPS) * g + b).astype(x.dtype)


def rms_norm(x, g):
    xf = x.astype(jnp.float32)
    return (xf * lax.rsqrt(jnp.mean(xf * xf, axis=-1, keepdims=True) + EPS) * g).astype(x.dtype)


def apply_rope(x, cos, sin):
    half = MLA_ROPE_DIM // 2
    x1, x2 = x[..., :half], x[..., half:]
    return jnp.concatenate([x1 * cos - x2 * sin, x2 * cos + x1 * sin], axis=-1).astype(x.dtype)


def mla_group(cq_raw, ckv_raw, positions, q_norm_g, w_qb, kv_norm_g, w_kvb):
    B, S, _ = cq_raw.shape
    H = MLA_HEADS
    q = (rms_norm(cq_raw, q_norm_g) @ w_qb).reshape(B, S, H, MLA_NOPE_DIM + MLA_ROPE_DIM)
    q_nope, q_rope = q[..., :MLA_NOPE_DIM], q[..., MLA_NOPE_DIM:]
    c_kv, k_rope = ckv_raw[..., :KV_LORA_RANK], ckv_raw[..., KV_LORA_RANK:]
    kv = (rms_norm(c_kv, kv_norm_g) @ w_kvb).reshape(B, S, H, MLA_NOPE_DIM + MLA_V_DIM)
    k_nope, v = kv[..., :MLA_NOPE_DIM], kv[..., MLA_NOPE_DIM:]
    half = MLA_ROPE_DIM // 2
    inv_freq = ROPE_THETA ** (-jnp.arange(half, dtype=jnp.float32) / half)
    ang = positions.astype(jnp.float32)[..., None] * inv_freq
    cos, sin = jnp.cos(ang), jnp.sin(ang)
    q_rope = apply_rope(q_rope, cos[:, :, None, :], sin[:, :, None, :])
    k_rope = apply_rope(k_rope, cos, sin)
    scale = (MLA_NOPE_DIM + MLA_ROPE_DIM) ** -0.5
    nb = S // Q_BLOCK
    qn_b = q_nope.reshape(B, nb, Q_BLOCK, H, MLA_NOPE_DIM).transpose(1, 0, 2, 3, 4)
    qr_b = q_rope.reshape(B, nb, Q_BLOCK, H, MLA_ROPE_DIM).transpose(1, 0, 2, 3, 4)

    def attend(blk):
        qn, qr = blk
        s = jnp.einsum('bqhd,bkhd->bhqk', qn, k_nope) + jnp.einsum('bqhr,bkr->bhqk', qr, k_rope)
        p = jax.nn.softmax(s.astype(jnp.float32) * scale, axis=-1).astype(v.dtype)
        return jnp.einsum('bhqk,bkhd->bqhd', p, v)

    o = lax.map(attend, (qn_b, qr_b))
    return o.transpose(1, 0, 2, 3, 4).reshape(B, S, H * MLA_V_DIM)


def hyena_filter_spectrum(L, w1, b1, freq, w2, b2, w3, b3, decay):
    f32 = jnp.float32
    pos = jnp.arange(L, dtype=f32)
    t = pos[:, None] / (L - 1)
    bands = (FILTER_EMB - 1) // 2
    freqs = jnp.linspace(1e-4, bands - 1, bands, dtype=f32)
    phase = (2.0 * math.pi / L) * pos[:, None] * freqs[None, :]
    feats = jnp.concatenate([t, jnp.cos(phase), -jnp.sin(phase)], axis=-1)
    fr = freq.astype(f32)
    h = jnp.sin(fr * (feats @ w1.astype(f32) + b1.astype(f32)))
    h = jnp.sin(fr * (h @ w2.astype(f32) + b2.astype(f32)))
    h = (h @ w3.astype(f32) + b3.astype(f32)).reshape(L, 2, HYENA_ORDER, HYENA_WIDTH)
    h = h * jnp.exp(-t[:, :, None, None] * jnp.abs(decay.astype(f32)))
    h_fwd, h_bwd = h[:, 0], h[:, 1]
    two_sided = jnp.concatenate([h_fwd, jnp.zeros_like(h_fwd[:1]), h_bwd[:0:-1]], axis=0)
    return jnp.fft.rfft(two_sided, axis=0)


def hyena_group(hy_raw, conv_w, conv_b, filt_f, hyena_bias):
    B, S, _ = hy_raw.shape
    pad = SHORT_CONV // 2
    xp = jnp.pad(hy_raw, ((0, 0), (pad, pad), (0, 0)))
    u = conv_b + sum(xp[:, j:j + S] * conv_w[j] for j in range(SHORT_CONV))
    parts = jnp.split(u, HYENA_ORDER + 1, axis=-1)
    z = parts[0]
    for o in range(HYENA_ORDER):
        zf = z.astype(jnp.float32)
        y = jnp.fft.irfft(jnp.fft.rfft(zf, n=2 * S, axis=1) * filt_f[:, o], n=2 * S, axis=1)[:, :S]
        z = (parts[o + 1].astype(jnp.float32) * (y + zf * hyena_bias[o])).astype(hy_raw.dtype)
    return z


def expert_choice_moe(u, w_router, w_gate, w_up, w_down):
    B, S, D = u.shape
    cap = EC_FACTOR * S // N_EXPERTS
    aff = jax.nn.softmax((u @ w_router).astype(jnp.float32), axis=-1)
    g, idx = lax.top_k(aff.transpose(0, 2, 1), cap)
    xe = jax.vmap(lambda ub, ib: ub[ib])(u, idx)
    h = jax.nn.silu(jnp.einsum('becd,edf->becf', xe, w_gate)) * jnp.einsum('becd,edf->becf', xe, w_up)
    ye = jnp.einsum('becf,efd->becd', h, w_down) * g[..., None].astype(u.dtype)
    flat_idx = (idx + (jnp.arange(B, dtype=idx.dtype) * S)[:, None, None]).reshape(-1)
    out = jnp.zeros((B * S, D), u.dtype).at[flat_idx].add(ye.reshape(-1, D))
    return out.reshape(B, S, D)


def setup_inputs(seed: int = 0) -> dict:
    key = jax.random.key(seed)
    ks = iter(jax.random.split(key, 40))
    f32 = jnp.float32
    L_ = DEPTH

    def nrm(shape, std):
        return jax.random.normal(next(ks), shape, f32) * std

    def gain(shape):
        return 1.0 + nrm(shape, 0.02)

    x = jax.random.normal(next(ks), (BATCH, SEQ, D_MODEL), f32)
    c = jax.random.normal(next(ks), (BATCH, D_MODEL), f32)
    offs = jax.random.randint(next(ks), (BATCH, 1), 0, 4096, dtype=jnp.int32)
    positions = offs + jnp.arange(SEQ, dtype=jnp.int32)[None, :]
    min_decay = abs(math.log(DECAY_TARGET) / SLOW_DECAY_PCT)
    max_decay = abs(math.log(DECAY_TARGET) / FAST_DECAY_PCT)
    base_decay = jnp.linspace(min_decay, max_decay, HYENA_WIDTH, dtype=f32)
    hyena_decay = base_decay * jnp.exp(nrm((L_, 2, HYENA_ORDER, HYENA_WIDTH), 0.1))
    return {
        "x": x,
        "c": c,
        "positions": positions,
        "w_ada": nrm((L_, D_MODEL, 6 * D_MODEL), 0.5 * D_MODEL ** -0.5),
        "b_ada": nrm((L_, 6 * D_MODEL), 0.01),
        "w_in": nrm((L_, D_MODEL, IN_COLS), D_MODEL ** -0.5),
        "q_norm_g": gain((L_, Q_LORA_RANK)),
        "w_qb": nrm((L_, Q_LORA_RANK, MLA_HEADS * (MLA_NOPE_DIM + MLA_ROPE_DIM)), Q_LORA_RANK ** -0.5),
        "kv_norm_g": gain((L_, KV_LORA_RANK)),
        "w_kvb": nrm((L_, KV_LORA_RANK, MLA_HEADS * (MLA_NOPE_DIM + MLA_V_DIM)), KV_LORA_RANK ** -0.5),
        "conv_w": nrm((L_, SHORT_CONV, HY_COLS), SHORT_CONV ** -0.5),
        "conv_b": nrm((L_, HY_COLS), 0.01),
        "filt_w1": nrm((L_, FILTER_EMB, FILTER_ORDER), FILTER_EMB ** -0.5),
        "filt_b1": nrm((L_, FILTER_ORDER), 0.02),
        "filt_freq": gain((L_, FILTER_ORDER)),
        "filt_w2": nrm((L_, FILTER_ORDER, FILTER_ORDER), FILTER_ORDER ** -0.5),
        "filt_b2": nrm((L_, FILTER_ORDER), 0.02),
        "filt_w3": nrm((L_, FILTER_ORDER, 2 * HYENA_ORDER * HYENA_WIDTH), 0.1 * FILTER_ORDER ** -0.5),
        "filt_b3": nrm((L_, 2 * HYENA_ORDER * HYENA_WIDTH), 0.01),
        "hyena_decay": hyena_decay,
        "hyena_bias": nrm((L_, HYENA_ORDER, HYENA_WIDTH), 1.0),
        "attn_out_g": gain((L_, MLA_WIDTH)),
        "hyena_out_g": gain((L_, HYENA_WIDTH)),
        "w_o": nrm((L_, MIX_WIDTH, D_MODEL), DN_BETA * MIX_WIDTH ** -0.5),
        "ln1_g": gain((L_, D_MODEL)),
        "ln1_b": nrm((L_, D_MODEL), 0.01),
        "w_router": nrm((L_, D_MODEL, N_EXPERTS), D_MODEL ** -0.5),
        "w_gate": nrm((L_, N_EXPERTS, D_MODEL, EXPERT_FF), D_MODEL ** -0.5),
        "w_up": nrm((L_, N_EXPERTS, D_MODEL, EXPERT_FF), D_MODEL ** -0.5),
        "w_down": nrm((L_, N_EXPERTS, EXPERT_FF, D_MODEL), DN_BETA * EXPERT_FF ** -0.5),
        "ln2_g": gain((L_, D_MODEL)),
        "ln2_b": nrm((L_, D_MODEL), 0.01),
    }


def reference(x, c, positions, w_ada, b_ada, w_in, q_norm_g, w_qb, kv_norm_g, w_kvb,
              conv_w, conv_b, filt_w1, filt_b1, filt_freq, filt_w2, filt_b2, filt_w3, filt_b3,
              hyena_decay, hyena_bias, attn_out_g, hyena_out_g, w_o, ln1_g, ln1_b,
              w_router, w_gate, w_up, w_down, ln2_g, ln2_b):
    S = x.shape[1]
    for l in range(DEPTH):
        mod = jax.nn.silu(c) @ w_ada[l] + b_ada[l]
        sh1, sc1, g1, sh2, sc2, g2 = jnp.split(mod[:, None, :], 6, axis=-1)
        u = x * (1.0 + sc1) + sh1
        proj = u @ w_in[l]
        cq_raw = proj[..., :Q_A_COLS]
        ckv_raw = proj[..., Q_A_COLS:Q_A_COLS + KV_A_COLS]
        hy_raw = proj[..., Q_A_COLS + KV_A_COLS:]
        a = mla_group(cq_raw, ckv_raw, positions, q_norm_g[l], w_qb[l], kv_norm_g[l], w_kvb[l])
        filt_f = hyena_filter_spectrum(S, filt_w1[l], filt_b1[l], filt_freq[l], filt_w2[l], filt_b2[l],
                                       filt_w3[l], filt_b3[l], hyena_decay[l])
        hy = hyena_group(hy_raw, conv_w[l], conv_b[l], filt_f, hyena_bias[l])
        mixed = jnp.concatenate([rms_norm(a, attn_out_g[l]), rms_norm(hy, hyena_out_g[l])], axis=-1) @ w_o[l]
        x = layer_norm(DN_ALPHA * x + g1 * mixed, ln1_g[l], ln1_b[l])
        u = x * (1.0 + sc2) + sh2
        ffn = expert_choice_moe(u, w_router[l], w_gate[l], w_up[l], w_down[l])
        x = layer_norm(DN_ALPHA * x + g2 * ffn, ln2_g[l], ln2_b[l])
    return x
```

```cpp
#include <hip/hip_runtime.h>
#include <hip/hip_cooperative_groups.h>
#include <hip/hip_bf16.h>
#include <cstdio>
#include <cstdint>
#include <cmath>
namespace cg = cooperative_groups;

constexpr int BATCH = 2, SEQ = 8192, DM = 1024, T = BATCH * SEQ;
constexpr int NH = 8, QKD = 96, VD = 64, NOPE = 64, ROPE = 32;
constexpr int QLR = 256, KVLR = 128;
constexpr int HW = 512;
constexpr int IN_COLS = 1952, IN_PAD = 2048;
constexpr int NEXP = 16, CAP = 1024, EFF = 1024;
constexpr int FEMB = 33, FORD = 64;
constexpr float EPS = 1e-5f;
constexpr float DN_ALPHA = 1.189207115002721f;
constexpr int NFFT = 2 * SEQ;

namespace pg8 {
#define PG8_LAS __attribute__((address_space(3)))
typedef unsigned short bf16_t;
typedef short bf16x8 __attribute__((ext_vector_type(8)));
typedef float f32x4 __attribute__((ext_vector_type(4)));
typedef unsigned u32x4 __attribute__((ext_vector_type(4)));
constexpr int BM = 256, BK = 64, HALF = 128, HTB = HALF * BK * 2  , STAGE_BYTES = 8 * HTB, NXCD = 8, WGM = 8;

__host__ __device__ __forceinline__ int lds_byte(int r, int c) { const int st = (r >> 4) * 2 + (c >> 5), rr = r & 15, cc = c & 31, ob = rr * 64 + cc * 2; return st * 1024 + (ob ^ (((ob >> 9) & 1) << 5)); }
__host__ __device__ __forceinline__ void stage_rc(int b, int& R, int& C) { const int st = b / 1024, sb = b % 1024, swz = sb ^ (((sb >> 9) & 1) << 5); R = (st >> 1) * 16 + swz / 64; C = (st & 1) * 32 + (swz % 64) / 2; }
__host__ __device__ __forceinline__ int perm32(int rho) { const int n = rho >> 4, i = rho & 15; return 8 * (i >> 2) + 4 * n + (i & 3); }

struct Unit { int pm, pn; };
struct Gemm { const bf16_t* A; const bf16_t* Bt; int M, N, K; int lda, ldb; int pm_per_grp, grp_mod; size_t b_grp_bytes; };

struct StaticOrder {
    int nM, nN, nwg, G, c;
    __host__ __device__ void init(int M, int N, int G_, int c_) { nM = M / BM; nN = N / BM; nwg = nM * nN; G = G_; c = c_; }
    __host__ __device__ bool next(int i, Unit& u) const {
        const long L = (long)i * G + c; if (L >= nwg) return false;
        int wgid = (int)L; { const int q = nwg / NXCD, r = nwg % NXCD, xcd = wgid % NXCD, off = wgid / NXCD; wgid = (xcd < r ? xcd * (q + 1) : r * (q + 1) + (xcd - r) * q) + off; }
        const int nig = WGM * nN, gid = wgid / nig, fm = gid * WGM, gsz = (nM - fm) < WGM ? (nM - fm) : WGM;
        u.pm = fm + ((wgid % nig) % gsz); u.pn = (wgid % nig) / gsz; return true;
    }
    __device__ __forceinline__ void a_ready(const Unit&) const {}
    __device__ __forceinline__ void done(const Unit&) const {}
};

__device__ __forceinline__ unsigned cvt_pk_bf16(float lo, float hi) { unsigned r; asm volatile("v_cvt_pk_bf16_f32 %0, %1, %2" : "=v"(r) : "v"(lo), "v"(hi)); return r; }
typedef float f32x2 __attribute__((ext_vector_type(2)));
__device__ __forceinline__ f32x2 gelu_pk(f32x2 v) {
    const f32x2 av = __builtin_elementwise_abs(v), d = av * 0.2316418882f + 1.0f;
    f32x2 t; t.x = __builtin_amdgcn_rcpf(d.x); t.y = __builtin_amdgcn_rcpf(d.y);
    f32x2 q = t * 0.5307027145f + (-0.7265760135f); q = q * t + 0.7107068705f; q = q * t + (-0.142248368f); q = q * t + 0.127414796f; q = q * t;
    const f32x2 s = (v * v) * (-0.72134752044f);
    f32x2 e; e.x = __builtin_amdgcn_exp2f(s.x); e.y = __builtin_amdgcn_exp2f(s.y);
    const f32x2 m = v * (q * e), r = v - m;
    f32x2 o; o.x = v.x < 0.f ? m.x : r.x; o.y = v.y < 0.f ? m.y : r.y; return o;
}

template <int ACT  > struct EpiBf16 {
    static constexpr bool PERM = true, AFTER_DRAIN = false; static_assert(ACT == 0 || ACT == 1, "EpiBf16: ACT is 0 (none) or 1 (gelu_pk)");
    bf16_t* O; int ldc; const float* bias; int split_cols; size_t split_stride; float scale0;
    __device__ __forceinline__ void operator()(const f32x4 (&acc)[2][2][4][2], const Unit& u, int wr, int wc, int fr, int fq) const {
        const int row0 = u.pm * BM + wr * 64 + fr; int colt = u.pn * BM; bf16_t* base = O;
        float sc = 1.f; if (split_cols) { const int t = colt / split_cols; base += (size_t)t * split_stride; colt -= t * split_cols; if (t == 0) sc = scale0; }
        const int col0 = colt + wc * 32 + 8 * fq, bcol0 = u.pn * BM + wc * 32 + 8 * fq;
        f32x4 bv[2][2];
#pragma unroll
        for (int bj = 0; bj < 2; ++bj)
#pragma unroll
            for (int n = 0; n < 2; ++n) bv[bj][n] = bias ? *(const f32x4*)(bias + bcol0 + bj * HALF + 4 * n) : (f32x4){0.f, 0.f, 0.f, 0.f};
#pragma unroll
        for (int ai = 0; ai < 2; ++ai)
#pragma unroll
            for (int m = 0; m < 4; ++m) { bf16_t* rowp = base + (size_t)(row0 + ai * HALF + m * 16) * ldc + col0;
#pragma unroll
                for (int bj = 0; bj < 2; ++bj) { f32x4 v0 = acc[ai][bj][m][0] + bv[bj][0], v1 = acc[ai][bj][m][1] + bv[bj][1];
                    if (ACT == 1) { f32x2 a = gelu_pk((f32x2){v0[0], v0[1]}), b = gelu_pk((f32x2){v0[2], v0[3]}), c = gelu_pk((f32x2){v1[0], v1[1]}), d = gelu_pk((f32x2){v1[2], v1[3]});
                        v0 = (f32x4){a.x, a.y, b.x, b.y}; v1 = (f32x4){c.x, c.y, d.x, d.y}; }
                    v0 = v0 * sc; v1 = v1 * sc; u32x4 w; w.x = cvt_pk_bf16(v0[0], v0[1]); w.y = cvt_pk_bf16(v0[2], v0[3]); w.z = cvt_pk_bf16(v1[0], v1[1]); w.w = cvt_pk_bf16(v1[2], v1[3]);
                    *(u32x4*)(rowp + bj * HALF) = w; } }
    }
};

struct PanelStats {
    unsigned* xbuf;
    unsigned* cnt;
    unsigned* tmo;
    int ntn; float eps;
    unsigned code;
    __device__ __forceinline__ bool run(const f32x4 (&v)[2][2][4][2], const Unit& u, int wr, int wc, int fr, int fq, PG8_LAS unsigned char* lds, int wid, int lane) const {
        typedef float f32x2v __attribute__((ext_vector_type(2)));
        PG8_LAS f32x2v* P = (PG8_LAS f32x2v*)lds;
        PG8_LAS f32x2v* S = (PG8_LAS f32x2v*)(lds + 8192);
        PG8_LAS unsigned* flag = (PG8_LAS unsigned*)(lds + 8192 + 2048);
#pragma unroll
        for (int ai = 0; ai < 2; ++ai)
#pragma unroll
            for (int m = 0; m < 4; ++m) {
                float s = 0.f;
#pragma unroll
                for (int bj = 0; bj < 2; ++bj)
#pragma unroll
                    for (int n = 0; n < 2; ++n) { const f32x4 x = v[ai][bj][m][n]; s += (x[0] + x[1]) + (x[2] + x[3]); }
                s += __shfl_xor(s, 16); s += __shfl_xor(s, 32);
                const float mw = s * (1.0f / 64.0f); float q = 0.f;
#pragma unroll
                for (int bj = 0; bj < 2; ++bj)
#pragma unroll
                    for (int n = 0; n < 2; ++n) { const f32x4 d = v[ai][bj][m][n] - mw; q += (d[0] * d[0] + d[1] * d[1]) + (d[2] * d[2] + d[3] * d[3]); }
                q += __shfl_xor(q, 16); q += __shfl_xor(q, 32);
                if (fq == 0) P[(ai * HALF + wr * 64 + m * 16 + fr) * 4 + wc] = (f32x2v){mw, q};
            }
        asm volatile("s_waitcnt lgkmcnt(0)" ::: "memory"); __builtin_amdgcn_s_barrier(); asm volatile("" ::: "memory");
#if defined(BROKEN_EXCHANGE_NO_WAIT)
#warning BROKEN CONTROL BUILD: the row-statistics exchange does not wait; results are wrong by design
        if (blockIdx.x >= 64) { const long long t0_ = clock64(); while (clock64() - t0_ < 60000) __builtin_amdgcn_s_sleep(8); }
#endif
        const int row = wid * 32 + (lane & 31);
        if (lane < 32) {
            const f32x2v a = P[row * 4 + 0], b = P[row * 4 + 1], c = P[row * 4 + 2], d = P[row * 4 + 3];
            const float mt = (a.x + b.x + c.x + d.x) * 0.25f;
            const float da = a.x - mt, db = b.x - mt, dc = c.x - mt, dd = d.x - mt;
            const float m2 = (a.y + b.y) + (c.y + d.y) + 64.0f * ((da * da + db * db) + (dc * dc + dd * dd));
            unsigned long long* slot = (unsigned long long*)xbuf + ((size_t)(u.pm * BM + row) * 4 + u.pn);
            __hip_atomic_store(slot, ((unsigned long long)__float_as_uint(m2) << 32) | __float_as_uint(mt), __ATOMIC_RELAXED, __HIP_MEMORY_SCOPE_AGENT);
        }
        asm volatile("s_waitcnt vmcnt(0)" ::: "memory");
        if (lane == 0) __hip_atomic_fetch_add(cnt + 64 * u.pm, 1u, __ATOMIC_RELAXED, __HIP_MEMORY_SCOPE_AGENT);
        if (wid == 0) {
            bool dead = false; const unsigned long long t0 = __builtin_amdgcn_s_memrealtime(); const unsigned want = 8u * (unsigned)ntn;
            for (;;) {
#if defined(BROKEN_EXCHANGE_NO_WAIT)
                break;
#endif
                if ((unsigned)__builtin_amdgcn_readfirstlane(__hip_atomic_load(cnt + 64 * u.pm, __ATOMIC_RELAXED, __HIP_MEMORY_SCOPE_AGENT)) >= want) break;
                if (__builtin_amdgcn_s_memrealtime() - t0 > 2000000ull) {
                    if (lane == 0) { unsigned expect = 0u; __hip_atomic_compare_exchange_strong(tmo + 1, &expect, code | (unsigned)(u.pm & 0xff), __ATOMIC_RELAXED, __ATOMIC_RELAXED, __HIP_MEMORY_SCOPE_AGENT);
                                     __hip_atomic_store(tmo, 1u, __ATOMIC_RELAXED, __HIP_MEMORY_SCOPE_AGENT); }
                    dead = true; break; }
                __builtin_amdgcn_s_sleep(2);
            }
            __builtin_amdgcn_fence(__ATOMIC_ACQUIRE, "agent");
            if (lane == 0) flag[0] = dead ? 1u : 0u;
        }
        asm volatile("s_waitcnt vmcnt(0) lgkmcnt(0)" ::: "memory"); __builtin_amdgcn_s_barrier(); asm volatile("" ::: "memory");
        const bool bad = flag[0] != 0u;
        if (lane < 32) {
            const unsigned long long* slot = (const unsigned long long*)xbuf + (size_t)(u.pm * BM + row) * 4; float mt[4], m2[4]; float ms = 0.f;
#pragma unroll
            for (int t = 0; t < 4; ++t) { if (t < ntn) { const unsigned long long w = __hip_atomic_load(slot + t, __ATOMIC_RELAXED, __HIP_MEMORY_SCOPE_AGENT); mt[t] = __uint_as_float((unsigned)w); m2[t] = __uint_as_float((unsigned)(w >> 32)); } else { mt[t] = 0.f; m2[t] = 0.f; } ms += mt[t]; }
            const float mean = ms / (float)ntn; float q = 0.f;
#pragma unroll
            for (int t = 0; t < 4; ++t) if (t < ntn) { const float dm = mt[t] - mean; q += m2[t] + 256.0f * dm * dm; }
            S[row] = (f32x2v){mean, 1.0f / sqrtf(q / (256.0f * (float)ntn) + eps)};
        }
        asm volatile("s_waitcnt lgkmcnt(0)" ::: "memory"); __builtin_amdgcn_s_barrier(); asm volatile("" ::: "memory");
        return bad;
    }
};
struct EpiLnRes {
    static constexpr bool PERM = false, AFTER_DRAIN = true;
    const float* base; float* out; int ldc; const float* bias; PanelStats st; unsigned poison;
    __device__ __forceinline__ void fused(f32x4 (&acc)[2][2][4][2], const Unit& u, int wr, int wc, int fr, int fq, PG8_LAS unsigned char* lds, int wid, int lane) const {
        typedef float f32x2v __attribute__((ext_vector_type(2)));
        const PG8_LAS f32x2v* S = (const PG8_LAS f32x2v*)(lds + 8192);
        const int col0 = u.pn * BM + wc * 32 + 4 * fq;
#pragma unroll
        for (int bj = 0; bj < 2; ++bj)
#pragma unroll
            for (int n = 0; n < 2; ++n) { const f32x4 bv = bias ? *(const f32x4*)(bias + col0 + bj * HALF + n * 16) : (f32x4){0.f, 0.f, 0.f, 0.f};
#pragma unroll
                for (int ai = 0; ai < 2; ++ai)
#pragma unroll
                    for (int m = 0; m < 4; ++m) acc[ai][bj][m][n] += bv; }
        f32x4 pre[4][2][2];
#pragma unroll
        for (int m = 0; m < 4; ++m) { const size_t off = (size_t)(u.pm * BM + wr * 64 + m * 16 + fr) * ldc + col0;
#pragma unroll
            for (int bj = 0; bj < 2; ++bj)
#pragma unroll
                for (int n = 0; n < 2; ++n) pre[m][bj][n] = *(const f32x4*)(base + off + bj * HALF + n * 16); }
        const bool bad = st.run(acc, u, wr, wc, fr, fq, lds, wid, lane) || poison != 0u;
        const float qnan = __builtin_nanf("");
#pragma unroll
        for (int ai = 0; ai < 2; ++ai)
#pragma unroll
            for (int m = 0; m < 4; ++m) { const int r = ai * HALF + wr * 64 + m * 16 + fr; const f32x2v sr = S[r]; const size_t off = (size_t)(u.pm * BM + r) * ldc + col0;
#pragma unroll
                for (int bj = 0; bj < 2; ++bj)
#pragma unroll
                    for (int n = 0; n < 2; ++n) { const f32x4 bs = ai == 0 ? pre[m][bj][n] : *(const f32x4*)(base + off + bj * HALF + n * 16); f32x4 o = bs + (acc[ai][bj][m][n] - sr.x) * sr.y;
                        if (bad) o = (f32x4){qnan, qnan, qnan, qnan}; *(f32x4*)(out + off + bj * HALF + n * 16) = o; }
                if (m & 1) asm volatile("" ::: "memory"); }
    }
};
struct EpiLnResLn {
    static constexpr bool PERM = false, AFTER_DRAIN = true;
    const float* base; float* out; bf16_t* xn; int ldc; const float* bias; PanelStats st1, st2; unsigned poison;
    __device__ __forceinline__ void fused(f32x4 (&acc)[2][2][4][2], const Unit& u, int wr, int wc, int fr, int fq, PG8_LAS unsigned char* lds, int wid, int lane) const {
        typedef float f32x2v __attribute__((ext_vector_type(2))); typedef unsigned u32x2v __attribute__((ext_vector_type(2)));
        const PG8_LAS f32x2v* S = (const PG8_LAS f32x2v*)(lds + 8192);
        const int col0 = u.pn * BM + wc * 32 + 4 * fq;
#pragma unroll
        for (int bj = 0; bj < 2; ++bj)
#pragma unroll
            for (int n = 0; n < 2; ++n) { const f32x4 bv = bias ? *(const f32x4*)(bias + col0 + bj * HALF + n * 16) : (f32x4){0.f, 0.f, 0.f, 0.f};
#pragma unroll
                for (int ai = 0; ai < 2; ++ai)
#pragma unroll
                    for (int m = 0; m < 4; ++m) acc[ai][bj][m][n] += bv; }
        bool bad = st1.run(acc, u, wr, wc, fr, fq, lds, wid, lane) || poison != 0u;
        const float qnan = __builtin_nanf("");
#pragma unroll
        for (int ai = 0; ai < 2; ++ai)
#pragma unroll
            for (int m = 0; m < 4; ++m) { const int r = ai * HALF + wr * 64 + m * 16 + fr; const f32x2v sr = S[r]; const size_t off = (size_t)(u.pm * BM + r) * ldc + col0;
#pragma unroll
                for (int bj = 0; bj < 2; ++bj)
#pragma unroll
                    for (int n = 0; n < 2; ++n) { const f32x4 bs = *(const f32x4*)(base + off + bj * HALF + n * 16); acc[ai][bj][m][n] = bs + (acc[ai][bj][m][n] - sr.x) * sr.y; }
                asm volatile("" : "+v"(acc[ai][0][m][0]), "+v"(acc[ai][0][m][1]), "+v"(acc[ai][1][m][0]), "+v"(acc[ai][1][m][1]));
                if (m & 1) asm volatile("" ::: "memory"); }
        const bool bad1 = bad;
        bad = st2.run(acc, u, wr, wc, fr, fq, lds, wid, lane) || bad;
#pragma unroll
        for (int ai = 0; ai < 2; ++ai)
#pragma unroll
            for (int m = 0; m < 4; ++m) { const int r = ai * HALF + wr * 64 + m * 16 + fr; const f32x2v sr = S[r]; const size_t off = (size_t)(u.pm * BM + r) * ldc + col0;
#pragma unroll
                for (int bj = 0; bj < 2; ++bj)
#pragma unroll
                    for (int n = 0; n < 2; ++n) { const f32x4 x1 = acc[ai][bj][m][n]; *(f32x4*)(out + off + bj * HALF + n * 16) = bad1 ? (f32x4){qnan, qnan, qnan, qnan} : x1;
                        const f32x4 o = (x1 - sr.x) * sr.y; u32x2v w; w.x = cvt_pk_bf16(o[0], o[1]); w.y = cvt_pk_bf16(o[2], o[3]);
                        if (bad) { w.x = 0x7fc07fc0u; w.y = 0x7fc07fc0u; } *(u32x2v*)(xn + off + bj * HALF + n * 16) = w; }
                asm volatile("" ::: "memory"); }
    }
};

template <class Epi, class Sched, bool ALIGN_EPI = false, bool SP2 = false>
__device__ __forceinline__ void gemm_phase(PG8_LAS unsigned char* lds, const Gemm g, const Sched& S, const Epi& E, const int tid) {
    const int  wid = __builtin_amdgcn_readfirstlane(tid >> 6), lane = tid & 63, wr = wid >> 2, wc = wid & 3, fr = lane & 15, fq = lane >> 4;
    const int K = g.K, nt = K / BK;
    unsigned voffA[2], voffB[2];
#pragma unroll
    for (int i = 0; i < 2; ++i) { int R, C; stage_rc(tid * 16 + i * 8192, R, C); const int Rb = Epi::PERM ? ((R & ~31) + perm32(R & 31)) : R;
        voffA[i] = (unsigned)(R * g.lda + C) * 2u; voffB[i] = (unsigned)(Rb * g.ldb + C) * 2u; }
    const size_t kstep = (size_t)(BK * 2);
    const size_t hstepA = (size_t)HALF * g.lda * 2, hstepB = (size_t)HALF * g.ldb * 2;
    const size_t tstepA = 2 * hstepA, tstepB = 2 * hstepB;
    const unsigned ldsw = (unsigned)wid * 1024u;
    const int aoff = lds_byte(wr * 64 + fr, fq * 8), boff = lds_byte(wc * 32 + fr, fq * 8);
#define PG8_SA(b, h) (((b) * 2 + (h)) * HTB)
#define PG8_SB(b, h) ((4 + (b) * 2 + (h)) * HTB)
#define PG8_STAGE(bufoff, gbase, voff) do { _Pragma("unroll") for (int _i = 0; _i < 2; ++_i) \
        __builtin_amdgcn_global_load_lds((const unsigned*)((const char*)(gbase) + (voff)[_i]), (PG8_LAS unsigned*)(lds + (bufoff) + ldsw + _i * 8192), 16, 0, 0); } while (0)
#define PG8_LDA(dst, b, h) do { _Pragma("unroll") for (int m = 0; m < 4; ++m) _Pragma("unroll") for (int k = 0; k < 2; ++k) dst[m][k] = *(const PG8_LAS bf16x8*)(lds + PG8_SA(b, h) + aoff + m * 2048 + k * 1024); } while (0)
#define PG8_LDB(dst, b, h) do { _Pragma("unroll") for (int n = 0; n < 2; ++n) _Pragma("unroll") for (int k = 0; k < 2; ++k) dst[n][k] = *(const PG8_LAS bf16x8*)(lds + PG8_SB(b, h) + boff + n * 2048 + k * 1024); } while (0)
#define PG8_MMA(ai, bj, At, Bt) do { __builtin_amdgcn_s_setprio(1); _Pragma("unroll") for (int m = 0; m < 4; ++m) _Pragma("unroll") for (int n = 0; n < 2; ++n) _Pragma("unroll") for (int k = 0; k < 2; ++k) \
        acc[ai][bj][m][n] = __builtin_amdgcn_mfma_f32_16x16x32_bf16(Bt[n][k], At[m][k], acc[ai][bj][m][n], 0, 0, 0); __builtin_amdgcn_s_setprio(0); } while (0)
#define PG8_WAIT_V(n) asm volatile("s_waitcnt vmcnt(" #n ")" ::: "memory")
#define PG8_WAIT_L(n) asm volatile("s_waitcnt lgkmcnt(" #n ")" ::: "memory")
#define PG8_BAR __builtin_amdgcn_s_barrier()
#define PG8_SCHED __builtin_amdgcn_sched_barrier(0)
    Unit cur, nxt; int ui = 0;
    if (!S.next(0, cur)) return;
    f32x4 acc[2][2][4][2];
#pragma unroll
    for (int a = 0; a < 2; ++a)
#pragma unroll
        for (int b = 0; b < 2; ++b)
#pragma unroll
            for (int m = 0; m < 4; ++m)
#pragma unroll
                for (int n = 0; n < 2; ++n) acc[a][b][m][n] = (f32x4){0.f, 0.f, 0.f, 0.f};
    bf16x8 At[4][2], B0[2][2], B1[2][2];
    const char* cA = (const char*)g.A + (size_t)cur.pm * tstepA; const char* cB = (const char*)g.Bt + (size_t)((cur.pm / g.pm_per_grp) % g.grp_mod) * g.b_grp_bytes + (size_t)cur.pn * tstepB;
    S.a_ready(cur);
    if constexpr (SP2) {
        PG8_STAGE(PG8_SB(0, 0), cB, voffB); PG8_STAGE(PG8_SB(0, 1), cB + hstepB, voffB); PG8_STAGE(PG8_SA(0, 0), cA, voffA); PG8_STAGE(PG8_SA(0, 1), cA + hstepA, voffA);
        if (wr == 1) PG8_BAR;
        PG8_WAIT_V(2); PG8_BAR;
        PG8_STAGE(PG8_SB(1, 0), cB + kstep, voffB); PG8_STAGE(PG8_SA(1, 0), cA + kstep, voffA); PG8_STAGE(PG8_SB(1, 1), cB + hstepB + kstep, voffB);
        PG8_WAIT_V(6); PG8_BAR;
    } else {
        PG8_STAGE(PG8_SB(0, 0), cB, voffB); PG8_STAGE(PG8_SA(0, 0), cA, voffA); PG8_STAGE(PG8_SB(0, 1), cB + hstepB, voffB); PG8_STAGE(PG8_SA(0, 1), cA + hstepA, voffA);
        if (wr == 1) PG8_BAR;
        PG8_WAIT_V(4); PG8_BAR;
        PG8_STAGE(PG8_SB(1, 0), cB + kstep, voffB); PG8_STAGE(PG8_SA(1, 0), cA + kstep, voffA); PG8_STAGE(PG8_SB(1, 1), cB + hstepB + kstep, voffB);
        PG8_WAIT_V(6); PG8_BAR;
    }
    for (;;) {
        const bool has_next = S.next(ui + 1, nxt);
        const char* nA = has_next ? (const char*)g.A + (size_t)nxt.pm * tstepA : cA; const char* nB = has_next ? (const char*)g.Bt + (size_t)((nxt.pm / g.pm_per_grp) % g.grp_mod) * g.b_grp_bytes + (size_t)nxt.pn * tstepB : cB;
        for (int t = 0; t < nt; t += 2) {
            const bool last = (t == nt - 2);
            const char* a1 = cA + (size_t)(t + 1) * kstep;
            const char* a2 = last ? nA : cA + (size_t)(t + 2) * kstep; const char* b2 = last ? nB : cB + (size_t)(t + 2) * kstep;
            const char* a3 = a2 + kstep; const char* b3 = b2 + kstep;
            if (last && has_next) S.a_ready(nxt);
            if constexpr (SP2) {
            PG8_LDB(B0, 0, 0); PG8_LDB(B1, 0, 1); PG8_SCHED; PG8_LDA(At, 0, 0); PG8_STAGE(PG8_SA(1, 1), a1 + hstepA, voffA);
            PG8_WAIT_V(8); PG8_WAIT_L(0); PG8_BAR; PG8_MMA(0, 0, At, B0); PG8_MMA(0, 1, At, B1); PG8_BAR; PG8_SCHED;
            PG8_LDA(At, 0, 1); PG8_STAGE(PG8_SB(0, 0), b2, voffB); PG8_STAGE(PG8_SB(0, 1), b2 + hstepB, voffB); PG8_STAGE(PG8_SA(0, 0), a2, voffA);
            PG8_WAIT_V(8); PG8_WAIT_L(0); PG8_BAR; PG8_MMA(1, 0, At, B0); PG8_MMA(1, 1, At, B1); PG8_BAR; PG8_SCHED;
            PG8_LDB(B0, 1, 0); PG8_LDB(B1, 1, 1); PG8_SCHED; PG8_LDA(At, 1, 0); PG8_STAGE(PG8_SA(0, 1), a2 + hstepA, voffA);
            PG8_WAIT_V(8); PG8_WAIT_L(0); PG8_BAR; PG8_MMA(0, 0, At, B0); PG8_MMA(0, 1, At, B1); PG8_BAR; PG8_SCHED;
            PG8_LDA(At, 1, 1); PG8_STAGE(PG8_SB(1, 0), b3, voffB); PG8_STAGE(PG8_SB(1, 1), b3 + hstepB, voffB); PG8_STAGE(PG8_SA(1, 0), a3, voffA);
            PG8_WAIT_V(8); PG8_WAIT_L(0); PG8_BAR; PG8_MMA(1, 0, At, B0); PG8_MMA(1, 1, At, B1); PG8_BAR; PG8_SCHED;
            } else {
            PG8_LDB(B0, 0, 0); PG8_SCHED; PG8_LDA(At, 0, 0); PG8_STAGE(PG8_SA(1, 1), a1 + hstepA, voffA);
            PG8_WAIT_L(8); PG8_BAR; PG8_WAIT_L(0); PG8_MMA(0, 0, At, B0); PG8_BAR; PG8_SCHED;
            PG8_LDB(B1, 0, 1); PG8_STAGE(PG8_SB(0, 0), b2, voffB);
            PG8_BAR; PG8_WAIT_L(0); PG8_MMA(0, 1, At, B1); PG8_BAR;
            PG8_LDA(At, 0, 1); PG8_STAGE(PG8_SA(0, 0), a2, voffA);
            PG8_BAR; PG8_WAIT_L(0); PG8_MMA(1, 0, At, B0); PG8_BAR; PG8_SCHED;
            PG8_STAGE(PG8_SB(0, 1), b2 + hstepB, voffB);
            PG8_WAIT_V(6); PG8_BAR; PG8_MMA(1, 1, At, B1); PG8_BAR;
            PG8_LDB(B0, 1, 0); PG8_SCHED; PG8_LDA(At, 1, 0); PG8_STAGE(PG8_SA(0, 1), a2 + hstepA, voffA);
            PG8_WAIT_L(8); PG8_BAR; PG8_WAIT_L(0); PG8_MMA(0, 0, At, B0); PG8_BAR; PG8_SCHED;
            PG8_LDB(B1, 1, 1); PG8_STAGE(PG8_SB(1, 0), b3, voffB);
            PG8_BAR; PG8_WAIT_L(0); PG8_MMA(0, 1, At, B1); PG8_BAR;
            PG8_LDA(At, 1, 1); PG8_STAGE(PG8_SA(1, 0), a3, voffA);
            PG8_BAR; PG8_WAIT_L(0); PG8_MMA(1, 0, At, B0); PG8_BAR; PG8_SCHED;
            PG8_STAGE(PG8_SB(1, 1), b3 + hstepB, voffB);
            PG8_WAIT_V(6); PG8_BAR; PG8_MMA(1, 1, At, B1); PG8_BAR;
            }
        }
        if constexpr (ALIGN_EPI) { if (wr == 0) PG8_BAR; }
        if constexpr (!Epi::AFTER_DRAIN) { E(acc, cur, wr, wc, fr, fq); S.done(cur); }
        if (!has_next) break;
#pragma unroll
        for (int a = 0; a < 2; ++a)
#pragma unroll
            for (int b = 0; b < 2; ++b)
#pragma unroll
                for (int m = 0; m < 4; ++m)
#pragma unroll
                    for (int n = 0; n < 2; ++n) acc[a][b][m][n] = (f32x4){0.f, 0.f, 0.f, 0.f};
        cur = nxt; cA = nA; cB = nB; ++ui;
        if constexpr (ALIGN_EPI) { if (wr == 1) PG8_BAR; }
    }
    PG8_WAIT_V(0);
    if constexpr (!ALIGN_EPI) { if (wr == 0) PG8_BAR; }
    PG8_BAR;
    if constexpr (Epi::AFTER_DRAIN) { E.fused(acc, cur, wr, wc, fr, fq, lds, wid, lane); S.done(cur); }
#undef PG8_SA
#undef PG8_SB
#undef PG8_STAGE
#undef PG8_LDA
#undef PG8_LDB
#undef PG8_MMA
#undef PG8_WAIT_V
#undef PG8_WAIT_L
#undef PG8_BAR
#undef PG8_SCHED
}
}

namespace epi {
using pg8::f32x4; using pg8::u32x4; using pg8::Unit; using pg8::bf16_t; using pg8::cvt_pk_bf16; using pg8::HALF; using pg8::BM;
typedef unsigned u32x2 __attribute__((ext_vector_type(2)));

struct EpiIn {
    static constexpr bool PERM = false, AFTER_DRAIN = false;
    bf16_t* cq; bf16_t* ckv; float* krr; bf16_t* hyT; float* ssq_q; float* ssq_kv;
    __device__ __forceinline__ void operator()(const f32x4 (&acc)[2][2][4][2], const Unit& u, int wr, int wc, int fr, int fq) const {
#pragma unroll
        for (int ai = 0; ai < 2; ++ai)
#pragma unroll
            for (int m = 0; m < 4; ++m) {
                const int row = u.pm * BM + ai * HALF + wr * 64 + m * 16 + fr;
                float sq = 0.f, skv = 0.f;
#pragma unroll
                for (int bj = 0; bj < 2; ++bj)
#pragma unroll
                    for (int n = 0; n < 2; ++n) {
                        const int c0 = u.pn * BM + bj * HALF + wc * 32 + n * 16 + 4 * fq;
                        const f32x4 v = acc[ai][bj][m][n];
                        if (c0 < 256) {
                            u32x2 w; w.x = cvt_pk_bf16(v[0], v[1]); w.y = cvt_pk_bf16(v[2], v[3]);
                            *(u32x2*)(cq + (size_t)row * 256 + c0) = w;
                            sq += (v[0] * v[0] + v[1] * v[1]) + (v[2] * v[2] + v[3] * v[3]);
                        } else if (c0 < 384) {
                            u32x2 w; w.x = cvt_pk_bf16(v[0], v[1]); w.y = cvt_pk_bf16(v[2], v[3]);
                            *(u32x2*)(ckv + (size_t)row * 128 + (c0 - 256)) = w;
                            skv += (v[0] * v[0] + v[1] * v[1]) + (v[2] * v[2] + v[3] * v[3]);
                        } else if (c0 < 416) {
                            *(f32x4*)(krr + (size_t)row * 32 + (c0 - 384)) = v;
                        } else if (c0 < IN_COLS) {
                            bf16_t* p = hyT + (size_t)(c0 - 416) * T + row;
                            const unsigned w0 = cvt_pk_bf16(v[0], v[1]), w1 = cvt_pk_bf16(v[2], v[3]);
                            p[0] = (bf16_t)(w0 & 0xffffu); p[(size_t)T] = (bf16_t)(w0 >> 16); p[2 * (size_t)T] = (bf16_t)(w1 & 0xffffu); p[3 * (size_t)T] = (bf16_t)(w1 >> 16);
                        }
                    }
                if (u.pn == 0) { sq += __shfl_xor(sq, 16); sq += __shfl_xor(sq, 32); if (fq == 0) atomicAdd(ssq_q + row, sq); }
                if (u.pn == 1) { skv += __shfl_xor(skv, 16); skv += __shfl_xor(skv, 32); if (fq == 0) atomicAdd(ssq_kv + row, skv); }
            }
    }
};

struct EpiRowScale {
    static constexpr bool PERM = true, AFTER_DRAIN = false;
    bf16_t* O; int ldc; const float* ssq; float inv_n;
    __device__ __forceinline__ void operator()(const f32x4 (&acc)[2][2][4][2], const Unit& u, int wr, int wc, int fr, int fq) const {
        const int col0 = u.pn * BM + wc * 32 + 8 * fq;
#pragma unroll
        for (int ai = 0; ai < 2; ++ai)
#pragma unroll
            for (int m = 0; m < 4; ++m) {
                const int row = u.pm * BM + ai * HALF + wr * 64 + m * 16 + fr;
                const float s = ssq ? __builtin_amdgcn_rsqf(ssq[row] * inv_n + EPS) : 1.f;
#pragma unroll
                for (int bj = 0; bj < 2; ++bj) {
                    const f32x4 v0 = acc[ai][bj][m][0] * s, v1 = acc[ai][bj][m][1] * s;
                    u32x4 w; w.x = cvt_pk_bf16(v0[0], v0[1]); w.y = cvt_pk_bf16(v0[2], v0[3]); w.z = cvt_pk_bf16(v1[0], v1[1]); w.w = cvt_pk_bf16(v1[2], v1[3]);
                    *(u32x4*)(O + (size_t)row * ldc + col0 + bj * HALF) = w;
                }
            }
    }
};

struct EpiFilt {
    static constexpr bool PERM = false, AFTER_DRAIN = false;
    bf16_t* kT; const float* b3; const float* decay;
    __device__ __forceinline__ void operator()(const f32x4 (&acc)[2][2][4][2], const Unit& u, int wr, int wc, int fr, int fq) const {
#pragma unroll
        for (int bj = 0; bj < 2; ++bj)
#pragma unroll
            for (int n = 0; n < 2; ++n) {
                const int c0 = u.pn * BM + bj * HALF + wc * 32 + n * 16 + 4 * fq;
                const f32x4 bb = *(const f32x4*)(b3 + c0); const f32x4 dd = *(const f32x4*)(decay + c0);
#pragma unroll
                for (int ai = 0; ai < 2; ++ai)
#pragma unroll
                    for (int m = 0; m < 4; ++m) {
                        const int row = u.pm * BM + ai * HALF + wr * 64 + m * 16 + fr;
                        const float tl = (float)row * (1.0f / (float)(SEQ - 1));
                        const f32x4 v = acc[ai][bj][m][n];
#pragma unroll
                        for (int j = 0; j < 4; ++j) {
                            const float val = (v[j] + bb[j]) * __expf(-tl * fabsf(dd[j]));
                            kT[(size_t)(c0 + j) * SEQ + row] = (bf16_t)(cvt_pk_bf16(val, 0.f) & 0xffffu);
                        }
                    }
            }
    }
};

struct EpiGU {
    static constexpr bool PERM = true, AFTER_DRAIN = false;
    bf16_t* H;
    __device__ __forceinline__ void operator()(const f32x4 (&acc)[2][2][4][2], const Unit& u, int wr, int wc, int fr, int fq) const {
        const int col0 = u.pn * BM + wc * 32 + 8 * fq;
#pragma unroll
        for (int ai = 0; ai < 2; ++ai)
#pragma unroll
            for (int m = 0; m < 4; ++m) {
                const int row = u.pm * BM + ai * HALF + wr * 64 + m * 16 + fr;
#pragma unroll
                for (int bj = 0; bj < 2; ++bj) {
                    const f32x4 v0 = acc[ai][bj][m][0], v1 = acc[ai][bj][m][1];
                    float h[4];
                    { const float g = v0[0], up = v0[1]; h[0] = g / (1.f + __expf(-g)) * up; }
                    { const float g = v0[2], up = v0[3]; h[1] = g / (1.f + __expf(-g)) * up; }
                    { const float g = v1[0], up = v1[1]; h[2] = g / (1.f + __expf(-g)) * up; }
                    { const float g = v1[2], up = v1[3]; h[3] = g / (1.f + __expf(-g)) * up; }
                    u32x2 w; w.x = cvt_pk_bf16(h[0], h[1]); w.y = cvt_pk_bf16(h[2], h[3]);
                    *(u32x2*)(H + (size_t)row * EFF + ((col0 + bj * HALF) >> 1)) = w;
                }
            }
    }
};

struct EpiDown {
    static constexpr bool PERM = true, AFTER_DRAIN = false;
    bf16_t* O; const float* gate;
    __device__ __forceinline__ void operator()(const f32x4 (&acc)[2][2][4][2], const Unit& u, int wr, int wc, int fr, int fq) const {
        const int col0 = u.pn * BM + wc * 32 + 8 * fq;
#pragma unroll
        for (int ai = 0; ai < 2; ++ai)
#pragma unroll
            for (int m = 0; m < 4; ++m) {
                const int row = u.pm * BM + ai * HALF + wr * 64 + m * 16 + fr;
                const float s = gate[row];
#pragma unroll
                for (int bj = 0; bj < 2; ++bj) {
                    const f32x4 v0 = acc[ai][bj][m][0] * s, v1 = acc[ai][bj][m][1] * s;
                    u32x4 w; w.x = cvt_pk_bf16(v0[0], v0[1]); w.y = cvt_pk_bf16(v0[2], v0[3]); w.z = cvt_pk_bf16(v1[0], v1[1]); w.w = cvt_pk_bf16(v1[2], v1[3]);
                    *(u32x4*)(O + (size_t)row * DM + col0 + bj * HALF) = w;
                }
            }
    }
};
}

namespace attn {
using bf16x8 = __attribute__((ext_vector_type(8))) short;
using s16x4  = __attribute__((ext_vector_type(4))) short;
using f32x16 = __attribute__((ext_vector_type(16))) float;
using f32x8  = __attribute__((ext_vector_type(8))) float;
using u32x4  = __attribute__((ext_vector_type(4))) unsigned;
typedef unsigned short bf16_t;
constexpr int NW = 8, QBLK = 32, KVBLK = 64;
constexpr float SCALE = 0.10206207261596575f;
constexpr float THR = 8.f;
constexpr int LDQ = NH * QKD;
constexpr int LDKV = NH * 128;
constexpr int LDO = NH * VD;
constexpr int SHM_V = KVBLK * 128 * 2, SHM_K = KVBLK * 128 * 2;
constexpr int SHM_ATTN = 2 * SHM_V + 2 * SHM_K + NW * 64 * 4;
#define KSWZ(row, colB) ((row) * 256 + ((colB) ^ (((row) & 7) << 4)))
#define SBAR() __builtin_amdgcn_sched_barrier(0)
__device__ __forceinline__ int crow(int r, int hi) { return (r & 3) + 8 * (r >> 2) + 4 * hi; }
__device__ __forceinline__ unsigned cvtpk(float lo, float hi) { unsigned r; asm volatile("v_cvt_pk_bf16_f32 %0, %1, %2" : "=v"(r) : "v"(lo), "v"(hi)); return r; }
__device__ __forceinline__ float bf2f(short s) { return __uint_as_float(((unsigned)(unsigned short)s) << 16); }

__device__ __forceinline__ void partialSM(f32x16& p0, f32x16& p1, float& m_reg, float& mn, float& alpha) {
  constexpr float C = SCALE * 1.4426950408889634f;
  float pmax = p0[0]; for (int r = 1; r < 16; ++r) pmax = fmaxf(pmax, p0[r]); for (int r = 0; r < 16; ++r) pmax = fmaxf(pmax, p1[r]);
  { auto rr = __builtin_amdgcn_permlane32_swap(__float_as_uint(pmax), __float_as_uint(pmax), false, false);
    pmax = fmaxf(__uint_as_float(rr[0]), __uint_as_float(rr[1])); }
  if (__builtin_expect(__all(pmax - m_reg <= THR / SCALE), 1)) { mn = m_reg; alpha = 1.f; }
  else { mn = fmaxf(m_reg, pmax); alpha = __builtin_amdgcn_exp2f((m_reg - mn) * C); m_reg = mn; }
  float mnC = -mn * C;
  for (int r = 0; r < 16; ++r) p0[r] = fmaf(p0[r], C, mnC); for (int r = 0; r < 16; ++r) p1[r] = fmaf(p1[r], C, mnC);
  for (int r = 0; r < 16; ++r) p0[r] = __builtin_amdgcn_exp2f(p0[r]);
}
__device__ __forceinline__ void finishSM(f32x16& p0, f32x16& p1, float alpha, float& l_reg, bf16x8& pa0, bf16x8& pa1, bf16x8& pa2, bf16x8& pa3) {
  for (int r = 0; r < 16; ++r) p1[r] = __builtin_amdgcn_exp2f(p1[r]);
  float ps = 0; for (int r = 0; r < 16; ++r) ps += p0[r]; for (int r = 0; r < 16; ++r) ps += p1[r];
  { auto rr = __builtin_amdgcn_permlane32_swap(__float_as_uint(ps), __float_as_uint(ps), false, false);
    ps = __uint_as_float(rr[0]) + __uint_as_float(rr[1]); }
  l_reg = l_reg * alpha + ps;
#define PK4(P, BASE, OUT) do { unsigned a0 = cvtpk(P[BASE + 0], P[BASE + 1]), a1 = cvtpk(P[BASE + 2], P[BASE + 3]);   \
    unsigned b0 = cvtpk(P[BASE + 4], P[BASE + 5]), b1 = cvtpk(P[BASE + 6], P[BASE + 7]);                              \
    auto r0 = __builtin_amdgcn_permlane32_swap(a0, b0, false, false); auto r1 = __builtin_amdgcn_permlane32_swap(a1, b1, false, false); \
    u32x4 w = {r0[0], r1[0], r0[1], r1[1]}; OUT = *reinterpret_cast<bf16x8*>(&w); } while (0)
  PK4(p0, 0, pa0); PK4(p0, 8, pa1); PK4(p1, 0, pa2); PK4(p1, 8, pa3);
#undef PK4
}
__device__ __forceinline__ void qkt(f32x16& p0, f32x16& p1, const bf16_t* Ks, const bf16x8* qr, int r32, int hi) {
  p0 = f32x16{}; p1 = f32x16{};
#pragma unroll
  for (int d0 = 0; d0 < 6; ++d0) { int cb = (d0 * 16 + hi * 8) * 2;
    bf16x8 b0 = *reinterpret_cast<const bf16x8*>((const char*)Ks + KSWZ(r32, cb));
    bf16x8 b1 = *reinterpret_cast<const bf16x8*>((const char*)Ks + KSWZ(32 + r32, cb));
    p0 = __builtin_amdgcn_mfma_f32_32x32x16_bf16(b0, qr[d0], p0, 0, 0, 0);
    p1 = __builtin_amdgcn_mfma_f32_32x32x16_bf16(b1, qr[d0], p1, 0, 0, 0); }
}
__device__ __forceinline__ int v_st(int k, int c) { const int kk = (k & ~0xC) | ((k & 4) << 1) | ((k & 8) >> 1); return ((kk >> 3) * 4 + (c >> 5)) * 512 + ((kk & 7) * 32 + (c & 31)) * 2; }
__device__ __forceinline__ int v_rd_base(int lane) { return ((lane & 3) << 3) | (((lane >> 2) & 3) << 6) | (((lane >> 4) & 1) << 5) | (((lane >> 5) & 1) << 8); }
constexpr int v_rd_off(int d0, int ks, int half) { return d0 * 512 + ks * 4096 + half * 2048; }
template <int OFF> __device__ __forceinline__ s16x4 tr_read(int vb) {
  s16x4 r; asm volatile("ds_read_b64_tr_b16 %0, %1 offset:%2" : "=&v"(r) : "v"(vb), "i"(OFF) : "memory"); return r;
}
template <int D0> __device__ __forceinline__ void pv_one(f32x16& od, int vb, bf16x8 pa0, bf16x8 pa1, bf16x8 pa2, bf16x8 pa3) {
  const s16x4 l0 = tr_read<v_rd_off(D0, 0, 0)>(vb), h0 = tr_read<v_rd_off(D0, 0, 1)>(vb), l1 = tr_read<v_rd_off(D0, 1, 0)>(vb), h1 = tr_read<v_rd_off(D0, 1, 1)>(vb);
  const s16x4 l2 = tr_read<v_rd_off(D0, 2, 0)>(vb), h2 = tr_read<v_rd_off(D0, 2, 1)>(vb), l3 = tr_read<v_rd_off(D0, 3, 0)>(vb), h3 = tr_read<v_rd_off(D0, 3, 1)>(vb);
  asm volatile("s_waitcnt lgkmcnt(0)" ::: "memory"); SBAR();
#define PK(L, H) (bf16x8){L[0], L[1], L[2], L[3], H[0], H[1], H[2], H[3]}
  od = __builtin_amdgcn_mfma_f32_32x32x16_bf16(pa0, PK(l0, h0), od, 0, 0, 0);
  od = __builtin_amdgcn_mfma_f32_32x32x16_bf16(pa1, PK(l1, h1), od, 0, 0, 0);
  od = __builtin_amdgcn_mfma_f32_32x32x16_bf16(pa2, PK(l2, h2), od, 0, 0, 0);
  od = __builtin_amdgcn_mfma_f32_32x32x16_bf16(pa3, PK(l3, h3), od, 0, 0, 0);
#undef PK
}
__device__ __forceinline__ void pv_d0(f32x16* o, int vb, bf16x8 pa0, bf16x8 pa1, bf16x8 pa2, bf16x8 pa3) {
  pv_one<0>(o[0], vb, pa0, pa1, pa2, pa3); pv_one<1>(o[1], vb, pa0, pa1, pa2, pa3);
}

__device__ __forceinline__ void attn_unit(const bf16_t* __restrict__ Q, const bf16_t* __restrict__ KV, const bf16_t* __restrict__ KR, const float* __restrict__ CS,
                                          bf16_t* __restrict__ O, int h, long tq0, long tk0, int seq, char* lds, const int tid) {
  const int wid = tid >> 6, lane = tid & 63, r32 = lane & 31, hi = lane >> 5;
  bf16_t* V_lds = (bf16_t*)lds; bf16_t* K_lds = (bf16_t*)(lds + 2 * SHM_V);
  float* ws = (float*)(lds + 2 * SHM_V + 2 * SHM_K) + wid * 64; float* li_l = ws; float* al_l = ws + 32;
  float m_reg = -1e30f, l_reg = 0; f32x16 o[2] = {}; bf16x8 qr[6];
  { const long trow = tq0 + wid * QBLK + r32;
    const bf16_t* Qw = Q + trow * LDQ + h * QKD + hi * 8;
#pragma unroll
    for (int d0 = 0; d0 < 6; ++d0) qr[d0] = *reinterpret_cast<const bf16x8*>(Qw + d0 * 16);
    const float* cs = CS + trow * 32 + hi * 16;
    bf16x8 q4 = qr[4], q5 = qr[5];
    unsigned w4[4], w5[4];
#pragma unroll
    for (int jj = 0; jj < 4; ++jj) {
      const float4 c2 = *reinterpret_cast<const float4*>(cs + jj * 4);
      const float a0 = bf2f(q4[2 * jj]), b0 = bf2f(q5[2 * jj]), a1 = bf2f(q4[2 * jj + 1]), b1 = bf2f(q5[2 * jj + 1]);
      w4[jj] = cvtpk(a0 * c2.x - b0 * c2.y, a1 * c2.z - b1 * c2.w);
      w5[jj] = cvtpk(b0 * c2.x + a0 * c2.y, b1 * c2.z + a1 * c2.w);
    }
    u32x4 W4 = {w4[0], w4[1], w4[2], w4[3]}, W5 = {w5[0], w5[1], w5[2], w5[3]};
    qr[4] = *reinterpret_cast<bf16x8*>(&W4); qr[5] = *reinterpret_cast<bf16x8*>(&W5);
  }
  const int sr = tid >> 3, sc = (tid & 7) * 8, vst0 = v_st(sr, sc);
  const int rr = (tid & 255) >> 2, rc = (tid & 3) * 8;
  const bool rope_w = tid < 256;
  const bf16_t* Vg = KV + (tk0 + sr) * LDKV + h * 128 + 64 + sc;
  const bf16_t* Kg = KV + (tk0 + sr) * LDKV + h * 128 + sc;
  const bf16_t* Rg = KR + (tk0 + rr) * 32 + rc;
  const int vb0 = (int)(uintptr_t)V_lds + v_rd_base(lane);
  struct { bf16x8 vs, ks, rs; } sr_[2];
#define SLOAD(i, k0) do { sr_[i].vs = *reinterpret_cast<const bf16x8*>(Vg + (long)(k0) * LDKV); sr_[i].ks = *reinterpret_cast<const bf16x8*>(Kg + (long)(k0) * LDKV); \
    sr_[i].rs = *reinterpret_cast<const bf16x8*>(Rg + (long)(k0) * 32); } while (0)
#define SWRITE(b, i) do { *(bf16x8*)((char*)V_lds + (b) * SHM_V + vst0) = sr_[i].vs;          \
    *(bf16x8*)((char*)K_lds + (b) * SHM_K + KSWZ(sr, sc * 2)) = sr_[i].ks;                       \
    if (rope_w) *(bf16x8*)((char*)K_lds + (b) * SHM_K + KSWZ(rr, (64 + rc) * 2)) = sr_[i].rs; } while (0)
#define SWAIT() asm volatile("s_waitcnt vmcnt(3)" ::: "memory")
#define RESC(a) do { if (__any((a) < 1.f)) { if (hi == 0) al_l[r32] = (a); asm volatile("s_waitcnt lgkmcnt(0)" ::: "memory"); \
    for (int d = 0; d < 2; ++d) for (int r = 0; r < 16; ++r) o[d][r] *= al_l[crow(r, hi)]; } } while (0)
  f32x16 pA0, pA1, pB0, pB1; float mnA, mnB, alA, alB; bf16x8 pa0, pa1, pa2, pa3; const int NT = seq / KVBLK;
  constexpr int SE = 0, SO = 1;
  SLOAD(SE, 0); asm volatile("s_waitcnt vmcnt(0)" ::: "memory"); SWRITE(0, SE); __syncthreads();
  qkt(pA0, pA1, K_lds, qr, r32, hi); partialSM(pA0, pA1, m_reg, mnA, alA);
  SLOAD(SO, KVBLK); if (2 < NT) SLOAD(SE, 2 * KVBLK);
  SWAIT(); SWRITE(1, SO); __syncthreads();
  for (int j = 1; j + 1 < NT; j += 2) {
    SBAR(); qkt(pB0, pB1, (bf16_t*)((char*)K_lds + SHM_K), qr, r32, hi);
    finishSM(pA0, pA1, alA, l_reg, pa0, pa1, pa2, pa3); SBAR();
    SLOAD(SO, (j + 2) * KVBLK); SBAR();
    pv_d0(o, vb0, pa0, pa1, pa2, pa3); partialSM(pB0, pB1, m_reg, mnB, alB);
    __syncthreads(); SWAIT(); SWRITE(0, SE);
    RESC(alB); __syncthreads();
    SBAR(); qkt(pA0, pA1, K_lds, qr, r32, hi);
    finishSM(pB0, pB1, alB, l_reg, pa0, pa1, pa2, pa3); SBAR();
    if (j + 3 < NT) SLOAD(SE, (j + 3) * KVBLK); SBAR();
    pv_d0(o, vb0 + (int)SHM_V, pa0, pa1, pa2, pa3); partialSM(pA0, pA1, m_reg, mnA, alA);
    __syncthreads(); SWAIT(); SWRITE(1, SO);
    RESC(alA); __syncthreads();
  }
  SBAR(); qkt(pB0, pB1, (bf16_t*)((char*)K_lds + SHM_K), qr, r32, hi);
  finishSM(pA0, pA1, alA, l_reg, pa0, pa1, pa2, pa3); SBAR();
  pv_d0(o, vb0, pa0, pa1, pa2, pa3); partialSM(pB0, pB1, m_reg, mnB, alB);
  __syncthreads(); RESC(alB);
  finishSM(pB0, pB1, alB, l_reg, pa0, pa1, pa2, pa3); SBAR();
  pv_d0(o, vb0 + (int)SHM_V, pa0, pa1, pa2, pa3);
  if (hi == 0) li_l[r32] = l_reg; asm volatile("s_waitcnt lgkmcnt(0)" ::: "memory");
  float rli[16];
#pragma unroll
  for (int r = 0; r < 16; ++r) rli[r] = __builtin_amdgcn_rcpf(li_l[crow(r, hi)]);
  bf16_t* Ow = O + (tq0 + wid * QBLK) * LDO + h * VD;
#pragma unroll
  for (int r = 0; r < 16; ++r) { int orow = crow(r, hi);
#pragma unroll
    for (int d0 = 0; d0 < 2; ++d0) Ow[(long)orow * LDO + d0 * 32 + r32] = (bf16_t)(cvtpk(o[d0][r] * rli[r], 0.f) & 0xffffu); }
  __syncthreads();
#undef SLOAD
#undef SWRITE
#undef SWAIT
#undef RESC
}
#undef KSWZ
#undef SBAR
}

namespace hy {
typedef float2 cf;
typedef unsigned short bf16_t;
constexpr int N = NFFT, L = SEQ;
constexpr int ZELEMS = 17408;
__device__ __forceinline__ int phys(int n) { return n + (n >> 4); }
__device__ __forceinline__ cf cmul(cf a, cf b) { return make_float2(a.x * b.x - a.y * b.y, a.x * b.y + a.y * b.x); }
__device__ __forceinline__ cf cadd(cf a, cf b) { return make_float2(a.x + b.x, a.y + b.y); }
__device__ __forceinline__ cf csub(cf a, cf b) { return make_float2(a.x - b.x, a.y - b.y); }
__device__ __forceinline__ float bf2f(bf16_t s) { return __uint_as_float(((unsigned)s) << 16); }
__device__ constexpr int BR32[32] = {0, 16, 8, 24, 4, 20, 12, 28, 2, 18, 10, 26, 6, 22, 14, 30, 1, 17, 9, 25, 5, 21, 13, 29, 3, 19, 11, 27, 7, 23, 15, 31};
__device__ constexpr int BR16[16] = {0, 8, 4, 12, 2, 10, 6, 14, 1, 9, 5, 13, 3, 11, 7, 15};
__device__ constexpr int BR4[4] = {0, 2, 1, 3};
#define bitrev(p, R) (((R) == 32) ? BR32[(p) & 31] : ((R) == 16) ? BR16[(p) & 15] : BR4[(p) & 3])
__device__ constexpr float C32[16] = {1.0f, 0.98078528040323043f, 0.92387953251128674f, 0.83146961230254524f, 0.70710678118654752f, 0.55557023301960218f, 0.38268343236508977f, 0.19509032201612825f,
                                      0.0f, -0.19509032201612825f, -0.38268343236508977f, -0.55557023301960218f, -0.70710678118654752f, -0.83146961230254524f, -0.92387953251128674f, -0.98078528040323043f};
__device__ constexpr float S32[16] = {0.0f, 0.19509032201612825f, 0.38268343236508977f, 0.55557023301960218f, 0.70710678118654752f, 0.83146961230254524f, 0.92387953251128674f, 0.98078528040323043f,
                                      1.0f, 0.98078528040323043f, 0.92387953251128674f, 0.83146961230254524f, 0.70710678118654752f, 0.55557023301960218f, 0.38268343236508977f, 0.19509032201612825f};

template <int R, int LEN, int SGN> struct DftStage {
    static __device__ __forceinline__ void run(cf (&v)[R]) {
        constexpr int half = LEN / 2;
#pragma unroll
        for (int blk = 0; blk < R; blk += LEN) {
#pragma unroll
            for (int k = 0; k < half; ++k) {
                const cf a = v[blk + k], b = v[blk + k + half];
                v[blk + k] = cadd(a, b);
                const cf d = csub(a, b);
                const int tk = k * (32 / LEN);
                if (tk == 0) v[blk + k + half] = d;
                else if (tk == 8) v[blk + k + half] = (SGN < 0) ? make_float2(d.y, -d.x) : make_float2(-d.y, d.x);
                else { const float c = C32[tk], s = (SGN < 0) ? -S32[tk] : S32[tk]; v[blk + k + half] = make_float2(d.x * c - d.y * s, d.x * s + d.y * c); }
            }
        }
        DftStage<R, LEN / 2, SGN>::run(v);
    }
};
template <int R, int SGN> struct DftStage<R, 1, SGN> { static __device__ __forceinline__ void run(cf (&)[R]) {} };
template <int R, int SGN> __device__ __forceinline__ void dft_reg(cf (&v)[R]) { DftStage<R, R, SGN>::run(v); }
template <int R> __device__ __forceinline__ void tw_apply_br(cf (&v)[R], cf w1) {
    const cf w2 = cmul(w1, w1), w3 = cmul(w2, w1), w4 = cmul(w2, w2);
    cf c0 = w4, c1 = w1, c2 = w2, c3 = w3;
#pragma unroll
    for (int k = 0; k < R / 4; ++k) {
        if (k > 0) { v[bitrev(4 * k, R)] = cmul(v[bitrev(4 * k, R)], c0); c0 = cmul(c0, w4); }
        v[bitrev(4 * k + 1, R)] = cmul(v[bitrev(4 * k + 1, R)], c1); c1 = cmul(c1, w4);
        v[bitrev(4 * k + 2, R)] = cmul(v[bitrev(4 * k + 2, R)], c2); c2 = cmul(c2, w4);
        v[bitrev(4 * k + 3, R)] = cmul(v[bitrev(4 * k + 3, R)], c3); c3 = cmul(c3, w4);
    }
}
template <int R> __device__ __forceinline__ void tw_apply_nat(cf (&v)[R], cf w1) {
    const cf w2 = cmul(w1, w1), w3 = cmul(w2, w1), w4 = cmul(w2, w2);
    cf c0 = w4, c1 = w1, c2 = w2, c3 = w3;
#pragma unroll
    for (int k = 0; k < R / 4; ++k) {
        if (k > 0) { v[4 * k] = cmul(v[4 * k], c0); c0 = cmul(c0, w4); }
        v[4 * k + 1] = cmul(v[4 * k + 1], c1); c1 = cmul(c1, w4);
        v[4 * k + 2] = cmul(v[4 * k + 2], c2); c2 = cmul(c2, w4);
        v[4 * k + 3] = cmul(v[4 * k + 3], c3); c3 = cmul(c3, w4);
    }
}
template <int R, int S> __device__ __forceinline__ void fwd_bfly(cf* Z, int base, int j, cf w1) {
    cf v[R];
#pragma unroll
    for (int q = 0; q < R; ++q) v[q] = Z[phys(base + j + q * S)];
    dft_reg<R, -1>(v);
    if (S > 1) tw_apply_br<R>(v, w1);
#pragma unroll
    for (int p = 0; p < R; ++p) Z[phys(base + j + p * S)] = v[bitrev(p, R)];
}
template <int R, int S> __device__ __forceinline__ void inv_bfly(cf* Z, int base, int j, cf w1c) {
    cf v[R];
#pragma unroll
    for (int p = 0; p < R; ++p) v[p] = Z[phys(base + j + p * S)];
    if (S > 1) tw_apply_nat<R>(v, w1c);
    dft_reg<R, 1>(v);
#pragma unroll
    for (int q = 0; q < R; ++q) Z[phys(base + j + q * S)] = v[bitrev(q, R)];
}
__device__ __forceinline__ void fft_pass123(cf* Z, const cf* __restrict__ TW, const int tid) {
#pragma unroll 1
    for (int i = 0; i < 2; ++i) { const int b = tid + 512 * i; fwd_bfly<16, 1024>(Z, 0, b, TW[b]); }
    __syncthreads();
#pragma unroll 1
    for (int i = 0; i < 2; ++i) { const int b = tid + 512 * i, blk = b >> 6, j = b & 63; fwd_bfly<16, 64>(Z, blk * 1024, j, TW[j * 16]); }
    __syncthreads();
#pragma unroll 1
    for (int i = 0; i < 2; ++i) { const int b = tid + 512 * i, blk = b >> 2, j = b & 3; fwd_bfly<16, 4>(Z, blk * 64, j, TW[j * 256]); }
    __syncthreads();
}
__device__ __forceinline__ void ifft_pass321(cf* Z, const cf* __restrict__ TW, const int tid) {
    __syncthreads();
#pragma unroll 1
    for (int i = 0; i < 2; ++i) { const int b = tid + 512 * i, blk = b >> 2, j = b & 3; cf w = TW[j * 256]; w.y = -w.y; inv_bfly<16, 4>(Z, blk * 64, j, w); }
    __syncthreads();
#pragma unroll 1
    for (int i = 0; i < 2; ++i) { const int b = tid + 512 * i, blk = b >> 6, j = b & 63; cf w = TW[j * 16]; w.y = -w.y; inv_bfly<16, 64>(Z, blk * 1024, j, w); }
    __syncthreads();
#pragma unroll 1
    for (int i = 0; i < 2; ++i) { const int b = tid + 512 * i; cf w = TW[b]; w.y = -w.y; inv_bfly<16, 1024>(Z, 0, b, w); }
    __syncthreads();
}
__device__ __forceinline__ void fft_fwd(cf* Z, const cf* __restrict__ TW, const int tid) {
    fft_pass123(Z, TW, tid);
#pragma unroll 1
    for (int i = 0; i < 2; ++i) {
        const int base = (tid + 512 * i) * 16;
#pragma unroll
        for (int g = 0; g < 4; ++g) { cf v[4];
#pragma unroll
            for (int q = 0; q < 4; ++q) v[q] = Z[phys(base + 4 * g + q)];
            dft_reg<4, -1>(v);
#pragma unroll
            for (int p = 0; p < 4; ++p) Z[phys(base + 4 * g + p)] = v[bitrev(p, 4)]; }
    }
    __syncthreads();
}
__device__ __forceinline__ void fft_conv(cf* Z, const cf* __restrict__ TW, const cf* __restrict__ Hs, const int tid) {
    fft_pass123(Z, TW, tid);
#pragma unroll 1
    for (int i = 0; i < 2; ++i) {
        const int base = (tid + 512 * i) * 16;
#pragma unroll
        for (int g = 0; g < 4; ++g) { cf v[4];
#pragma unroll
            for (int q = 0; q < 4; ++q) v[q] = Z[phys(base + 4 * g + q)];
            dft_reg<4, -1>(v);
            const float4 h0 = *reinterpret_cast<const float4*>(Hs + base + 4 * g), h1 = *reinterpret_cast<const float4*>(Hs + base + 4 * g + 2);
            cf t[4];
            t[0] = cmul(v[bitrev(0, 4)], make_float2(h0.x, h0.y)); t[1] = cmul(v[bitrev(1, 4)], make_float2(h0.z, h0.w));
            t[2] = cmul(v[bitrev(2, 4)], make_float2(h1.x, h1.y)); t[3] = cmul(v[bitrev(3, 4)], make_float2(h1.z, h1.w));
            dft_reg<4, 1>(t);
#pragma unroll
            for (int q = 0; q < 4; ++q) Z[phys(base + 4 * g + q)] = t[bitrev(q, 4)]; }
    }
    ifft_pass321(Z, TW, tid);
}

__device__ __forceinline__ float conv3(const bf16_t* row, int b, int s, float w0, float w1, float w2, float cb) {
    const bf16_t* p = row + (size_t)b * SEQ + s;
    const float r0 = (s > 0) ? bf2f(p[-1]) : 0.f, r1 = bf2f(p[0]), r2 = (s < SEQ - 1) ? bf2f(p[1]) : 0.f;
    return cb + w0 * r0 + w1 * r1 + w2 * r2;
}

__device__ __forceinline__ void hyena_channel(int c, cf* Z, const cf* TW, const bf16_t* HYT, const bf16_t* KT,
                                              const float* conv_w, const float* conv_b, const float* hbias,
                                              cf* Hs, cf* Z1S, bf16_t* HYOT, const int tid) {
    {
        const bf16_t* f0 = KT + (size_t)(0 * 1024 + 0 * 512 + c) * SEQ; const bf16_t* f1 = KT + (size_t)(0 * 1024 + 1 * 512 + c) * SEQ;
        const bf16_t* g0 = KT + (size_t)(1 * 1024 + 0 * 512 + c) * SEQ; const bf16_t* g1 = KT + (size_t)(1 * 1024 + 1 * 512 + c) * SEQ;
#pragma unroll 2
        for (int i = 0; i < 16; ++i) { const int n = tid + 512 * i;
            Z[phys(n)] = make_float2(bf2f(f0[n]), bf2f(f1[n]));
            Z[phys(L + n)] = (n == 0) ? make_float2(0.f, 0.f) : make_float2(bf2f(g0[L - n]), bf2f(g1[L - n])); }
        __syncthreads();
        fft_fwd(Z, TW, tid);
        const float sc = 0.5f / (float)N;
#pragma unroll 2
        for (int i = 0; i < 32; ++i) { const int pos = tid + 512 * i;
            const int k = (pos >> 10) + (((pos >> 6) & 15) << 4) + (((pos >> 2) & 15) << 8) + ((pos & 3) << 12);
            const int k2 = (N - k) & (N - 1);
            const int pos2 = ((k2 & 15) << 10) + (((k2 >> 4) & 15) << 6) + (((k2 >> 8) & 15) << 2) + (k2 >> 12);
            const cf F = Z[phys(pos)], G = Z[phys(pos2)];
            Hs[pos] = make_float2((F.x + G.x) * sc, (F.y - G.y) * sc);
            Hs[N + pos] = make_float2((F.y + G.y) * sc, (G.x - F.x) * sc); }
        __syncthreads();
    }
    const float* cw = conv_w; const float* cbv = conv_b;
    const float w00 = cw[0 * 1536 + c], w01 = cw[1 * 1536 + c], w02 = cw[2 * 1536 + c], cb0 = cbv[c];
    const float w10 = cw[0 * 1536 + 512 + c], w11 = cw[1 * 1536 + 512 + c], w12 = cw[2 * 1536 + 512 + c], cb1 = cbv[512 + c];
    const float w20 = cw[0 * 1536 + 1024 + c], w21 = cw[1 * 1536 + 1024 + c], w22 = cw[2 * 1536 + 1024 + c], cb2 = cbv[1024 + c];
    const float bias0 = hbias[c], bias1 = hbias[512 + c];
    const bf16_t* r0 = HYT + (size_t)c * T; const bf16_t* r1 = HYT + (size_t)(512 + c) * T; const bf16_t* r2 = HYT + (size_t)(1024 + c) * T;
#pragma unroll 2
    for (int i = 0; i < 16; ++i) { const int s = tid + 512 * i;
        Z[phys(s)] = make_float2(conv3(r0, 0, s, w00, w01, w02, cb0), conv3(r0, 1, s, w00, w01, w02, cb0));
        Z[phys(L + s)] = make_float2(0.f, 0.f); }
    __syncthreads();
    fft_conv(Z, TW, Hs, tid);
#pragma unroll 2
    for (int i = 0; i < 16; ++i) { const int s = tid + 512 * i;
        const cf y = Z[phys(s)];
        const float za = conv3(r0, 0, s, w00, w01, w02, cb0), zb = conv3(r0, 1, s, w00, w01, w02, cb0);
        const float xa = conv3(r1, 0, s, w10, w11, w12, cb1), xb = conv3(r1, 1, s, w10, w11, w12, cb1);
        const cf z1 = make_float2(xa * (y.x + za * bias0), xb * (y.y + zb * bias0));
        Z[phys(s)] = z1; Z[phys(L + s)] = make_float2(0.f, 0.f); Z1S[s] = z1; }
    __syncthreads();
    fft_conv(Z, TW, Hs + N, tid);
#pragma unroll 2
    for (int i = 0; i < 16; ++i) { const int s = tid + 512 * i;
        const cf y = Z[phys(s)]; const cf z1 = Z1S[s];
        const float xa = conv3(r2, 0, s, w20, w21, w22, cb2), xb = conv3(r2, 1, s, w20, w21, w22, cb2);
        const float oa = xa * (y.x + z1.x * bias1), ob = xb * (y.y + z1.y * bias1);
        HYOT[(size_t)c * T + s] = (bf16_t)(pg8::cvt_pk_bf16(oa, 0.f) & 0xffffu);
        HYOT[(size_t)c * T + SEQ + s] = (bf16_t)(pg8::cvt_pk_bf16(ob, 0.f) & 0xffffu); }
    __syncthreads();
}
}

#define GAS __attribute__((address_space(1)))
#define LAS __attribute__((address_space(3)))
typedef unsigned short bf16;
typedef unsigned v4u __attribute__((ext_vector_type(4)));
typedef unsigned v2u __attribute__((ext_vector_type(2)));
typedef float f32x4 __attribute__((ext_vector_type(4)));
constexpr int NWAVES = 8, NTHR = 512;
constexpr size_t MiB = 1u << 20;
constexpr size_t WS_SSQQ = 0, WS_SSQKV = 64 * 1024, WS_MOD = 128 * 1024  , WS_MODP = 256 * 1024  ;
constexpr size_t WS_TW = 2 * MiB;
constexpr size_t WS_CS = 3 * MiB;
constexpr size_t WS_WTIN = 5 * MiB;
constexpr size_t WS_WTO = 9 * MiB;
constexpr size_t WS_WTQB = 11 * MiB;
constexpr size_t WS_WTKVB = 11 * MiB + 512 * 1024;
constexpr size_t WS_WT3 = 12 * MiB;
constexpr size_t WS_H2 = 13 * MiB;
constexpr size_t WS_AFF = 15 * MiB;
constexpr size_t WS_IDX = 16 * MiB;
constexpr size_t WS_GATE = 16 * MiB + 128 * 1024;
constexpr size_t WS_STATS = 16 * MiB + 256 * 1024;
constexpr size_t WS_INV = 17 * MiB;
constexpr size_t WS_U1 = 18 * MiB;
constexpr size_t WS_HYOT = 18 * MiB;
constexpr size_t WS_AATT = 34 * MiB;
constexpr size_t WS_MIXED = 18 * MiB;
constexpr size_t WS_HYT = 50 * MiB;
constexpr size_t WS_APRIME = 50 * MiB;
constexpr size_t WS_XE = 50 * MiB;
constexpr size_t WS_YE = 50 * MiB;
constexpr size_t WS_KT = 98 * MiB;
constexpr size_t WS_CQ = 130 * MiB;
constexpr size_t WS_CKV = 138 * MiB;
constexpr size_t WS_KRR = 142 * MiB;
constexpr size_t WS_KR = 144 * MiB;
constexpr size_t WS_FFTS = 146 * MiB;
constexpr size_t FFTS_PER_WG = 320 * 1024;
constexpr size_t WS_WTGU = 114 * MiB;
constexpr size_t WS_WTD = 178 * MiB;
constexpr size_t WS_U2 = 210 * MiB;
constexpr size_t WS_HB = 210 * MiB;
constexpr size_t WS_Q = 226 * MiB;
constexpr size_t WS_KV = 250 * MiB;
constexpr size_t WS_END = 282 * MiB;
constexpr int LDS_BYTES = 148 * 1024;

struct Params {
    const float* x; const float* c; const int* positions; const float* w_ada; const float* b_ada; const float* w_in; const float* q_norm_g; const float* w_qb;
    const float* kv_norm_g; const float* w_kvb; const float* conv_w; const float* conv_b; const float* filt_w1; const float* filt_b1; const float* filt_freq;
    const float* filt_w2; const float* filt_b2; const float* filt_w3; const float* filt_b3; const float* hyena_decay; const float* hyena_bias;
    const float* attn_out_g; const float* hyena_out_g; const float* w_o; const float* ln1_g; const float* ln1_b; const float* w_router;
    const float* w_gate; const float* w_up; const float* w_down; const float* ln2_g; const float* ln2_b;
    float* out; unsigned char* ws;
};

__device__ __forceinline__ unsigned f2bf(float f) { unsigned u = __builtin_bit_cast(unsigned, f); return (u + 0x7fffu + ((u >> 16) & 1u)) >> 16; }
__device__ __forceinline__ unsigned pk2(float lo, float hi) { return pg8::cvt_pk_bf16(lo, hi); }
__device__ __forceinline__ float bf_lo(unsigned w) { return __uint_as_float(w << 16); }
__device__ __forceinline__ float bf_hi(unsigned w) { return __uint_as_float(w & 0xffff0000u); }
__device__ __forceinline__ float wave_sum(float v) {
#pragma unroll
    for (int o = 1; o < 64; o <<= 1) v += __shfl_xor(v, o);
    return v;
}
struct Ctx { int tid, lane, wave, vcu, G, gw, NGW; unsigned char* lds; };

__device__ __forceinline__ void transpose_item(const float* __restrict__ W, int ldw, int N, bf16* WT, int ldk, int nmul, int nadd, const float* __restrict__ kscale, float* scr, int item, int lane) {
    const int nblk = N / 32, kb = item / nblk, nb = item % nblk, k0 = 64 * kb, n0 = 32 * nb;
#pragma unroll 8
    for (int i = 0; i < 32; ++i) { const int kk = 2 * i + (lane >> 5); float v = W[(size_t)(k0 + kk) * ldw + n0 + (lane & 31)]; if (kscale) v *= kscale[k0 + kk]; scr[kk * 33 + (lane & 31)] = v; }
    asm volatile("s_waitcnt lgkmcnt(0)" ::: "memory");
    const int c = lane & 7;
#pragma unroll
    for (int j = 0; j < 4; ++j) { const int n = (lane >> 3) + 8 * j; const float* s = scr + (8 * c) * 33 + n;
        v4u o; o.x = pk2(s[0 * 33], s[1 * 33]); o.y = pk2(s[2 * 33], s[3 * 33]); o.z = pk2(s[4 * 33], s[5 * 33]); o.w = pk2(s[6 * 33], s[7 * 33]);
        *(v4u*)(WT + (size_t)((n0 + n) * nmul + nadd) * ldk + k0 + 8 * c) = o; }
    asm volatile("s_waitcnt lgkmcnt(0)" ::: "memory");
}

__device__ __forceinline__ void phase0(const Params& P, const Ctx& X) {
    unsigned char* ws = P.ws;
    const int gt = X.vcu * NTHR + X.tid, NGT = X.G * NTHR;
    for (int i = gt; i < 2 * T; i += NGT) ((float*)(ws + WS_SSQQ))[i] = 0.f;
    for (int k = gt; k < NFFT; k += NGT) { float s, c; sincospif(2.0f * (float)k / (float)NFFT, &s, &c); ((float2*)(ws + WS_TW))[k] = make_float2(c, -s); }
    for (int i = gt; i < T * 16; i += NGT) { const int t = i >> 4, f = i & 15; const double inv = pow(10000.0, -(double)f / 16.0); const double ang = (double)P.positions[t] * inv;
        ((float2*)(ws + WS_CS))[i] = make_float2((float)cos(ang), (float)sin(ang)); }
    for (int i = gt; i < 96 * 1024 / 8; i += NGT) ((v4u*)(ws + WS_WTIN + (size_t)IN_COLS * 1024 * 2))[i] = (v4u){0u, 0u, 0u, 0u};
    for (int i = gt; i < 2048 * 8; i += NGT) { const int r = i >> 3, cc = i & 7; ((v4u*)(ws + WS_WT3 + (size_t)r * 256 + 128))[cc] = (v4u){0u, 0u, 0u, 0u}; }
    for (int i = gt; i < 8192 * 8; i += NGT) { const int r = i >> 3, cc = i & 7; ((v4u*)(ws + WS_H2 + (size_t)r * 256 + 128))[cc] = (v4u){0u, 0u, 0u, 0u}; }
    float* scr = (float*)(X.lds + X.wave * 16384);
    {
        constexpr int I_IN = (1024 / 64) * (IN_COLS / 32), I_O = 16 * 32, I_QB = (256 / 64) * (768 / 32), I_KVB = (128 / 64) * (1024 / 32), I_3 = 1 * (2048 / 32);
        constexpr int NIT = I_IN + I_O + I_QB + I_KVB + I_3;
        for (int it = X.gw; it < NIT; it += X.NGW) {
            int r = it;
            if (r < I_IN) { transpose_item(P.w_in, IN_COLS, IN_COLS, (bf16*)(ws + WS_WTIN), 1024, 1, 0, nullptr, scr, r, X.lane); continue; } r -= I_IN;
            if (r < I_O) { transpose_item(P.w_o, 1024, 1024, (bf16*)(ws + WS_WTO), 1024, 1, 0, nullptr, scr, r, X.lane); continue; } r -= I_O;
            if (r < I_QB) { transpose_item(P.w_qb, 768, 768, (bf16*)(ws + WS_WTQB), 256, 1, 0, P.q_norm_g, scr, r, X.lane); continue; } r -= I_QB;
            if (r < I_KVB) { transpose_item(P.w_kvb, 1024, 1024, (bf16*)(ws + WS_WTKVB), 128, 1, 0, P.kv_norm_g, scr, r, X.lane); continue; } r -= I_KVB;
            transpose_item(P.filt_w3, 2048, 2048, (bf16*)(ws + WS_WT3), 128, 1, 0, nullptr, scr, r, X.lane);
        }
    }
    for (int l = X.gw; l < SEQ; l += X.NGW) {
        const int j = X.lane;
        float feat;
        { const float pos = (float)l; const int i = j;
          if (i == 0) feat = pos / (float)(SEQ - 1);
          else if (i <= 32) { const int kk = (i - 1) & 15; const float fk = 1e-4f + (float)kk * ((15.0f - 1e-4f) / 15.0f);
              const float ph = (6.283185307179586f / (float)SEQ) * pos * fk; feat = (i <= 16) ? cosf(ph) : -sinf(ph); }
          else feat = 0.f; }
        float a = P.filt_b1[j];
#pragma unroll
        for (int i = 0; i < FEMB; ++i) a += __shfl(feat, i) * P.filt_w1[i * 64 + j];
        const float fr = P.filt_freq[j];
        const float h1 = sinf(fr * a);
        float b2 = P.filt_b2[j];
#pragma unroll 8
        for (int i = 0; i < 64; ++i) b2 += __shfl(h1, i) * P.filt_w2[i * 64 + j];
        const float h2 = sinf(fr * b2);
        ((bf16*)(ws + WS_H2))[(size_t)l * 128 + j] = (bf16)f2bf(h2);
    }
    for (int it = X.gw; it < 32 * 24; it += X.NGW) {
        const int kc = it / 24, nc = it % 24, n = nc * 256 + X.lane * 4;
        f32x4 a0 = {0.f, 0.f, 0.f, 0.f}, a1 = {0.f, 0.f, 0.f, 0.f};
#pragma unroll 8
        for (int kk = 0; kk < 32; ++kk) { const int k = kc * 32 + kk; const f32x4 w = *(const f32x4*)(P.w_ada + (size_t)k * 6144 + n);
            const float c0 = P.c[k], c1 = P.c[1024 + k]; const float s0 = c0 / (1.f + __expf(-c0)), s1 = c1 / (1.f + __expf(-c1));
            a0 += w * s0; a1 += w * s1; }
        float* mp = (float*)(ws + WS_MODP);
        *(f32x4*)(mp + ((size_t)kc * 2 + 0) * 6144 + n) = a0; *(f32x4*)(mp + ((size_t)kc * 2 + 1) * 6144 + n) = a1;
    }
}

__device__ __forceinline__ void phase1(const Params& P, const Ctx& X) {
    unsigned char* ws = P.ws;
    float* modl = (float*)X.lds;
    const float* mp = (const float*)(ws + WS_MODP);
    for (int i = X.tid; i < 4096; i += NTHR) { const int b = i >> 11, n = i & 2047;
        float s = P.b_ada[n];
        for (int kc = 0; kc < 32; ++kc) s += mp[((size_t)kc * 2 + b) * 6144 + n];
        modl[i] = s; }
    if (blockIdx.x == 0) {
        for (int i = X.tid; i < 2 * 6144; i += NTHR) { const int b = i / 6144, n = i % 6144;
            float s = P.b_ada[n];
            for (int kc = 0; kc < 32; ++kc) s += mp[((size_t)kc * 2 + b) * 6144 + n];
            ((float*)(ws + WS_MOD))[i] = s; }
    }
    __syncthreads();
    for (int m = X.gw; m < T; m += X.NGW) {
        const int b = m / SEQ; const float* sh = modl + b * 2048; const float* sc = sh + 1024;
        const f32x4* xr = (const f32x4*)(P.x + (size_t)m * DM) + X.lane;
        unsigned long long* o8 = (unsigned long long*)(ws + WS_U1 + (size_t)m * DM * 2) + X.lane;
#pragma unroll
        for (int j = 0; j < 4; ++j) { const f32x4 v = xr[64 * j]; const int c0 = 4 * X.lane + 256 * j;
            const float u0 = v.x * (1.f + sc[c0]) + sh[c0], u1 = v.y * (1.f + sc[c0 + 1]) + sh[c0 + 1], u2 = v.z * (1.f + sc[c0 + 2]) + sh[c0 + 2], u3 = v.w * (1.f + sc[c0 + 3]) + sh[c0 + 3];
            o8[64 * j] = (unsigned long long)pk2(u0, u1) | ((unsigned long long)pk2(u2, u3) << 32); }
    }
    __syncthreads();
}

__device__ __forceinline__ void krope_pass(const Params& P, const Ctx& X) {
    unsigned char* ws = P.ws;
    const int gt = X.vcu * NTHR + X.tid, NGT = X.G * NTHR;
    const float* krr = (const float*)(ws + WS_KRR); const float2* cs = (const float2*)(ws + WS_CS); bf16* kr = (bf16*)(ws + WS_KR);
    for (int i = gt; i < T * 16; i += NGT) { const int t = i >> 4, f = i & 15;
        const float x1 = krr[t * 32 + f], x2 = krr[t * 32 + 16 + f]; const float2 c = cs[i];
        kr[t * 32 + f] = (bf16)f2bf(x1 * c.x - x2 * c.y); kr[t * 32 + 16 + f] = (bf16)f2bf(x2 * c.x + x1 * c.y); }
}

__device__ __forceinline__ void phase5(const Params& P, const Ctx& X) {
    unsigned char* ws = P.ws;
    const bf16* hyot = (const bf16*)(ws + WS_HYOT); const bf16* aatt = (const bf16*)(ws + WS_AATT); bf16* ap = (bf16*)(ws + WS_APRIME);
    float* red = (float*)X.lds;
    for (int tile = X.vcu; tile < T / 64; tile += X.G) {
        const int t0 = tile * 64;
        { const int tl = X.tid & 63, cgp = X.tid >> 6; float v[64]; float ss = 0.f;
#pragma unroll
          for (int i = 0; i < 64; ++i) { v[i] = __uint_as_float(((unsigned)hyot[(size_t)(cgp * 64 + i) * T + t0 + tl]) << 16); ss += v[i] * v[i]; }
          red[cgp * 64 + tl] = ss;
          __syncthreads();
          float tot = 0.f;
#pragma unroll
          for (int g = 0; g < 8; ++g) tot += red[g * 64 + tl];
          const float rs = __builtin_amdgcn_rsqf(tot * (1.0f / 512.0f) + EPS);
          const float* gg = P.hyena_out_g + cgp * 64;
          v4u* dst = (v4u*)(ap + (size_t)(t0 + tl) * DM + 512 + cgp * 64);
#pragma unroll
          for (int i = 0; i < 8; ++i) { v4u o; o.x = pk2(v[8 * i] * rs * gg[8 * i], v[8 * i + 1] * rs * gg[8 * i + 1]); o.y = pk2(v[8 * i + 2] * rs * gg[8 * i + 2], v[8 * i + 3] * rs * gg[8 * i + 3]);
              o.z = pk2(v[8 * i + 4] * rs * gg[8 * i + 4], v[8 * i + 5] * rs * gg[8 * i + 5]); o.w = pk2(v[8 * i + 6] * rs * gg[8 * i + 6], v[8 * i + 7] * rs * gg[8 * i + 7]); dst[i] = o; }
          __syncthreads(); }
        for (int r = X.wave; r < 64; r += NWAVES) { const int t = t0 + r;
            const v4u w = *(const v4u*)(aatt + (size_t)t * 512 + X.lane * 8);
            float f[8] = {bf_lo(w.x), bf_hi(w.x), bf_lo(w.y), bf_hi(w.y), bf_lo(w.z), bf_hi(w.z), bf_lo(w.w), bf_hi(w.w)};
            float ss = 0.f;
#pragma unroll
            for (int i = 0; i < 8; ++i) ss += f[i] * f[i];
            ss = wave_sum(ss);
            const float rs = __builtin_amdgcn_rsqf(ss * (1.0f / 512.0f) + EPS);
            const float* gg = P.attn_out_g + X.lane * 8;
            v4u o; o.x = pk2(f[0] * rs * gg[0], f[1] * rs * gg[1]); o.y = pk2(f[2] * rs * gg[2], f[3] * rs * gg[3]); o.z = pk2(f[4] * rs * gg[4], f[5] * rs * gg[5]); o.w = pk2(f[6] * rs * gg[6], f[7] * rs * gg[7]);
            *(v4u*)(ap + (size_t)t * DM + X.lane * 8) = o; }
    }
}

__device__ __forceinline__ void load_y1(const Params& P, const unsigned char* ws, int m, int lane, const float* mod_b, f32x4 (&y)[4]) {
    const f32x4* xr = (const f32x4*)(P.x + (size_t)m * DM) + lane;
    const v2u* mr = (const v2u*)(ws + WS_MIXED + (size_t)m * DM * 2) + lane;
    const float* g1 = mod_b + 2 * 1024;
#pragma unroll
    for (int j = 0; j < 4; ++j) { const f32x4 xv = xr[64 * j]; const v2u mw = mr[64 * j]; const f32x4 gv = *(const f32x4*)(g1 + 4 * lane + 256 * j);
        y[j].x = DN_ALPHA * xv.x + gv.x * bf_lo(mw.x); y[j].y = DN_ALPHA * xv.y + gv.y * bf_hi(mw.x); y[j].z = DN_ALPHA * xv.z + gv.z * bf_lo(mw.y); y[j].w = DN_ALPHA * xv.w + gv.w * bf_hi(mw.y); }
}
__device__ __forceinline__ void phase7(const Params& P, const Ctx& X) {
    unsigned char* ws = P.ws;
    float* wr = (float*)X.lds;
    for (int i = X.tid; i < 1024 * 16 / 4; i += NTHR) ((f32x4*)wr)[i] = ((const f32x4*)P.w_router)[i];
    __syncthreads();
    const float* mod = (const float*)(ws + WS_MOD);
    for (int m = X.gw; m < T; m += X.NGW) {
        const int b = m / SEQ; const float* mb = mod + b * 6144;
        f32x4 y[4]; load_y1(P, ws, m, X.lane, mb, y);
        float s = 0.f;
#pragma unroll
        for (int j = 0; j < 4; ++j) s += (y[j].x + y[j].y) + (y[j].z + y[j].w);
        const float mean = wave_sum(s) * (1.0f / DM); float s2 = 0.f;
#pragma unroll
        for (int j = 0; j < 4; ++j) { y[j] = y[j] - mean; s2 += (y[j].x * y[j].x + y[j].y * y[j].y) + (y[j].z * y[j].z + y[j].w * y[j].w); }
        const float rstd = 1.0f / sqrtf(wave_sum(s2) * (1.0f / DM) + EPS);
        if (X.lane == 0) ((float2*)(ws + WS_STATS))[m] = make_float2(mean, rstd);
        float lg[16];
#pragma unroll
        for (int e = 0; e < 16; ++e) lg[e] = 0.f;
        unsigned long long* o8 = (unsigned long long*)(ws + WS_U2 + (size_t)m * DM * 2) + X.lane;
#pragma unroll
        for (int j = 0; j < 4; ++j) { const int c0 = 4 * X.lane + 256 * j;
            const f32x4 g = *(const f32x4*)(P.ln1_g + c0), bb = *(const f32x4*)(P.ln1_b + c0), sh = *(const f32x4*)(mb + 3 * 1024 + c0), sc = *(const f32x4*)(mb + 4 * 1024 + c0);
            f32x4 u; u = (y[j] * rstd * g + bb); u = u * (sc + 1.0f) + sh;
            o8[64 * j] = (unsigned long long)pk2(u.x, u.y) | ((unsigned long long)pk2(u.z, u.w) << 32);
#pragma unroll
            for (int q = 0; q < 4; ++q) { const float uv = u[q]; const f32x4* wq = (const f32x4*)(wr + (size_t)(c0 + q) * 16);
#pragma unroll
                for (int e4 = 0; e4 < 4; ++e4) { const f32x4 w = wq[e4]; lg[4 * e4] += uv * w.x; lg[4 * e4 + 1] += uv * w.y; lg[4 * e4 + 2] += uv * w.z; lg[4 * e4 + 3] += uv * w.w; } } }
#pragma unroll
        for (int e = 0; e < 16; ++e) lg[e] = wave_sum(lg[e]);
        float mx = lg[0];
#pragma unroll
        for (int e = 1; e < 16; ++e) mx = fmaxf(mx, lg[e]);
        float den = 0.f;
#pragma unroll
        for (int e = 0; e < 16; ++e) { lg[e] = expf(lg[e] - mx); den += lg[e]; }
        const float rden = 1.0f / den;
        float mine = 0.f;
#pragma unroll
        for (int e = 0; e < 16; ++e) if (X.lane == e) mine = lg[e] * rden;
        if (X.lane < 16) ((float*)(ws + WS_AFF))[(size_t)m * 16 + X.lane] = mine;
    }
    __syncthreads();
}

__device__ __forceinline__ void topk_be(const Params& P, const Ctx& X, int be) {
    unsigned char* ws = P.ws;
    const int b = be >> 4, e = be & 15;
    unsigned long long* keys = (unsigned long long*)X.lds;
    const float* aff = (const float*)(ws + WS_AFF);
    for (int s = X.tid; s < SEQ; s += NTHR) { const unsigned u = __float_as_uint(aff[((size_t)b * SEQ + s) * 16 + e]);
        keys[s] = ((unsigned long long)(~u) << 32) | (unsigned)s; }
    __syncthreads();
    for (int k = 2; k <= SEQ; k <<= 1)
        for (int j = k >> 1; j > 0; j >>= 1) {
            for (int i = X.tid; i < SEQ / 2; i += NTHR) {
                const int lo = ((i & ~(j - 1)) << 1) | (i & (j - 1)), hi = lo | j;
                const unsigned long long a = keys[lo], c = keys[hi];
                const bool up = ((lo & k) == 0);
                if ((a > c) == up) { keys[lo] = c; keys[hi] = a; }
            }
            __syncthreads();
        }
    int* idx = (int*)(ws + WS_IDX) + be * CAP; float* gate = (float*)(ws + WS_GATE) + be * CAP; int* inv = (int*)(ws + WS_INV);
    for (int r = X.tid; r < SEQ; r += NTHR) { const unsigned long long kk = keys[r]; const int s = (int)(unsigned)kk; const float g = __uint_as_float(~(unsigned)(kk >> 32));
        if (r < CAP) { idx[r] = s; gate[r] = g; }
        inv[((size_t)b * SEQ + s) * 16 + e] = (r < CAP) ? r : -1; }
    __syncthreads();
}
__device__ __forceinline__ void expert_weight_copies(const Params& P, const Ctx& X, int wg_rel, int nwg) {
    unsigned char* ws = P.ws;
    float* scr = (float*)(X.lds + X.wave * 16384);
    constexpr int I_E = (1024 / 64) * (1024 / 32);
    const int gw = wg_rel * NWAVES + X.wave, ngw = nwg * NWAVES;
    for (int it = gw; it < 48 * I_E; it += ngw) {
        const int mat = it / I_E, r = it % I_E, e = mat / 3, which = mat % 3;
        if (which == 0) transpose_item(P.w_gate + (size_t)e * 1048576, 1024, 1024, (bf16*)(ws + WS_WTGU) + (size_t)e * 2048 * 1024, 1024, 2, 0, nullptr, scr, r, X.lane);
        else if (which == 1) transpose_item(P.w_up + (size_t)e * 1048576, 1024, 1024, (bf16*)(ws + WS_WTGU) + (size_t)e * 2048 * 1024, 1024, 2, 1, nullptr, scr, r, X.lane);
        else transpose_item(P.w_down + (size_t)e * 1048576, 1024, 1024, (bf16*)(ws + WS_WTD) + (size_t)e * 1024 * 1024, 1024, 1, 0, nullptr, scr, r, X.lane);
    }
}

__device__ __forceinline__ void phase9(const Params& P, const Ctx& X) {
    unsigned char* ws = P.ws;
    const int* idx = (const int*)(ws + WS_IDX);
    for (int r = X.gw; r < 32 * CAP; r += X.NGW) { const int b = r >> 14; const int s = idx[r];
        const v4u* src = (const v4u*)(ws + WS_U2 + ((size_t)b * SEQ + s) * DM * 2) + X.lane; v4u* dst = (v4u*)(ws + WS_XE + (size_t)r * DM * 2) + X.lane;
        dst[0] = src[0]; dst[64] = src[64]; }
}

__device__ __forceinline__ void phase12(const Params& P, const Ctx& X) {
    unsigned char* ws = P.ws;
    const float* mod = (const float*)(ws + WS_MOD); const int* inv = (const int*)(ws + WS_INV);
    for (int m = X.gw; m < T; m += X.NGW) {
        const int b = m / SEQ; const float* mb = mod + b * 6144;
        f32x4 y[4]; load_y1(P, ws, m, X.lane, mb, y);
        const float2 st = ((const float2*)(ws + WS_STATS))[m];
        f32x4 f[4];
#pragma unroll
        for (int j = 0; j < 4; ++j) f[j] = (f32x4){0.f, 0.f, 0.f, 0.f};
        const int myinv = (X.lane < 16) ? inv[(size_t)m * 16 + X.lane] : -1;
        for (int e = 0; e < 16; ++e) { const int sl = __shfl(myinv, e);
            if (sl >= 0) { const v2u* yr = (const v2u*)(ws + WS_YE + ((size_t)(b * 16 + e) * CAP + sl) * DM * 2) + X.lane;
#pragma unroll
                for (int j = 0; j < 4; ++j) { const v2u w = yr[64 * j]; f[j].x += bf_lo(w.x); f[j].y += bf_hi(w.x); f[j].z += bf_lo(w.y); f[j].w += bf_hi(w.y); } } }
        float s = 0.f;
#pragma unroll
        for (int j = 0; j < 4; ++j) { const int c0 = 4 * X.lane + 256 * j;
            const f32x4 g = *(const f32x4*)(P.ln1_g + c0), bb = *(const f32x4*)(P.ln1_b + c0), g2 = *(const f32x4*)(mb + 5 * 1024 + c0);
            const f32x4 x1 = (y[j] - st.x) * st.y * g + bb;
            y[j] = x1 * DN_ALPHA + g2 * f[j];
            s += (y[j].x + y[j].y) + (y[j].z + y[j].w); }
        const float mean = wave_sum(s) * (1.0f / DM); float s2 = 0.f;
#pragma unroll
        for (int j = 0; j < 4; ++j) { y[j] = y[j] - mean; s2 += (y[j].x * y[j].x + y[j].y * y[j].y) + (y[j].z * y[j].z + y[j].w * y[j].w); }
        const float rstd = 1.0f / sqrtf(wave_sum(s2) * (1.0f / DM) + EPS);
        f32x4* orow = (f32x4*)(P.out + (size_t)m * DM) + X.lane;
#pragma unroll
        for (int j = 0; j < 4; ++j) { const int c0 = 4 * X.lane + 256 * j; const f32x4 g = *(const f32x4*)(P.ln2_g + c0), bb = *(const f32x4*)(P.ln2_b + c0);
            orow[64 * j] = y[j] * rstd * g + bb; }
    }
}

#ifndef DBG_LAST_PHASE
#define DBG_LAST_PHASE 99
#endif
typedef const __attribute__((address_space(4))) Params* KParams;
__device__ __forceinline__ KParams launder_kp(KParams p) { asm volatile("" : "+s"(p)); return p; }
__device__ __forceinline__ Params load_params(KParams p) { Params r{};
#if defined(__HIP_DEVICE_COMPILE__)
    r = *launder_kp(p);
#endif
    return r; }
#define LOADP() const Params P = load_params(kp); unsigned char* ws = P.ws; MKCTX()
__global__ void __launch_bounds__(NTHR, 2) fwd_megakernel(Params Pv) {
    extern __shared__ __attribute__((aligned(16))) unsigned char lds[];
    cg::grid_group grid = cg::this_grid();
    const int wave0 = __builtin_amdgcn_readfirstlane(threadIdx.x >> 6);
#define MKCTX() Ctx X; { int w_ = wave0; asm volatile("" : "+s"(w_)); X.wave = w_; unsigned m_ = ~0u; asm volatile("" : "+s"(m_)); X.lane = __builtin_amdgcn_mbcnt_hi(m_, __builtin_amdgcn_mbcnt_lo(m_, 0u)); X.tid = w_ * 64 + X.lane; \
    X.G = gridDim.x; const int bx_ = blockIdx.x; X.vcu = (X.G % 8 == 0) ? (bx_ % 8) * (X.G / 8) + bx_ / 8 : bx_; X.gw = X.vcu * NWAVES + X.wave; X.NGW = X.G * NWAVES; X.lds = lds; }
    KParams kp = (KParams)__builtin_amdgcn_kernarg_segment_ptr();
    PG8_LAS unsigned char* ring = (PG8_LAS unsigned char*)lds;

    { LOADP(); (void)ws; phase0(P, X); }
    grid.sync();
    { LOADP(); (void)ws; phase1(P, X); }
    grid.sync();
    { LOADP();
        { pg8::Gemm g{(const pg8::bf16_t*)(ws + WS_U1), (const pg8::bf16_t*)(ws + WS_WTIN), T, IN_PAD, 1024, 1024, 1024, 1 << 30, 1, 0};
          pg8::StaticOrder S; S.init(T, IN_PAD, X.G, (int)blockIdx.x);
          epi::EpiIn E{(pg8::bf16_t*)(ws + WS_CQ), (pg8::bf16_t*)(ws + WS_CKV), (float*)(ws + WS_KRR), (pg8::bf16_t*)(ws + WS_HYT), (float*)(ws + WS_SSQQ), (float*)(ws + WS_SSQKV)};
          pg8::gemm_phase<epi::EpiIn, pg8::StaticOrder, true, true>(ring, g, S, E, X.tid); }
        __syncthreads();
        { pg8::Gemm g{(const pg8::bf16_t*)(ws + WS_H2), (const pg8::bf16_t*)(ws + WS_WT3), SEQ, 2048, 128, 128, 128, 1 << 30, 1, 0};
          pg8::StaticOrder S; S.init(SEQ, 2048, X.G, (int)blockIdx.x);
          epi::EpiFilt E{(pg8::bf16_t*)(ws + WS_KT), P.filt_b3, P.hyena_decay};
          pg8::gemm_phase<epi::EpiFilt, pg8::StaticOrder, true, true>(ring, g, S, E, X.tid); }
    }
    grid.sync();
    { LOADP();
        { pg8::Gemm g{(const pg8::bf16_t*)(ws + WS_CQ), (const pg8::bf16_t*)(ws + WS_WTQB), T, 768, 256, 256, 256, 1 << 30, 1, 0};
          pg8::StaticOrder S; S.init(T, 768, X.G, (int)blockIdx.x);
          epi::EpiRowScale E{(pg8::bf16_t*)(ws + WS_Q), 768, (const float*)(ws + WS_SSQQ), 1.0f / 256.0f};
          pg8::gemm_phase<epi::EpiRowScale, pg8::StaticOrder, true, true>(ring, g, S, E, X.tid); }
        __syncthreads();
        { pg8::Gemm g{(const pg8::bf16_t*)(ws + WS_CKV), (const pg8::bf16_t*)(ws + WS_WTKVB), T, 1024, 128, 128, 128, 1 << 30, 1, 0};
          pg8::StaticOrder S; S.init(T, 1024, X.G, (int)blockIdx.x);
          epi::EpiRowScale E{(pg8::bf16_t*)(ws + WS_KV), 1024, (const float*)(ws + WS_SSQKV), 1.0f / 128.0f};
          pg8::gemm_phase<epi::EpiRowScale, pg8::StaticOrder, true, true>(ring, g, S, E, X.tid); }
        __syncthreads();
        krope_pass(P, X);
        for (int c = X.vcu; c < HW; c += X.G) {
            unsigned char* fs = ws + WS_FFTS + (size_t)blockIdx.x * FFTS_PER_WG;
            hy::hyena_channel(c, (hy::cf*)lds, (const hy::cf*)(ws + WS_TW), (const hy::bf16_t*)(ws + WS_HYT), (const hy::bf16_t*)(ws + WS_KT), P.conv_w, P.conv_b, P.hyena_bias,
                              (hy::cf*)fs, (hy::cf*)(fs + 256 * 1024), (hy::bf16_t*)(ws + WS_HYOT), X.tid);
        }
    }
    grid.sync();
    { LOADP();
        for (int u = X.vcu; u < BATCH * NH * (SEQ / 256); u += X.G) {
            const int bh = u >> 5, qb = u & 31, b = bh >> 3, h = bh & 7;
            attn::attn_unit((const attn::bf16_t*)(ws + WS_Q), (const attn::bf16_t*)(ws + WS_KV), (const attn::bf16_t*)(ws + WS_KR), (const float*)(ws + WS_CS),
                            (attn::bf16_t*)(ws + WS_AATT), h, (long)b * SEQ + qb * 256, (long)b * SEQ, SEQ, (char*)lds, X.tid);
        }
    }
    grid.sync();
    { LOADP(); (void)ws; phase5(P, X); }
    grid.sync();
    { LOADP();
        pg8::Gemm g{(const pg8::bf16_t*)(ws + WS_APRIME), (const pg8::bf16_t*)(ws + WS_WTO), T, 1024, 1024, 1024, 1024, 1 << 30, 1, 0};
        pg8::StaticOrder S; S.init(T, 1024, X.G, (int)blockIdx.x);
        epi::EpiRowScale E{(pg8::bf16_t*)(ws + WS_MIXED), 1024, nullptr, 0.f};
        pg8::gemm_phase<epi::EpiRowScale, pg8::StaticOrder, true, true>(ring, g, S, E, X.tid);
    }
    grid.sync();
    { LOADP(); (void)ws; phase7(P, X); }
    grid.sync();
    { LOADP();
        if (X.G >= 64) { if (blockIdx.x < 32) topk_be(P, X, blockIdx.x); else expert_weight_copies(P, X, blockIdx.x - 32, X.G - 32); }
        else { for (int be = blockIdx.x; be < 32; be += X.G) topk_be(P, X, be); expert_weight_copies(P, X, blockIdx.x, X.G); }
    }
    grid.sync();
    { LOADP(); (void)ws; phase9(P, X); }
    grid.sync();
    { LOADP();
        pg8::Gemm g{(const pg8::bf16_t*)(ws + WS_XE), (const pg8::bf16_t*)(ws + WS_WTGU), 32 * CAP, 2048, 1024, 1024, 1024, 4, 16, (size_t)2048 * 1024 * 2};
        pg8::StaticOrder S; S.init(32 * CAP, 2048, X.G, (int)blockIdx.x);
        epi::EpiGU E{(pg8::bf16_t*)(ws + WS_HB)};
        pg8::gemm_phase<epi::EpiGU, pg8::StaticOrder, true, true>(ring, g, S, E, X.tid);
    }
    grid.sync();
    { LOADP();
        pg8::Gemm g{(const pg8::bf16_t*)(ws + WS_HB), (const pg8::bf16_t*)(ws + WS_WTD), 32 * CAP, 1024, 1024, 1024, 1024, 4, 16, (size_t)1024 * 1024 * 2};
        pg8::StaticOrder S; S.init(32 * CAP, 1024, X.G, (int)blockIdx.x);
        epi::EpiDown E{(pg8::bf16_t*)(ws + WS_YE), (const float*)(ws + WS_GATE)};
        pg8::gemm_phase<epi::EpiDown, pg8::StaticOrder, true, true>(ring, g, S, E, X.tid);
    }
    grid.sync();
    { LOADP(); (void)ws; phase12(P, X); }
}

extern "C" void kernel_launch(void* const* d_in, const int* in_sizes, int n_in, void* d_out, int out_size, void* d_ws, size_t ws_size, hipStream_t stream) {
    static int grid = 0;
    if (grid == 0) {
        if (n_in != 32 || in_sizes[0] != T * DM || out_size != T * DM || ws_size < WS_END) {
            fprintf(stderr, "kernel_launch: unexpected shapes: n_in %d in0 %d out %d ws %zu (need >= %zu)\n", n_in, n_in > 0 ? in_sizes[0] : -1, out_size, ws_size, (size_t)WS_END); grid = -1; return; }
        int dev = 0, cus = 0, per_cu = 0;
        hipGetDevice(&dev); hipDeviceGetAttribute(&cus, hipDeviceAttributeMultiprocessorCount, dev);
        if (hipFuncSetAttribute((const void*)fwd_megakernel, hipFuncAttributeMaxDynamicSharedMemorySize, LDS_BYTES) != hipSuccess) { fprintf(stderr, "kernel_launch: hipFuncSetAttribute failed\n"); grid = -1; return; }
        if (hipOccupancyMaxActiveBlocksPerMultiprocessor(&per_cu, (const void*)fwd_megakernel, NTHR, LDS_BYTES) != hipSuccess || per_cu < 1) { fprintf(stderr, "kernel_launch: occupancy query failed (%d)\n", per_cu); (void)hipGetLastError(); per_cu = 1; }
        grid = cus * 1;
        fprintf(stderr, "kernel_launch: cus %d per_cu %d grid %d ws %zu\n", cus, per_cu, grid, ws_size);
    }
    if (grid < 0) return;
    Params p{};
    const float** pf = (const float**)&p;
    p.x = (const float*)d_in[0]; p.c = (const float*)d_in[1]; p.positions = (const int*)d_in[2];
    p.w_ada = (const float*)d_in[3]; p.b_ada = (const float*)d_in[4]; p.w_in = (const float*)d_in[5]; p.q_norm_g = (const float*)d_in[6]; p.w_qb = (const float*)d_in[7];
    p.kv_norm_g = (const float*)d_in[8]; p.w_kvb = (const float*)d_in[9]; p.conv_w = (const float*)d_in[10]; p.conv_b = (const float*)d_in[11];
    p.filt_w1 = (const float*)d_in[12]; p.filt_b1 = (const float*)d_in[13]; p.filt_freq = (const float*)d_in[14]; p.filt_w2 = (const float*)d_in[15]; p.filt_b2 = (const float*)d_in[16];
    p.filt_w3 = (const float*)d_in[17]; p.filt_b3 = (const float*)d_in[18]; p.hyena_decay = (const float*)d_in[19]; p.hyena_bias = (const float*)d_in[20];
    p.attn_out_g = (const float*)d_in[21]; p.hyena_out_g = (const float*)d_in[22]; p.w_o = (const float*)d_in[23]; p.ln1_g = (const float*)d_in[24]; p.ln1_b = (const float*)d_in[25];
    p.w_router = (const float*)d_in[26]; p.w_gate = (const float*)d_in[27]; p.w_up = (const float*)d_in[28]; p.w_down = (const float*)d_in[29]; p.ln2_g = (const float*)d_in[30]; p.ln2_b = (const float*)d_in[31];
    p.out = (float*)d_out; p.ws = (unsigned char*)d_ws; (void)pf;
    void* args[] = {&p};
    hipError_t e = hipLaunchCooperativeKernel((const void*)fwd_megakernel, dim3(grid), dim3(NTHR), args, LDS_BYTES, stream);
    if (e != hipSuccess) fprintf(stderr, "kernel_launch: cooperative launch failed: %s (grid %d)\n", hipGetErrorString(e), grid);
}
```

```cpp
#include <hip/hip_runtime.h>
#include <hip/hip_cooperative_groups.h>
#include <hip/hip_bf16.h>
#include <cstdio>
#include <cstdint>
#include <cmath>
namespace cg = cooperative_groups;

constexpr int BATCH = 2, SEQ = 8192, DM = 1024, T = BATCH * SEQ;
constexpr int NH = 8, QKD = 96, VD = 64, NOPE = 64, ROPE = 32;
constexpr int QLR = 256, KVLR = 128;
constexpr int HW = 512;
constexpr int IN_COLS = 1952, IN_PAD = 2048;
constexpr int NEXP = 16, CAP = 1024, EFF = 1024;
constexpr int FEMB = 33, FORD = 64;
constexpr float EPS = 1e-5f;
constexpr float DN_ALPHA = 1.189207115002721f;
constexpr int NFFT = 2 * SEQ;

namespace pg8 {
#define PG8_LAS __attribute__((address_space(3)))
typedef unsigned short bf16_t;
typedef short bf16x8 __attribute__((ext_vector_type(8)));
typedef float f32x4 __attribute__((ext_vector_type(4)));
typedef unsigned u32x4 __attribute__((ext_vector_type(4)));
constexpr int BM = 256, BK = 64, HALF = 128, HTB = HALF * BK * 2  , STAGE_BYTES = 8 * HTB, NXCD = 8, WGM = 8;

__host__ __device__ __forceinline__ int lds_byte(int r, int c) { const int st = (r >> 4) * 2 + (c >> 5), rr = r & 15, cc = c & 31, ob = rr * 64 + cc * 2; return st * 1024 + (ob ^ (((ob >> 9) & 1) << 5)); }
__host__ __device__ __forceinline__ void stage_rc(int b, int& R, int& C) { const int st = b / 1024, sb = b % 1024, swz = sb ^ (((sb >> 9) & 1) << 5); R = (st >> 1) * 16 + swz / 64; C = (st & 1) * 32 + (swz % 64) / 2; }
__host__ __device__ __forceinline__ int perm32(int rho) { const int n = rho >> 4, i = rho & 15; return 8 * (i >> 2) + 4 * n + (i & 3); }

struct Unit { int pm, pn; };
struct Gemm { const bf16_t* A; const bf16_t* Bt; int M, N, K; int lda, ldb; int pm_per_grp, grp_mod; size_t b_grp_bytes; const int* gidx; int g_shift, g_src; };

struct StaticOrder {
    int nM, nN, nwg, G, c, wgm;
    __host__ __device__ void init(int M, int N, int G_, int c_, int wgm_ = WGM) { nM = M / BM; nN = N / BM; nwg = nM * nN; G = G_; c = c_; wgm = wgm_; }
    __host__ __device__ bool next(int i, Unit& u) const {
        const long L = (long)i * G + c; if (L >= nwg) return false;
        int wgid = (int)L; { const int q = nwg / NXCD, r = nwg % NXCD, xcd = wgid % NXCD, off = wgid / NXCD; wgid = (xcd < r ? xcd * (q + 1) : r * (q + 1) + (xcd - r) * q) + off; }
        const int nig = wgm * nN, gid = wgid / nig, fm = gid * wgm, gsz = (nM - fm) < wgm ? (nM - fm) : wgm;
        u.pm = fm + ((wgid % nig) % gsz); u.pn = (wgid % nig) / gsz; return true;
    }
    __device__ __forceinline__ void a_ready(const Unit&) const {}
    __device__ __forceinline__ void done(const Unit&) const {}
};

__device__ __forceinline__ unsigned cvt_pk_bf16(float lo, float hi) { unsigned r; asm volatile("v_cvt_pk_bf16_f32 %0, %1, %2" : "=v"(r) : "v"(lo), "v"(hi)); return r; }
typedef float f32x2 __attribute__((ext_vector_type(2)));
__device__ __forceinline__ f32x2 gelu_pk(f32x2 v) {
    const f32x2 av = __builtin_elementwise_abs(v), d = av * 0.2316418882f + 1.0f;
    f32x2 t; t.x = __builtin_amdgcn_rcpf(d.x); t.y = __builtin_amdgcn_rcpf(d.y);
    f32x2 q = t * 0.5307027145f + (-0.7265760135f); q = q * t + 0.7107068705f; q = q * t + (-0.142248368f); q = q * t + 0.127414796f; q = q * t;
    const f32x2 s = (v * v) * (-0.72134752044f);
    f32x2 e; e.x = __builtin_amdgcn_exp2f(s.x); e.y = __builtin_amdgcn_exp2f(s.y);
    const f32x2 m = v * (q * e), r = v - m;
    f32x2 o; o.x = v.x < 0.f ? m.x : r.x; o.y = v.y < 0.f ? m.y : r.y; return o;
}

template <int ACT  > struct EpiBf16 {
    static constexpr bool PERM = true, AFTER_DRAIN = false; static_assert(ACT == 0 || ACT == 1, "EpiBf16: ACT is 0 (none) or 1 (gelu_pk)");
    bf16_t* O; int ldc; const float* bias; int split_cols; size_t split_stride; float scale0;
    __device__ __forceinline__ void operator()(const f32x4 (&acc)[2][2][4][2], const Unit& u, int wr, int wc, int fr, int fq) const {
        const int row0 = u.pm * BM + wr * 64 + fr; int colt = u.pn * BM; bf16_t* base = O;
        float sc = 1.f; if (split_cols) { const int t = colt / split_cols; base += (size_t)t * split_stride; colt -= t * split_cols; if (t == 0) sc = scale0; }
        const int col0 = colt + wc * 32 + 8 * fq, bcol0 = u.pn * BM + wc * 32 + 8 * fq;
        f32x4 bv[2][2];
#pragma unroll
        for (int bj = 0; bj < 2; ++bj)
#pragma unroll
            for (int n = 0; n < 2; ++n) bv[bj][n] = bias ? *(const f32x4*)(bias + bcol0 + bj * HALF + 4 * n) : (f32x4){0.f, 0.f, 0.f, 0.f};
#pragma unroll
        for (int ai = 0; ai < 2; ++ai)
#pragma unroll
            for (int m = 0; m < 4; ++m) { bf16_t* rowp = base + (size_t)(row0 + ai * HALF + m * 16) * ldc + col0;
#pragma unroll
                for (int bj = 0; bj < 2; ++bj) { f32x4 v0 = acc[ai][bj][m][0] + bv[bj][0], v1 = acc[ai][bj][m][1] + bv[bj][1];
                    if (ACT == 1) { f32x2 a = gelu_pk((f32x2){v0[0], v0[1]}), b = gelu_pk((f32x2){v0[2], v0[3]}), c = gelu_pk((f32x2){v1[0], v1[1]}), d = gelu_pk((f32x2){v1[2], v1[3]});
                        v0 = (f32x4){a.x, a.y, b.x, b.y}; v1 = (f32x4){c.x, c.y, d.x, d.y}; }
                    v0 = v0 * sc; v1 = v1 * sc; u32x4 w; w.x = cvt_pk_bf16(v0[0], v0[1]); w.y = cvt_pk_bf16(v0[2], v0[3]); w.z = cvt_pk_bf16(v1[0], v1[1]); w.w = cvt_pk_bf16(v1[2], v1[3]);
                    *(u32x4*)(rowp + bj * HALF) = w; } }
    }
};

struct PanelStats {
    unsigned* xbuf;
    unsigned* cnt;
    unsigned* tmo;
    int ntn; float eps;
    unsigned code;
    __device__ __forceinline__ bool run(const f32x4 (&v)[2][2][4][2], const Unit& u, int wr, int wc, int fr, int fq, PG8_LAS unsigned char* lds, int wid, int lane) const {
        typedef float f32x2v __attribute__((ext_vector_type(2)));
        PG8_LAS f32x2v* P = (PG8_LAS f32x2v*)lds;
        PG8_LAS f32x2v* S = (PG8_LAS f32x2v*)(lds + 8192);
        PG8_LAS unsigned* flag = (PG8_LAS unsigned*)(lds + 8192 + 2048);
#pragma unroll
        for (int ai = 0; ai < 2; ++ai)
#pragma unroll
            for (int m = 0; m < 4; ++m) {
                float s = 0.f;
#pragma unroll
                for (int bj = 0; bj < 2; ++bj)
#pragma unroll
                    for (int n = 0; n < 2; ++n) { const f32x4 x = v[ai][bj][m][n]; s += (x[0] + x[1]) + (x[2] + x[3]); }
                s += __shfl_xor(s, 16); s += __shfl_xor(s, 32);
                const float mw = s * (1.0f / 64.0f); float q = 0.f;
#pragma unroll
                for (int bj = 0; bj < 2; ++bj)
#pragma unroll
                    for (int n = 0; n < 2; ++n) { const f32x4 d = v[ai][bj][m][n] - mw; q += (d[0] * d[0] + d[1] * d[1]) + (d[2] * d[2] + d[3] * d[3]); }
                q += __shfl_xor(q, 16); q += __shfl_xor(q, 32);
                if (fq == 0) P[(ai * HALF + wr * 64 + m * 16 + fr) * 4 + wc] = (f32x2v){mw, q};
            }
        asm volatile("s_waitcnt lgkmcnt(0)" ::: "memory"); __builtin_amdgcn_s_barrier(); asm volatile("" ::: "memory");
#if defined(BROKEN_EXCHANGE_NO_WAIT)
#warning BROKEN CONTROL BUILD: the row-statistics exchange does not wait; results are wrong by design
        if (blockIdx.x >= 64) { const long long t0_ = clock64(); while (clock64() - t0_ < 60000) __builtin_amdgcn_s_sleep(8); }
#endif
        const int row = wid * 32 + (lane & 31);
        if (lane < 32) {
            const f32x2v a = P[row * 4 + 0], b = P[row * 4 + 1], c = P[row * 4 + 2], d = P[row * 4 + 3];
            const float mt = (a.x + b.x + c.x + d.x) * 0.25f;
            const float da = a.x - mt, db = b.x - mt, dc = c.x - mt, dd = d.x - mt;
            const float m2 = (a.y + b.y) + (c.y + d.y) + 64.0f * ((da * da + db * db) + (dc * dc + dd * dd));
            unsigned long long* slot = (unsigned long long*)xbuf + ((size_t)(u.pm * BM + row) * 4 + u.pn);
            __hip_atomic_store(slot, ((unsigned long long)__float_as_uint(m2) << 32) | __float_as_uint(mt), __ATOMIC_RELAXED, __HIP_MEMORY_SCOPE_AGENT);
        }
        asm volatile("s_waitcnt vmcnt(0)" ::: "memory");
        if (lane == 0) __hip_atomic_fetch_add(cnt + 64 * u.pm, 1u, __ATOMIC_RELAXED, __HIP_MEMORY_SCOPE_AGENT);
        if (wid == 0) {
            bool dead = false; const unsigned long long t0 = __builtin_amdgcn_s_memrealtime(); const unsigned want = 8u * (unsigned)ntn;
            for (;;) {
#if defined(BROKEN_EXCHANGE_NO_WAIT)
                break;
#endif
                if ((unsigned)__builtin_amdgcn_readfirstlane(__hip_atomic_load(cnt + 64 * u.pm, __ATOMIC_RELAXED, __HIP_MEMORY_SCOPE_AGENT)) >= want) break;
                if (__builtin_amdgcn_s_memrealtime() - t0 > 2000000ull) {
                    if (lane == 0) { unsigned expect = 0u; __hip_atomic_compare_exchange_strong(tmo + 1, &expect, code | (unsigned)(u.pm & 0xff), __ATOMIC_RELAXED, __ATOMIC_RELAXED, __HIP_MEMORY_SCOPE_AGENT);
                                     __hip_atomic_store(tmo, 1u, __ATOMIC_RELAXED, __HIP_MEMORY_SCOPE_AGENT); }
                    dead = true; break; }
                __builtin_amdgcn_s_sleep(2);
            }
            __builtin_amdgcn_fence(__ATOMIC_ACQUIRE, "agent");
            if (lane == 0) flag[0] = dead ? 1u : 0u;
        }
        asm volatile("s_waitcnt vmcnt(0) lgkmcnt(0)" ::: "memory"); __builtin_amdgcn_s_barrier(); asm volatile("" ::: "memory");
        const bool bad = flag[0] != 0u;
        if (lane < 32) {
            const unsigned long long* slot = (const unsigned long long*)xbuf + (size_t)(u.pm * BM + row) * 4; float mt[4], m2[4]; float ms = 0.f;
#pragma unroll
            for (int t = 0; t < 4; ++t) { if (t < ntn) { const unsigned long long w = __hip_atomic_load(slot + t, __ATOMIC_RELAXED, __HIP_MEMORY_SCOPE_AGENT); mt[t] = __uint_as_float((unsigned)w); m2[t] = __uint_as_float((unsigned)(w >> 32)); } else { mt[t] = 0.f; m2[t] = 0.f; } ms += mt[t]; }
            const float mean = ms / (float)ntn; float q = 0.f;
#pragma unroll
            for (int t = 0; t < 4; ++t) if (t < ntn) { const float dm = mt[t] - mean; q += m2[t] + 256.0f * dm * dm; }
            S[row] = (f32x2v){mean, 1.0f / sqrtf(q / (256.0f * (float)ntn) + eps)};
        }
        asm volatile("s_waitcnt lgkmcnt(0)" ::: "memory"); __builtin_amdgcn_s_barrier(); asm volatile("" ::: "memory");
        return bad;
    }
};
struct EpiLnRes {
    static constexpr bool PERM = false, AFTER_DRAIN = true;
    const float* base; float* out; int ldc; const float* bias; PanelStats st; unsigned poison;
    __device__ __forceinline__ void fused(f32x4 (&acc)[2][2][4][2], const Unit& u, int wr, int wc, int fr, int fq, PG8_LAS unsigned char* lds, int wid, int lane) const {
        typedef float f32x2v __attribute__((ext_vector_type(2)));
        const PG8_LAS f32x2v* S = (const PG8_LAS f32x2v*)(lds + 8192);
        const int col0 = u.pn * BM + wc * 32 + 4 * fq;
#pragma unroll
        for (int bj = 0; bj < 2; ++bj)
#pragma unroll
            for (int n = 0; n < 2; ++n) { const f32x4 bv = bias ? *(const f32x4*)(bias + col0 + bj * HALF + n * 16) : (f32x4){0.f, 0.f, 0.f, 0.f};
#pragma unroll
                for (int ai = 0; ai < 2; ++ai)
#pragma unroll
                    for (int m = 0; m < 4; ++m) acc[ai][bj][m][n] += bv; }
        f32x4 pre[4][2][2];
#pragma unroll
        for (int m = 0; m < 4; ++m) { const size_t off = (size_t)(u.pm * BM + wr * 64 + m * 16 + fr) * ldc + col0;
#pragma unroll
            for (int bj = 0; bj < 2; ++bj)
#pragma unroll
                for (int n = 0; n < 2; ++n) pre[m][bj][n] = *(const f32x4*)(base + off + bj * HALF + n * 16); }
        const bool bad = st.run(acc, u, wr, wc, fr, fq, lds, wid, lane) || poison != 0u;
        const float qnan = __builtin_nanf("");
#pragma unroll
        for (int ai = 0; ai < 2; ++ai)
#pragma unroll
            for (int m = 0; m < 4; ++m) { const int r = ai * HALF + wr * 64 + m * 16 + fr; const f32x2v sr = S[r]; const size_t off = (size_t)(u.pm * BM + r) * ldc + col0;
#pragma unroll
                for (int bj = 0; bj < 2; ++bj)
#pragma unroll
                    for (int n = 0; n < 2; ++n) { const f32x4 bs = ai == 0 ? pre[m][bj][n] : *(const f32x4*)(base + off + bj * HALF + n * 16); f32x4 o = bs + (acc[ai][bj][m][n] - sr.x) * sr.y;
                        if (bad) o = (f32x4){qnan, qnan, qnan, qnan}; *(f32x4*)(out + off + bj * HALF + n * 16) = o; }
                if (m & 1) asm volatile("" ::: "memory"); }
    }
};
struct EpiLnResLn {
    static constexpr bool PERM = false, AFTER_DRAIN = true;
    const float* base; float* out; bf16_t* xn; int ldc; const float* bias; PanelStats st1, st2; unsigned poison;
    __device__ __forceinline__ void fused(f32x4 (&acc)[2][2][4][2], const Unit& u, int wr, int wc, int fr, int fq, PG8_LAS unsigned char* lds, int wid, int lane) const {
        typedef float f32x2v __attribute__((ext_vector_type(2))); typedef unsigned u32x2v __attribute__((ext_vector_type(2)));
        const PG8_LAS f32x2v* S = (const PG8_LAS f32x2v*)(lds + 8192);
        const int col0 = u.pn * BM + wc * 32 + 4 * fq;
#pragma unroll
        for (int bj = 0; bj < 2; ++bj)
#pragma unroll
            for (int n = 0; n < 2; ++n) { const f32x4 bv = bias ? *(const f32x4*)(bias + col0 + bj * HALF + n * 16) : (f32x4){0.f, 0.f, 0.f, 0.f};
#pragma unroll
                for (int ai = 0; ai < 2; ++ai)
#pragma unroll
                    for (int m = 0; m < 4; ++m) acc[ai][bj][m][n] += bv; }
        bool bad = st1.run(acc, u, wr, wc, fr, fq, lds, wid, lane) || poison != 0u;
        const float qnan = __builtin_nanf("");
#pragma unroll
        for (int ai = 0; ai < 2; ++ai)
#pragma unroll
            for (int m = 0; m < 4; ++m) { const int r = ai * HALF + wr * 64 + m * 16 + fr; const f32x2v sr = S[r]; const size_t off = (size_t)(u.pm * BM + r) * ldc + col0;
#pragma unroll
                for (int bj = 0; bj < 2; ++bj)
#pragma unroll
                    for (int n = 0; n < 2; ++n) { const f32x4 bs = *(const f32x4*)(base + off + bj * HALF + n * 16); acc[ai][bj][m][n] = bs + (acc[ai][bj][m][n] - sr.x) * sr.y; }
                asm volatile("" : "+v"(acc[ai][0][m][0]), "+v"(acc[ai][0][m][1]), "+v"(acc[ai][1][m][0]), "+v"(acc[ai][1][m][1]));
                if (m & 1) asm volatile("" ::: "memory"); }
        const bool bad1 = bad;
        bad = st2.run(acc, u, wr, wc, fr, fq, lds, wid, lane) || bad;
#pragma unroll
        for (int ai = 0; ai < 2; ++ai)
#pragma unroll
            for (int m = 0; m < 4; ++m) { const int r = ai * HALF + wr * 64 + m * 16 + fr; const f32x2v sr = S[r]; const size_t off = (size_t)(u.pm * BM + r) * ldc + col0;
#pragma unroll
                for (int bj = 0; bj < 2; ++bj)
#pragma unroll
                    for (int n = 0; n < 2; ++n) { const f32x4 x1 = acc[ai][bj][m][n]; *(f32x4*)(out + off + bj * HALF + n * 16) = bad1 ? (f32x4){qnan, qnan, qnan, qnan} : x1;
                        const f32x4 o = (x1 - sr.x) * sr.y; u32x2v w; w.x = cvt_pk_bf16(o[0], o[1]); w.y = cvt_pk_bf16(o[2], o[3]);
                        if (bad) { w.x = 0x7fc07fc0u; w.y = 0x7fc07fc0u; } *(u32x2v*)(xn + off + bj * HALF + n * 16) = w; }
                asm volatile("" ::: "memory"); }
    }
};

template <class Epi, class Sched, bool ALIGN_EPI = false, bool SP2 = false, bool GATHER = false>
__device__ __forceinline__ void gemm_phase(PG8_LAS unsigned char* lds, const Gemm g, const Sched& S, const Epi& E, const int tid) {
    const int  wid = __builtin_amdgcn_readfirstlane(tid >> 6), lane = tid & 63, wr = wid >> 2, wc = wid & 3, fr = lane & 15, fq = lane >> 4;
    const int K = g.K, nt = K / BK;
    unsigned voffA[2], voffB[2]; int Rr[2], Cc[2];
#pragma unroll
    for (int i = 0; i < 2; ++i) { int R, C; stage_rc(tid * 16 + i * 8192, R, C); const int Rb = Epi::PERM ? ((R & ~31) + perm32(R & 31)) : R; Rr[i] = R; Cc[i] = C;
        voffA[i] = (unsigned)(R * g.lda + C) * 2u; voffB[i] = (unsigned)(Rb * g.ldb + C) * 2u; }
    unsigned gvC[2][2] = {{0u, 0u}, {0u, 0u}}, gvN[2][2] = {{0u, 0u}, {0u, 0u}};
#define PG8_GV(dst, un) do { _Pragma("unroll") for (int _h = 0; _h < 2; ++_h) _Pragma("unroll") for (int _i = 0; _i < 2; ++_i) { const int _r = (un).pm * BM + _h * HALF + Rr[_i]; \
        dst[_h][_i] = (unsigned)(((_r >> g.g_shift) * g.g_src + g.gidx[_r]) * g.lda + Cc[_i]) * 2u; } } while (0)
#define PG8_STAGE_A(bufoff, gbase, h, usenext) do { if constexpr (GATHER) { _Pragma("unroll") for (int _i = 0; _i < 2; ++_i) { const unsigned _vo = (usenext) ? gvN[h][_i] : gvC[h][_i]; \
        __builtin_amdgcn_global_load_lds((const unsigned*)((const char*)(gbase) + _vo), (PG8_LAS unsigned*)(lds + (bufoff) + ldsw + _i * 8192), 16, 0, 0); } } \
        else { PG8_STAGE(bufoff, (gbase) + (h) * hstepA, voffA); } } while (0)
    const size_t kstep = (size_t)(BK * 2);
    const size_t hstepA = (size_t)HALF * g.lda * 2, hstepB = (size_t)HALF * g.ldb * 2;
    const size_t tstepA = 2 * hstepA, tstepB = 2 * hstepB;
    const unsigned ldsw = (unsigned)wid * 1024u;
    const int aoff = lds_byte(wr * 64 + fr, fq * 8), boff = lds_byte(wc * 32 + fr, fq * 8);
#define PG8_SA(b, h) (((b) * 2 + (h)) * HTB)
#define PG8_SB(b, h) ((4 + (b) * 2 + (h)) * HTB)
#define PG8_STAGE(bufoff, gbase, voff) do { _Pragma("unroll") for (int _i = 0; _i < 2; ++_i) \
        __builtin_amdgcn_global_load_lds((const unsigned*)((const char*)(gbase) + (voff)[_i]), (PG8_LAS unsigned*)(lds + (bufoff) + ldsw + _i * 8192), 16, 0, 0); } while (0)
#define PG8_LDA(dst, b, h) do { _Pragma("unroll") for (int m = 0; m < 4; ++m) _Pragma("unroll") for (int k = 0; k < 2; ++k) dst[m][k] = *(const PG8_LAS bf16x8*)(lds + PG8_SA(b, h) + aoff + m * 2048 + k * 1024); } while (0)
#define PG8_LDB(dst, b, h) do { _Pragma("unroll") for (int n = 0; n < 2; ++n) _Pragma("unroll") for (int k = 0; k < 2; ++k) dst[n][k] = *(const PG8_LAS bf16x8*)(lds + PG8_SB(b, h) + boff + n * 2048 + k * 1024); } while (0)
#define PG8_MMA(ai, bj, At, Bt) do { __builtin_amdgcn_s_setprio(1); _Pragma("unroll") for (int m = 0; m < 4; ++m) _Pragma("unroll") for (int n = 0; n < 2; ++n) _Pragma("unroll") for (int k = 0; k < 2; ++k) \
        acc[ai][bj][m][n] = __builtin_amdgcn_mfma_f32_16x16x32_bf16(Bt[n][k], At[m][k], acc[ai][bj][m][n], 0, 0, 0); __builtin_amdgcn_s_setprio(0); } while (0)
#define PG8_WAIT_V(n) asm volatile("s_waitcnt vmcnt(" #n ")" ::: "memory")
#define PG8_WAIT_L(n) asm volatile("s_waitcnt lgkmcnt(" #n ")" ::: "memory")
#define PG8_BAR __builtin_amdgcn_s_barrier()
#define PG8_SCHED __builtin_amdgcn_sched_barrier(0)
    Unit cur, nxt; int ui = 0;
    if (!S.next(0, cur)) return;
    f32x4 acc[2][2][4][2];
#pragma unroll
    for (int a = 0; a < 2; ++a)
#pragma unroll
        for (int b = 0; b < 2; ++b)
#pragma unroll
            for (int m = 0; m < 4; ++m)
#pragma unroll
                for (int n = 0; n < 2; ++n) acc[a][b][m][n] = (f32x4){0.f, 0.f, 0.f, 0.f};
    bf16x8 At[4][2], B0[2][2], B1[2][2];
    const char* cA = (const char*)g.A + (GATHER ? (size_t)0 : (size_t)cur.pm * tstepA); if constexpr (GATHER) { PG8_GV(gvC, cur); }
    const char* cB = (const char*)g.Bt + (size_t)((cur.pm / g.pm_per_grp) % g.grp_mod) * g.b_grp_bytes + (size_t)cur.pn * tstepB;
    S.a_ready(cur);
    if constexpr (SP2) {
        PG8_STAGE(PG8_SB(0, 0), cB, voffB); PG8_STAGE(PG8_SB(0, 1), cB + hstepB, voffB); PG8_STAGE_A(PG8_SA(0, 0), cA, 0, false); PG8_STAGE_A(PG8_SA(0, 1), cA, 1, false);
        if (wr == 1) PG8_BAR;
        PG8_WAIT_V(2); PG8_BAR;
        PG8_STAGE(PG8_SB(1, 0), cB + kstep, voffB); PG8_STAGE_A(PG8_SA(1, 0), cA + kstep, 0, false); PG8_STAGE(PG8_SB(1, 1), cB + hstepB + kstep, voffB);
        PG8_WAIT_V(6); PG8_BAR;
    } else {
        PG8_STAGE(PG8_SB(0, 0), cB, voffB); PG8_STAGE_A(PG8_SA(0, 0), cA, 0, false); PG8_STAGE(PG8_SB(0, 1), cB + hstepB, voffB); PG8_STAGE_A(PG8_SA(0, 1), cA, 1, false);
        if (wr == 1) PG8_BAR;
        PG8_WAIT_V(4); PG8_BAR;
        PG8_STAGE(PG8_SB(1, 0), cB + kstep, voffB); PG8_STAGE_A(PG8_SA(1, 0), cA + kstep, 0, false); PG8_STAGE(PG8_SB(1, 1), cB + hstepB + kstep, voffB);
        PG8_WAIT_V(6); PG8_BAR;
    }
    for (;;) {
        const bool has_next = S.next(ui + 1, nxt);
        const char* nA = (has_next && !GATHER) ? (const char*)g.A + (size_t)nxt.pm * tstepA : cA;
        if constexpr (GATHER) { if (has_next) { PG8_GV(gvN, nxt); } else { _Pragma("unroll") for (int _h = 0; _h < 2; ++_h) _Pragma("unroll") for (int _i = 0; _i < 2; ++_i) gvN[_h][_i] = gvC[_h][_i]; } }
        const char* nB = has_next ? (const char*)g.Bt + (size_t)((nxt.pm / g.pm_per_grp) % g.grp_mod) * g.b_grp_bytes + (size_t)nxt.pn * tstepB : cB;
        for (int t = 0; t < nt; t += 2) {
            const bool last = (t == nt - 2);
            const char* a1 = cA + (size_t)(t + 1) * kstep;
            const char* a2 = last ? nA : cA + (size_t)(t + 2) * kstep; const char* b2 = last ? nB : cB + (size_t)(t + 2) * kstep;
            const char* a3 = a2 + kstep; const char* b3 = b2 + kstep;
            if (last && has_next) S.a_ready(nxt);
            if constexpr (SP2) {
            PG8_LDB(B0, 0, 0); PG8_LDB(B1, 0, 1); PG8_SCHED; PG8_LDA(At, 0, 0); PG8_STAGE_A(PG8_SA(1, 1), a1, 1, false);
            PG8_WAIT_V(8); PG8_WAIT_L(0); PG8_BAR; PG8_MMA(0, 0, At, B0); PG8_MMA(0, 1, At, B1); PG8_BAR; PG8_SCHED;
            PG8_LDA(At, 0, 1); PG8_STAGE(PG8_SB(0, 0), b2, voffB); PG8_STAGE(PG8_SB(0, 1), b2 + hstepB, voffB); PG8_STAGE_A(PG8_SA(0, 0), a2, 0, last);
            PG8_WAIT_V(8); PG8_WAIT_L(0); PG8_BAR; PG8_MMA(1, 0, At, B0); PG8_MMA(1, 1, At, B1); PG8_BAR; PG8_SCHED;
            PG8_LDB(B0, 1, 0); PG8_LDB(B1, 1, 1); PG8_SCHED; PG8_LDA(At, 1, 0); PG8_STAGE_A(PG8_SA(0, 1), a2, 1, last);
            PG8_WAIT_V(8); PG8_WAIT_L(0); PG8_BAR; PG8_MMA(0, 0, At, B0); PG8_MMA(0, 1, At, B1); PG8_BAR; PG8_SCHED;
            PG8_LDA(At, 1, 1); PG8_STAGE(PG8_SB(1, 0), b3, voffB); PG8_STAGE(PG8_SB(1, 1), b3 + hstepB, voffB); PG8_STAGE_A(PG8_SA(1, 0), a3, 0, last);
            PG8_WAIT_V(8); PG8_WAIT_L(0); PG8_BAR; PG8_MMA(1, 0, At, B0); PG8_MMA(1, 1, At, B1); PG8_BAR; PG8_SCHED;
            } else {
            PG8_LDB(B0, 0, 0); PG8_SCHED; PG8_LDA(At, 0, 0); PG8_STAGE_A(PG8_SA(1, 1), a1, 1, false);
            PG8_WAIT_L(8); PG8_BAR; PG8_WAIT_L(0); PG8_MMA(0, 0, At, B0); PG8_BAR; PG8_SCHED;
            PG8_LDB(B1, 0, 1); PG8_STAGE(PG8_SB(0, 0), b2, voffB);
            PG8_BAR; PG8_WAIT_L(0); PG8_MMA(0, 1, At, B1); PG8_BAR;
            PG8_LDA(At, 0, 1); PG8_STAGE_A(PG8_SA(0, 0), a2, 0, last);
            PG8_BAR; PG8_WAIT_L(0); PG8_MMA(1, 0, At, B0); PG8_BAR; PG8_SCHED;
            PG8_STAGE(PG8_SB(0, 1), b2 + hstepB, voffB);
            PG8_WAIT_V(6); PG8_BAR; PG8_MMA(1, 1, At, B1); PG8_BAR;
            PG8_LDB(B0, 1, 0); PG8_SCHED; PG8_LDA(At, 1, 0); PG8_STAGE_A(PG8_SA(0, 1), a2, 1, last);
            PG8_WAIT_L(8); PG8_BAR; PG8_WAIT_L(0); PG8_MMA(0, 0, At, B0); PG8_BAR; PG8_SCHED;
            PG8_LDB(B1, 1, 1); PG8_STAGE(PG8_SB(1, 0), b3, voffB);
            PG8_BAR; PG8_WAIT_L(0); PG8_MMA(0, 1, At, B1); PG8_BAR;
            PG8_LDA(At, 1, 1); PG8_STAGE_A(PG8_SA(1, 0), a3, 0, last);
            PG8_BAR; PG8_WAIT_L(0); PG8_MMA(1, 0, At, B0); PG8_BAR; PG8_SCHED;
            PG8_STAGE(PG8_SB(1, 1), b3 + hstepB, voffB);
            PG8_WAIT_V(6); PG8_BAR; PG8_MMA(1, 1, At, B1); PG8_BAR;
            }
        }
        if constexpr (ALIGN_EPI) { if (wr == 0) PG8_BAR; }
        if constexpr (!Epi::AFTER_DRAIN) { E(acc, cur, wr, wc, fr, fq); S.done(cur); }
        if (!has_next) break;
#pragma unroll
        for (int a = 0; a < 2; ++a)
#pragma unroll
            for (int b = 0; b < 2; ++b)
#pragma unroll
                for (int m = 0; m < 4; ++m)
#pragma unroll
                    for (int n = 0; n < 2; ++n) acc[a][b][m][n] = (f32x4){0.f, 0.f, 0.f, 0.f};
        cur = nxt; cA = nA; cB = nB; ++ui;
        if constexpr (GATHER) { _Pragma("unroll") for (int _h = 0; _h < 2; ++_h) _Pragma("unroll") for (int _i = 0; _i < 2; ++_i) gvC[_h][_i] = gvN[_h][_i]; }
        if constexpr (ALIGN_EPI) { if (wr == 1) PG8_BAR; }
    }
    PG8_WAIT_V(0);
    if constexpr (!ALIGN_EPI) { if (wr == 0) PG8_BAR; }
    PG8_BAR;
    if constexpr (Epi::AFTER_DRAIN) { E.fused(acc, cur, wr, wc, fr, fq, lds, wid, lane); S.done(cur); }
#undef PG8_SA
#undef PG8_SB
#undef PG8_STAGE
#undef PG8_STAGE_A
#undef PG8_GV
#undef PG8_LDA
#undef PG8_LDB
#undef PG8_MMA
#undef PG8_WAIT_V
#undef PG8_WAIT_L
#undef PG8_BAR
#undef PG8_SCHED
}
}

namespace epi {
using pg8::f32x4; using pg8::u32x4; using pg8::Unit; using pg8::bf16_t; using pg8::cvt_pk_bf16; using pg8::HALF; using pg8::BM;
typedef unsigned u32x2 __attribute__((ext_vector_type(2)));

struct EpiIn {
    static constexpr bool PERM = false, AFTER_DRAIN = false;
    bf16_t* cq; bf16_t* ckv; float* krr; bf16_t* hyT; float* ssq_q; float* ssq_kv; PG8_LAS unsigned char* stg;
    __device__ __forceinline__ void operator()(const f32x4 (&acc)[2][2][4][2], const Unit& u, int wr, int wc, int fr, int fq) const {
        PG8_LAS unsigned char* ws_ = stg + (wr * 4 + wc) * 2304; const int lane = fr + 16 * fq;
#pragma unroll
        for (int ai = 0; ai < 2; ++ai)
#pragma unroll
            for (int bj = 0; bj < 2; ++bj)
#pragma unroll
                for (int n = 0; n < 2; ++n) {
                    const int cg = u.pn * BM + bj * HALF + wc * 32 + n * 16;
                    if (cg >= 416 && cg < IN_COLS) {
#pragma unroll
                        for (int m = 0; m < 4; ++m) { const f32x4 v = acc[ai][bj][m][n]; const unsigned w0 = cvt_pk_bf16(v[0], v[1]), w1 = cvt_pk_bf16(v[2], v[3]);
                            PG8_LAS unsigned char* p = ws_ + (4 * fq) * 144 + (16 * m + fr) * 2;
                            *(PG8_LAS unsigned short*)(p) = (unsigned short)(w0 & 0xffffu); *(PG8_LAS unsigned short*)(p + 144) = (unsigned short)(w0 >> 16);
                            *(PG8_LAS unsigned short*)(p + 288) = (unsigned short)(w1 & 0xffffu); *(PG8_LAS unsigned short*)(p + 432) = (unsigned short)(w1 >> 16); }
                        asm volatile("s_waitcnt lgkmcnt(0)" ::: "memory");
                        const int rowbase = u.pm * BM + ai * HALF + wr * 64;
#pragma unroll
                        for (int h = 0; h < 2; ++h) { const int pc = lane + 64 * h, col = pc >> 3, oct = pc & 7;
                            const u32x4 w = *(const PG8_LAS u32x4*)(ws_ + col * 144 + oct * 16);
                            *(u32x4*)(hyT + (size_t)(cg - 416 + col) * T + rowbase + oct * 8) = w; }
                        asm volatile("s_waitcnt lgkmcnt(0)" ::: "memory");
                    }
                }
#pragma unroll
        for (int ai = 0; ai < 2; ++ai)
#pragma unroll
            for (int m = 0; m < 4; ++m) {
                const int rowp = u.pm * BM + ai * HALF + wr * 64 + m * 16 + fr;
                const int row = (rowp & 1) * SEQ + (rowp >> 1);
                float sq = 0.f, skv = 0.f;
#pragma unroll
                for (int bj = 0; bj < 2; ++bj)
#pragma unroll
                    for (int n = 0; n < 2; ++n) {
                        const int c0 = u.pn * BM + bj * HALF + wc * 32 + n * 16 + 4 * fq;
                        const f32x4 v = acc[ai][bj][m][n];
                        if (c0 < 256) {
                            u32x2 w; w.x = cvt_pk_bf16(v[0], v[1]); w.y = cvt_pk_bf16(v[2], v[3]);
                            *(u32x2*)(cq + (size_t)row * 256 + c0) = w;
                            sq += (v[0] * v[0] + v[1] * v[1]) + (v[2] * v[2] + v[3] * v[3]);
                        } else if (c0 < 384) {
                            u32x2 w; w.x = cvt_pk_bf16(v[0], v[1]); w.y = cvt_pk_bf16(v[2], v[3]);
                            *(u32x2*)(ckv + (size_t)row * 128 + (c0 - 256)) = w;
                            skv += (v[0] * v[0] + v[1] * v[1]) + (v[2] * v[2] + v[3] * v[3]);
                        } else if (c0 < 416) {
                            *(f32x4*)(krr + (size_t)row * 32 + (c0 - 384)) = v;
                        }
                    }
                if (u.pn == 0) { sq += __shfl_xor(sq, 16); sq += __shfl_xor(sq, 32); if (fq == 0) ssq_q[row * 4 + wc] = sq; }
                if (u.pn == 1) { skv += __shfl_xor(skv, 16); skv += __shfl_xor(skv, 32); if (fq == 0) ssq_kv[row * 4 + wc] = skv; }
            }
    }
};

struct EpiRowScale {
    static constexpr bool PERM = true, AFTER_DRAIN = false;
    bf16_t* O; int ldc; const float* ssq; float inv_n; float post;
    __device__ __forceinline__ void operator()(const f32x4 (&acc)[2][2][4][2], const Unit& u, int wr, int wc, int fr, int fq) const {
        const int col0 = u.pn * BM + wc * 32 + 8 * fq;
#pragma unroll
        for (int ai = 0; ai < 2; ++ai)
#pragma unroll
            for (int m = 0; m < 4; ++m) {
                const int row = u.pm * BM + ai * HALF + wr * 64 + m * 16 + fr;
                float s = 1.f; if (ssq) { const f32x4 pp = *(const f32x4*)(ssq + (size_t)row * 4); s = __builtin_amdgcn_rsqf(((pp[0] + pp[1]) + (pp[2] + pp[3])) * inv_n + EPS) * post; }
#pragma unroll
                for (int bj = 0; bj < 2; ++bj) {
                    const f32x4 v0 = acc[ai][bj][m][0] * s, v1 = acc[ai][bj][m][1] * s;
                    u32x4 w; w.x = cvt_pk_bf16(v0[0], v0[1]); w.y = cvt_pk_bf16(v0[2], v0[3]); w.z = cvt_pk_bf16(v1[0], v1[1]); w.w = cvt_pk_bf16(v1[2], v1[3]);
                    *(u32x4*)(O + (size_t)row * ldc + col0 + bj * HALF) = w;
                }
            }
    }
};

struct EpiFilt {
    static constexpr bool PERM = false, AFTER_DRAIN = false;
    unsigned* kT2; const float* b3; const float* decay;
    __device__ __forceinline__ void operator()(const f32x4 (&acc)[2][2][4][2], const Unit& u, int wr, int wc, int fr, int fq) const {
        typedef float f32x2 __attribute__((ext_vector_type(2)));
#pragma unroll
        for (int bj = 0; bj < 2; ++bj)
#pragma unroll
            for (int n = 0; n < 2; ++n) {
                const int c0 = u.pn * BM + bj * HALF + wc * 32 + n * 16 + 4 * fq;
                const int dir = c0 >> 10, cp = (c0 & 1023) >> 1;
                const f32x2 b_o0 = *(const f32x2*)(b3 + dir * 1024 + cp), b_o1 = *(const f32x2*)(b3 + dir * 1024 + 512 + cp);
                const f32x2 d_o0 = *(const f32x2*)(decay + dir * 1024 + cp), d_o1 = *(const f32x2*)(decay + dir * 1024 + 512 + cp);
                const float bb[4] = {b_o0.x, b_o1.x, b_o0.y, b_o1.y}; const float dd[4] = {fabsf(d_o0.x), fabsf(d_o1.x), fabsf(d_o0.y), fabsf(d_o1.y)};
#pragma unroll
                for (int ai = 0; ai < 2; ++ai)
#pragma unroll
                    for (int m = 0; m < 4; ++m) {
                        const int row = u.pm * BM + ai * HALF + wr * 64 + m * 16 + fr;
                        const float tl = (float)row * (1.0f / (float)(SEQ - 1));
                        const f32x4 v = acc[ai][bj][m][n];
                        float val[4];
#pragma unroll
                        for (int j = 0; j < 4; ++j) val[j] = (v[j] + bb[j]) * __expf(-tl * dd[j]);
                        kT2[(size_t)(dir * 512 + cp) * SEQ + row] = cvt_pk_bf16(val[0], val[1]);
                        kT2[(size_t)(dir * 512 + cp + 1) * SEQ + row] = cvt_pk_bf16(val[2], val[3]);
                    }
            }
    }
};

struct EpiGU {
    static constexpr bool PERM = true, AFTER_DRAIN = false;
    bf16_t* H;
    __device__ __forceinline__ void operator()(const f32x4 (&acc)[2][2][4][2], const Unit& u, int wr, int wc, int fr, int fq) const {
        const int col0 = u.pn * BM + wc * 32 + 8 * fq;
#pragma unroll
        for (int ai = 0; ai < 2; ++ai)
#pragma unroll
            for (int m = 0; m < 4; ++m) {
                const int row = u.pm * BM + ai * HALF + wr * 64 + m * 16 + fr;
#pragma unroll
                for (int bj = 0; bj < 2; ++bj) {
                    const f32x4 v0 = acc[ai][bj][m][0], v1 = acc[ai][bj][m][1];
                    float h[4];
                    { const float g = v0[0], up = v0[1]; h[0] = g * __builtin_amdgcn_rcpf(1.f + __expf(-g)) * up; }
                    { const float g = v0[2], up = v0[3]; h[1] = g * __builtin_amdgcn_rcpf(1.f + __expf(-g)) * up; }
                    { const float g = v1[0], up = v1[1]; h[2] = g * __builtin_amdgcn_rcpf(1.f + __expf(-g)) * up; }
                    { const float g = v1[2], up = v1[3]; h[3] = g * __builtin_amdgcn_rcpf(1.f + __expf(-g)) * up; }
                    u32x2 w; w.x = cvt_pk_bf16(h[0], h[1]); w.y = cvt_pk_bf16(h[2], h[3]);
                    *(u32x2*)(H + (size_t)row * EFF + ((col0 + bj * HALF) >> 1)) = w;
                }
            }
    }
};

struct EpiDown {
    static constexpr bool PERM = true, AFTER_DRAIN = false;
    bf16_t* O; const float* gate;
    __device__ __forceinline__ void operator()(const f32x4 (&acc)[2][2][4][2], const Unit& u, int wr, int wc, int fr, int fq) const {
        const int col0 = u.pn * BM + wc * 32 + 8 * fq;
#pragma unroll
        for (int ai = 0; ai < 2; ++ai)
#pragma unroll
            for (int m = 0; m < 4; ++m) {
                const int row = u.pm * BM + ai * HALF + wr * 64 + m * 16 + fr;
                const float s = gate[row];
#pragma unroll
                for (int bj = 0; bj < 2; ++bj) {
                    const f32x4 v0 = acc[ai][bj][m][0] * s, v1 = acc[ai][bj][m][1] * s;
                    u32x4 w; w.x = cvt_pk_bf16(v0[0], v0[1]); w.y = cvt_pk_bf16(v0[2], v0[3]); w.z = cvt_pk_bf16(v1[0], v1[1]); w.w = cvt_pk_bf16(v1[2], v1[3]);
                    *(u32x4*)(O + (size_t)row * DM + col0 + bj * HALF) = w;
                }
            }
    }
};
}

namespace attn {
using bf16x8 = __attribute__((ext_vector_type(8))) short;
using s16x4  = __attribute__((ext_vector_type(4))) short;
using f32x16 = __attribute__((ext_vector_type(16))) float;
using f32x8  = __attribute__((ext_vector_type(8))) float;
using u32x4  = __attribute__((ext_vector_type(4))) unsigned;
typedef unsigned short bf16_t;
constexpr int NW = 8, QBLK = 32, KVBLK = 64;
constexpr float SCALE = 0.10206207261596575f;
constexpr float THR = 8.f;
constexpr int LDQ = NH * QKD;
constexpr int LDKV = NH * 128;
constexpr int LDO = NH * VD;
constexpr int SHM_V = KVBLK * 128 * 2, SHM_K = KVBLK * 128 * 2;
constexpr int SHM_ATTN = 2 * SHM_V + 2 * SHM_K + NW * 64 * 4;
#define KSWZ(row, colB) ((row) * 256 + ((colB) ^ (((row) & 7) << 4)))
#define SBAR() __builtin_amdgcn_sched_barrier(0)
__device__ __forceinline__ int crow(int r, int hi) { return (r & 3) + 8 * (r >> 2) + 4 * hi; }
__device__ __forceinline__ unsigned cvtpk(float lo, float hi) { unsigned r; asm volatile("v_cvt_pk_bf16_f32 %0, %1, %2" : "=v"(r) : "v"(lo), "v"(hi)); return r; }
__device__ __forceinline__ float bf2f(short s) { return __uint_as_float(((unsigned)(unsigned short)s) << 16); }

__device__ __forceinline__ void partialSM(f32x16& p0, f32x16& p1, float& m_reg, float& mn, float& alpha) {
  constexpr float C = SCALE * 1.4426950408889634f;
  float pmax = p0[0]; for (int r = 1; r < 16; ++r) pmax = fmaxf(pmax, p0[r]); for (int r = 0; r < 16; ++r) pmax = fmaxf(pmax, p1[r]);
  { auto rr = __builtin_amdgcn_permlane32_swap(__float_as_uint(pmax), __float_as_uint(pmax), false, false);
    pmax = fmaxf(__uint_as_float(rr[0]), __uint_as_float(rr[1])); }
  if (__builtin_expect(__all(pmax - m_reg <= THR / SCALE), 1)) { mn = m_reg; alpha = 1.f; }
  else { mn = fmaxf(m_reg, pmax); alpha = __builtin_amdgcn_exp2f((m_reg - mn) * C); m_reg = mn; }
  float mnC = -mn * C;
  for (int r = 0; r < 16; ++r) p0[r] = fmaf(p0[r], C, mnC); for (int r = 0; r < 16; ++r) p1[r] = fmaf(p1[r], C, mnC);
  for (int r = 0; r < 16; ++r) p0[r] = __builtin_amdgcn_exp2f(p0[r]);
}
__device__ __forceinline__ void finishSM(f32x16& p0, f32x16& p1, float alpha, float& l_reg, bf16x8& pa0, bf16x8& pa1, bf16x8& pa2, bf16x8& pa3) {
  for (int r = 0; r < 16; ++r) p1[r] = __builtin_amdgcn_exp2f(p1[r]);
  float ps = 0; for (int r = 0; r < 16; ++r) ps += p0[r]; for (int r = 0; r < 16; ++r) ps += p1[r];
  { auto rr = __builtin_amdgcn_permlane32_swap(__float_as_uint(ps), __float_as_uint(ps), false, false);
    ps = __uint_as_float(rr[0]) + __uint_as_float(rr[1]); }
  l_reg = l_reg * alpha + ps;
#define PK4(P, BASE, OUT) do { unsigned a0 = cvtpk(P[BASE + 0], P[BASE + 1]), a1 = cvtpk(P[BASE + 2], P[BASE + 3]);   \
    unsigned b0 = cvtpk(P[BASE + 4], P[BASE + 5]), b1 = cvtpk(P[BASE + 6], P[BASE + 7]);                              \
    auto r0 = __builtin_amdgcn_permlane32_swap(a0, b0, false, false); auto r1 = __builtin_amdgcn_permlane32_swap(a1, b1, false, false); \
    u32x4 w = {r0[0], r1[0], r0[1], r1[1]}; OUT = *reinterpret_cast<bf16x8*>(&w); } while (0)
  PK4(p0, 0, pa0); PK4(p0, 8, pa1); PK4(p1, 0, pa2); PK4(p1, 8, pa3);
#undef PK4
}
__device__ __forceinline__ void qkt(f32x16& p0, f32x16& p1, const bf16_t* Ks, const bf16x8* qr, int r32, int hi) {
  p0 = f32x16{}; p1 = f32x16{};
#pragma unroll
  for (int d0 = 0; d0 < 6; ++d0) { int cb = (d0 * 16 + hi * 8) * 2;
    bf16x8 b0 = *reinterpret_cast<const bf16x8*>((const char*)Ks + KSWZ(r32, cb));
    bf16x8 b1 = *reinterpret_cast<const bf16x8*>((const char*)Ks + KSWZ(32 + r32, cb));
    p0 = __builtin_amdgcn_mfma_f32_32x32x16_bf16(b0, qr[d0], p0, 0, 0, 0);
    p1 = __builtin_amdgcn_mfma_f32_32x32x16_bf16(b1, qr[d0], p1, 0, 0, 0); }
}
__device__ __forceinline__ int v_st(int k, int c) { const int kk = (k & ~0xC) | ((k & 4) << 1) | ((k & 8) >> 1); return ((kk >> 3) * 4 + (c >> 5)) * 512 + ((kk & 7) * 32 + (c & 31)) * 2; }
__device__ __forceinline__ int v_rd_base(int lane) { return ((lane & 3) << 3) | (((lane >> 2) & 3) << 6) | (((lane >> 4) & 1) << 5) | (((lane >> 5) & 1) << 8); }
constexpr int v_rd_off(int d0, int ks, int half) { return d0 * 512 + ks * 4096 + half * 2048; }
template <int OFF> __device__ __forceinline__ s16x4 tr_read(int vb) {
  s16x4 r; asm volatile("ds_read_b64_tr_b16 %0, %1 offset:%2" : "=&v"(r) : "v"(vb), "i"(OFF) : "memory"); return r;
}
template <int D0> __device__ __forceinline__ void pv_one(f32x16& od, int vb, bf16x8 pa0, bf16x8 pa1, bf16x8 pa2, bf16x8 pa3) {
  const s16x4 l0 = tr_read<v_rd_off(D0, 0, 0)>(vb), h0 = tr_read<v_rd_off(D0, 0, 1)>(vb), l1 = tr_read<v_rd_off(D0, 1, 0)>(vb), h1 = tr_read<v_rd_off(D0, 1, 1)>(vb);
  const s16x4 l2 = tr_read<v_rd_off(D0, 2, 0)>(vb), h2 = tr_read<v_rd_off(D0, 2, 1)>(vb), l3 = tr_read<v_rd_off(D0, 3, 0)>(vb), h3 = tr_read<v_rd_off(D0, 3, 1)>(vb);
  asm volatile("s_waitcnt lgkmcnt(0)" ::: "memory"); SBAR();
#define PK(L, H) (bf16x8){L[0], L[1], L[2], L[3], H[0], H[1], H[2], H[3]}
  od = __builtin_amdgcn_mfma_f32_32x32x16_bf16(pa0, PK(l0, h0), od, 0, 0, 0);
  od = __builtin_amdgcn_mfma_f32_32x32x16_bf16(pa1, PK(l1, h1), od, 0, 0, 0);
  od = __builtin_amdgcn_mfma_f32_32x32x16_bf16(pa2, PK(l2, h2), od, 0, 0, 0);
  od = __builtin_amdgcn_mfma_f32_32x32x16_bf16(pa3, PK(l3, h3), od, 0, 0, 0);
#undef PK
}
__device__ __forceinline__ void pv_d0(f32x16* o, int vb, bf16x8 pa0, bf16x8 pa1, bf16x8 pa2, bf16x8 pa3) {
  pv_one<0>(o[0], vb, pa0, pa1, pa2, pa3); pv_one<1>(o[1], vb, pa0, pa1, pa2, pa3);
}

__device__ __forceinline__ void attn_unit(const bf16_t* __restrict__ Q, const bf16_t* __restrict__ KV, const bf16_t* __restrict__ KR, const float* __restrict__ CS,
                                          bf16_t* __restrict__ O, int h, long tq0, long tk0, int seq, char* lds, const int tid) {
  const int wid = tid >> 6, lane = tid & 63, r32 = lane & 31, hi = lane >> 5;
  bf16_t* V_lds = (bf16_t*)lds; bf16_t* K_lds = (bf16_t*)(lds + 2 * SHM_V);
  float* ws = (float*)(lds + 2 * SHM_V + 2 * SHM_K) + wid * 64; float* li_l = ws; float* al_l = ws + 32;
  float m_reg = -1e30f, l_reg = 0; f32x16 o[2] = {}; bf16x8 qr[6];
  { const long trow = tq0 + wid * QBLK + r32;
    const bf16_t* Qw = Q + trow * LDQ + h * QKD + hi * 8;
#pragma unroll
    for (int d0 = 0; d0 < 6; ++d0) qr[d0] = *reinterpret_cast<const bf16x8*>(Qw + d0 * 16);
    const float* cs = CS + trow * 32 + hi * 16;
    bf16x8 q4 = qr[4], q5 = qr[5];
    unsigned w4[4], w5[4];
#pragma unroll
    for (int jj = 0; jj < 4; ++jj) {
      const float4 c2 = *reinterpret_cast<const float4*>(cs + jj * 4);
      const float a0 = bf2f(q4[2 * jj]), b0 = bf2f(q5[2 * jj]), a1 = bf2f(q4[2 * jj + 1]), b1 = bf2f(q5[2 * jj + 1]);
      w4[jj] = cvtpk(a0 * c2.x - b0 * c2.y, a1 * c2.z - b1 * c2.w);
      w5[jj] = cvtpk(b0 * c2.x + a0 * c2.y, b1 * c2.z + a1 * c2.w);
    }
    u32x4 W4 = {w4[0], w4[1], w4[2], w4[3]}, W5 = {w5[0], w5[1], w5[2], w5[3]};
    qr[4] = *reinterpret_cast<bf16x8*>(&W4); qr[5] = *reinterpret_cast<bf16x8*>(&W5);
  }
  const int sr = tid >> 3, sc = (tid & 7) * 8, vst0 = v_st(sr, sc);
  const int rr = (tid & 255) >> 2, rc = (tid & 3) * 8;
  const bool rope_w = tid < 256;
  const bf16_t* Vg = KV + (tk0 + sr) * LDKV + h * 128 + 64 + sc;
  const bf16_t* Kg = KV + (tk0 + sr) * LDKV + h * 128 + sc;
  const bf16_t* Rg = KR + (tk0 + rr) * 32 + rc;
  const int vb0 = (int)(uintptr_t)V_lds + v_rd_base(lane);
  struct { bf16x8 vs, ks, rs; } sr_[2];
#define SLOAD(i, k0) do { sr_[i].vs = *reinterpret_cast<const bf16x8*>(Vg + (long)(k0) * LDKV); sr_[i].ks = *reinterpret_cast<const bf16x8*>(Kg + (long)(k0) * LDKV); \
    sr_[i].rs = *reinterpret_cast<const bf16x8*>(Rg + (long)(k0) * 32); } while (0)
#define SWRITE(b, i) do { *(bf16x8*)((char*)V_lds + (b) * SHM_V + vst0) = sr_[i].vs;          \
    *(bf16x8*)((char*)K_lds + (b) * SHM_K + KSWZ(sr, sc * 2)) = sr_[i].ks;                       \
    if (rope_w) *(bf16x8*)((char*)K_lds + (b) * SHM_K + KSWZ(rr, (64 + rc) * 2)) = sr_[i].rs; } while (0)
#define SWAIT() asm volatile("s_waitcnt vmcnt(3)" ::: "memory")
#define RESC(a) do { if (__any((a) < 1.f)) { if (hi == 0) al_l[r32] = (a); asm volatile("s_waitcnt lgkmcnt(0)" ::: "memory"); \
    for (int d = 0; d < 2; ++d) for (int r = 0; r < 16; ++r) o[d][r] *= al_l[crow(r, hi)]; } } while (0)
  f32x16 pA0, pA1, pB0, pB1; float mnA, mnB, alA, alB; bf16x8 pa0, pa1, pa2, pa3; const int NT = seq / KVBLK;
  constexpr int SE = 0, SO = 1;
  SLOAD(SE, 0); asm volatile("s_waitcnt vmcnt(0)" ::: "memory"); SWRITE(0, SE); __syncthreads();
  qkt(pA0, pA1, K_lds, qr, r32, hi); partialSM(pA0, pA1, m_reg, mnA, alA);
  SLOAD(SO, KVBLK); if (2 < NT) SLOAD(SE, 2 * KVBLK);
  SWAIT(); SWRITE(1, SO); __syncthreads();
  for (int j = 1; j + 1 < NT; j += 2) {
    SBAR(); qkt(pB0, pB1, (bf16_t*)((char*)K_lds + SHM_K), qr, r32, hi);
    finishSM(pA0, pA1, alA, l_reg, pa0, pa1, pa2, pa3); SBAR();
    SLOAD(SO, (j + 2) * KVBLK); SBAR();
    pv_d0(o, vb0, pa0, pa1, pa2, pa3); partialSM(pB0, pB1, m_reg, mnB, alB);
    __syncthreads(); SWAIT(); SWRITE(0, SE);
    RESC(alB); __syncthreads();
    SBAR(); qkt(pA0, pA1, K_lds, qr, r32, hi);
    finishSM(pB0, pB1, alB, l_reg, pa0, pa1, pa2, pa3); SBAR();
    if (j + 3 < NT) SLOAD(SE, (j + 3) * KVBLK); SBAR();
    pv_d0(o, vb0 + (int)SHM_V, pa0, pa1, pa2, pa3); partialSM(pA0, pA1, m_reg, mnA, alA);
    __syncthreads(); SWAIT(); SWRITE(1, SO);
    RESC(alA); __syncthreads();
  }
  SBAR(); qkt(pB0, pB1, (bf16_t*)((char*)K_lds + SHM_K), qr, r32, hi);
  finishSM(pA0, pA1, alA, l_reg, pa0, pa1, pa2, pa3); SBAR();
  pv_d0(o, vb0, pa0, pa1, pa2, pa3); partialSM(pB0, pB1, m_reg, mnB, alB);
  __syncthreads(); RESC(alB);
  finishSM(pB0, pB1, alB, l_reg, pa0, pa1, pa2, pa3); SBAR();
  pv_d0(o, vb0 + (int)SHM_V, pa0, pa1, pa2, pa3);
  if (hi == 0) li_l[r32] = l_reg; asm volatile("s_waitcnt lgkmcnt(0)" ::: "memory");
  float rli[16];
#pragma unroll
  for (int r = 0; r < 16; ++r) rli[r] = __builtin_amdgcn_rcpf(li_l[crow(r, hi)]);
  bf16_t* Ow = O + (tq0 + wid * QBLK) * LDO + h * VD;
#pragma unroll
  for (int r = 0; r < 16; ++r) { int orow = crow(r, hi);
#pragma unroll
    for (int d0 = 0; d0 < 2; ++d0) Ow[(long)orow * LDO + d0 * 32 + r32] = (bf16_t)(cvtpk(o[d0][r] * rli[r], 0.f) & 0xffffu); }
  __syncthreads();
#undef SLOAD
#undef SWRITE
#undef SWAIT
#undef RESC
}
#undef KSWZ
#undef SBAR
}

namespace attn2 {
using bf16=__hip_bfloat16;
using bf16x8=__attribute__((ext_vector_type(8)))short;
using s16x4=__attribute__((ext_vector_type(4)))short;
using f32x16=__attribute__((ext_vector_type(16)))float;
using u32x4=__attribute__((ext_vector_type(4)))unsigned;
constexpr int NHEAD=8,DQK=96,DV=64,PQ=NHEAD*DQK  ,PKV=NHEAD*128  ,PKR=32  ,PO=NHEAD*DV  ;
constexpr int NW=8,QBLK=32,QB=QBLK*NW,KVBLK=64,NQB=SEQ/QB;
constexpr int ATTN_UNIT_ROWS=QB;
__device__ __forceinline__ int crow(int r,int hi){return (r&3)+8*(r>>2)+4*hi;}
#define SBAR() __builtin_amdgcn_sched_barrier(0)
__device__ __forceinline__ void cmask(f32x16&p0,f32x16&p1,int jb,int qrel,int hi){
  const float NEG=-INFINITY; int kb=64*jb+4*hi;
  #pragma unroll
  for(int r=0;r<16;++r){int kv=kb+(r&3)+8*(r>>2); if(kv>qrel)p0[r]=NEG; if(kv+32>qrel)p1[r]=NEG;}
}

constexpr int NSLOT=3, SLOTK=8192, SLOTR=4096, SLOTV=8192;
constexpr int LDS_K=0, LDS_V=NSLOT*SLOTK, LDS_R=LDS_V+NSLOT*SLOTV, LDS_WS=LDS_R+NSLOT*SLOTR, LDS_OST=LDS_WS+NW*64*4, LDS_BYTES=LDS_OST+NW*4096;
constexpr float C2=0.10206207261596575f*1.4426950408889634f;
__device__ __forceinline__ void glds16(const void*gsrc,unsigned lds_dst){
  asm volatile("s_mov_b32 m0, %1\n\ts_nop 0\n\tglobal_load_lds_dwordx4 %0, off"::"v"(gsrc),"s"(lds_dst):"memory");}
__device__ __forceinline__ float max3f(float a,float b,float c){float r;asm("v_max3_f32 %0, %1, %2, %3":"=v"(r):"v"(a),"v"(b),"v"(c));return r;}
__device__ __forceinline__ float max2f(float a,float b){float r;asm("v_max_f32_e32 %0, %1, %2":"=v"(r):"v"(a),"v"(b));return r;}
__device__ __forceinline__ float fadd_s(float a,float b){float r;asm("v_add_f32_e32 %0, %1, %2":"=v"(r):"v"(a),"v"(b));return r;}
__device__ __forceinline__ float fsub_s(float a,float b){float r;asm("v_sub_f32_e32 %0, %1, %2":"=v"(r):"v"(a),"v"(b));return r;}
typedef float f32x2_t __attribute__((ext_vector_type(2))); typedef __bf16 bf16x2_t __attribute__((ext_vector_type(2)));
__device__ __forceinline__ unsigned cvtpk_s(float lo,float hi){f32x2_t v={lo,hi};bf16x2_t b=__builtin_convertvector(v,bf16x2_t);return __builtin_bit_cast(unsigned,b);}
#define WAIT_BAR(N) asm volatile("s_waitcnt vmcnt(" #N ") lgkmcnt(0)\n\ts_barrier":::"memory")

__device__ __forceinline__ void qkt(f32x16&p0,f32x16&p1,const char*Kslot,const char*Rslot,const bf16x8*qr,const f32x16&negm,int r32,int hi){
  const char*kb=Kslot+hi*1024+r32*16; const char*rb=Rslot+hi*1024+r32*16-4*2048;
  #pragma unroll
  for(int d0=0;d0<6;++d0){
    const bf16x8 b0=*reinterpret_cast<const bf16x8*>((d0<4?kb:rb)+d0*2048);
    const bf16x8 b1=*reinterpret_cast<const bf16x8*>((d0<4?kb:rb)+d0*2048+512);
    if(d0==0){p0=__builtin_amdgcn_mfma_f32_32x32x16_bf16(b0,qr[0],negm,0,0,0);p1=__builtin_amdgcn_mfma_f32_32x32x16_bf16(b1,qr[0],negm,0,0,0);}
    else{p0=__builtin_amdgcn_mfma_f32_32x32x16_bf16(b0,qr[d0],p0,0,0,0);p1=__builtin_amdgcn_mfma_f32_32x32x16_bf16(b1,qr[d0],p1,0,0,0);}}
}
typedef __attribute__((address_space(3))) const char* lds_cptr;
typedef short v4i16_t __attribute__((ext_vector_type(4)));
__device__ __forceinline__ void kload8(bf16x8*kf,lds_cptr kp){
  kf[0]=*(const __attribute__((address_space(3))) bf16x8*)(kp);      kf[1]=*(const __attribute__((address_space(3))) bf16x8*)(kp+512);
  kf[2]=*(const __attribute__((address_space(3))) bf16x8*)(kp+2048); kf[3]=*(const __attribute__((address_space(3))) bf16x8*)(kp+2560);
  kf[4]=*(const __attribute__((address_space(3))) bf16x8*)(kp+4096); kf[5]=*(const __attribute__((address_space(3))) bf16x8*)(kp+4608);
  kf[6]=*(const __attribute__((address_space(3))) bf16x8*)(kp+6144); kf[7]=*(const __attribute__((address_space(3))) bf16x8*)(kp+6656);
}
__device__ __forceinline__ void kload2(bf16x8*kf,lds_cptr kp,int j){ kf[2*j]=*(const __attribute__((address_space(3))) bf16x8*)(kp+j*2048); kf[2*j+1]=*(const __attribute__((address_space(3))) bf16x8*)(kp+j*2048+512); }
__device__ __forceinline__ s16x4 vtr(lds_cptr p){ return __builtin_bit_cast(s16x4,__builtin_amdgcn_ds_read_tr16_b64_v4i16((__attribute__((address_space(3))) v4i16_t*)p)); }
__device__ __forceinline__ float rowmax(const f32x16&p0,const f32x16&p1){
  float a=max3f(p0[0],p0[1],p1[0]),b=max3f(p0[2],p0[3],p1[1]);a=max3f(a,p1[2],p1[3]);
  #pragma unroll
  for(int r=4;r<16;r+=4){a=max3f(a,p0[r],p0[r+1]);b=max3f(b,p0[r+2],p0[r+3]);a=max3f(a,p1[r],p1[r+1]);b=max3f(b,p1[r+2],p1[r+3]);}
  const float m=max2f(a,b);
  auto rr=__builtin_amdgcn_permlane32_swap(__float_as_uint(m),__float_as_uint(m),false,false);
  return max2f(__uint_as_float(rr[0]),__uint_as_float(rr[1]));
}
__device__ __forceinline__ void pv(f32x16*o,int vb,bf16x8 pa0,bf16x8 pa1,bf16x8 pa2,bf16x8 pa3){
  #pragma unroll
  for(int d0=0;d0<2;++d0){s16x4 lo[4],hi[4];
    #pragma unroll
    for(int ks=0;ks<4;++ks){
      asm volatile("ds_read_b64_tr_b16 %0,%1 offset:%c2":"=&v"(lo[ks]):"v"(vb),"i"(d0*4096+ks*1024):"memory");
      asm volatile("ds_read_b64_tr_b16 %0,%1 offset:%c2":"=&v"(hi[ks]):"v"(vb),"i"(d0*4096+ks*1024+512):"memory");}
    asm volatile("s_waitcnt lgkmcnt(0)":::"memory");SBAR();
    #define PK(k) (bf16x8){lo[k][0],lo[k][1],lo[k][2],lo[k][3],hi[k][0],hi[k][1],hi[k][2],hi[k][3]}
    o[d0]=__builtin_amdgcn_mfma_f32_32x32x16_bf16(pa0,PK(0),o[d0],0,0,0);
    o[d0]=__builtin_amdgcn_mfma_f32_32x32x16_bf16(pa1,PK(1),o[d0],0,0,0);
    o[d0]=__builtin_amdgcn_mfma_f32_32x32x16_bf16(pa2,PK(2),o[d0],0,0,0);
    o[d0]=__builtin_amdgcn_mfma_f32_32x32x16_bf16(pa3,PK(3),o[d0],0,0,0);
    #undef PK
  }
}

#ifndef ATTN_STORE16
#define ATTN_STORE16(p,v) (*(u32x4*)(p)=(v))
#endif
template<int THRL> __device__ __forceinline__ void attn_unit(int b,int h,int qb,const bf16*Q,const bf16*__restrict__ KV,const bf16*__restrict__ KR,const float*__restrict__ CS,bf16*O,char*shm,const int tid){
  const int lane=tid&63,r32=lane&31,hi=lane>>5; const int wid=__builtin_amdgcn_readfirstlane(tid>>6);
  unsigned m0keep; asm volatile("s_mov_b32 %0, m0":"=s"(m0keep));
  const long rowbase=(long)b*SEQ; const int q0=qb*QB;
  const bf16*Qw=Q+(rowbase+q0+wid*QBLK)*PQ+h*DQK;
  const bf16*Kh=KV+rowbase*PKV+h*128,*Vh=KV+rowbase*PKV+h*128+64,*Rh=KR+rowbase*PKR;
  const unsigned lds0=(unsigned)(uintptr_t)shm;
  float*wsf=(float*)(shm+LDS_WS)+wid*64;
  const bf16*ksrc=Kh+(long)lane*PKV+wid*8;
  const bf16*rsrc=Rh+(long)lane*PKR+(wid&3)*8;
  const bf16*vsrc=Vh+(long)(16*(wid&3)+(lane>>2))*PKV+(wid>>2)*32+(lane&3)*8;
  const unsigned kdst=lds0+LDS_K+wid*1024, rdst=lds0+LDS_R+(wid&3)*1024, vdst=lds0+LDS_V+wid*1024;
  #define DMA_K(t,slot) glds16(ksrc+(long)(t)*KVBLK*PKV,(unsigned)__builtin_amdgcn_readfirstlane(kdst+(slot)*SLOTK))
  #define DMA_R(t,slot) glds16(rsrc+(long)(t)*KVBLK*PKR,(unsigned)__builtin_amdgcn_readfirstlane(rdst+(slot)*SLOTR))
  #define DMA_V(t,slot) glds16(vsrc+(long)(t)*KVBLK*PKV,(unsigned)__builtin_amdgcn_readfirstlane(vdst+(slot)*SLOTV))
  const int vb0=(int)(lds0+LDS_V)+((lane>>4)&1)*32+(lane&3)*8+(4*hi+((lane&15)>>2))*64;
  const char*Kbase=shm+LDS_K; bf16x8 kf[8];
  const lds_cptr shm3=(lds_cptr)shm; const lds_cptr kp0=shm3+LDS_K+hi*1024+r32*16; const lds_cptr rp0=shm3+LDS_R+hi*1024+r32*16; const lds_cptr vp0=shm3+LDS_V+((lane>>4)&1)*32+(lane&3)*8+(4*hi+((lane&15)>>2))*64;
  const int NT=SEQ/KVBLK;
  DMA_K(0,0);DMA_R(0,0);DMA_V(0,0);DMA_K(1,1);DMA_R(1,1);
  bf16x8 qr[6];
  #pragma unroll
  for(int d0=0;d0<6;++d0)qr[d0]=*reinterpret_cast<const bf16x8*>(&Qw[(long)r32*PQ+d0*16+hi*8]);
  {
    const float*cs=CS+(rowbase+q0+wid*QBLK+r32)*32+hi*16; const bf16x8 q4=qr[4],q5=qr[5]; unsigned w4[4],w5[4];
    #pragma unroll
    for(int jj=0;jj<4;++jj){ const float4 c2=*reinterpret_cast<const float4*>(cs+jj*4);
      const float a0=__uint_as_float(((unsigned)(unsigned short)q4[2*jj])<<16),b0=__uint_as_float(((unsigned)(unsigned short)q5[2*jj])<<16),a1=__uint_as_float(((unsigned)(unsigned short)q4[2*jj+1])<<16),b1=__uint_as_float(((unsigned)(unsigned short)q5[2*jj+1])<<16);
      w4[jj]=cvtpk_s(a0*c2.x-b0*c2.y,a1*c2.z-b1*c2.w); w5[jj]=cvtpk_s(b0*c2.x+a0*c2.y,b1*c2.z+a1*c2.w); }
    const u32x4 W4={w4[0],w4[1],w4[2],w4[3]},W5={w5[0],w5[1],w5[2],w5[3]}; qr[4]=__builtin_bit_cast(bf16x8,W4); qr[5]=__builtin_bit_cast(bf16x8,W5); }
  float mhat=0.f,l_reg=0.f;f32x16 o[2];o[0]=f32x16{};o[1]=f32x16{};f32x16 negm=f32x16{};asm volatile("":"+v"(negm));
  #define CMASK(P0,P1,t) do{}while(0)
  bool resc=false;
  #define START(P0,P1) do{ const float rm=rowmax(P0,P1); resc=false; \
    { const float dl=rm; mhat=fadd_s(mhat,dl); \
      _Pragma("unroll") for(int r=0;r<16;++r){P0[r]=fsub_s(P0[r],dl);P1[r]=fsub_s(P1[r],dl);} \
      _Pragma("unroll") for(int r=0;r<16;++r)negm[r]=-mhat; asm volatile("":"+v"(negm)); } \
    _Pragma("unroll") for(int r=0;r<16;++r)P0[r]=__builtin_amdgcn_exp2f(P0[r]); }while(0)
  #define RESC() do{ if(resc){ asm volatile("s_waitcnt lgkmcnt(0)":::"memory"); \
      _Pragma("unroll") for(int d_=0;d_<2;++d_) _Pragma("unroll") for(int r=0;r<16;++r)o[d_][r]*=wsf[crow(r,hi)]; } }while(0)
  f32x16 pA0,pA1,pB0,pB1;
  int sl_prev=0,sl_cur=0,sl_next=1;
  #define ROT() do{sl_prev=sl_cur;sl_cur=sl_next;sl_next=(sl_next==NSLOT-1)?0:sl_next+1;}while(0)
  DMA_K(2,2);
  WAIT_BAR(3);
  qkt(pA0,pA1,Kbase,shm+LDS_R,qr,negm,r32,hi);asm volatile("s_nop 15\n\ts_nop 7":"+v"(pA0),"+v"(pA1));CMASK(pA0,pA1,0);
  START(pA0,pA1);
  _Pragma("unroll") for(int r=0;r<16;++r)pA1[r]=__builtin_amdgcn_exp2f(pA1[r]);
  WAIT_BAR(0);
  DMA_K(3,0);DMA_R(2,2);DMA_V(1,1);
  ROT();
  kload8(kf,kp0+sl_cur*SLOTK);
  WAIT_BAR(3);
  s16x4 vlo[8],vhi[8]; u32x4 pw0,pw1,pw2,pw3;
  #define PKW(P,B) cvtpk_s(P[B],P[B+1])
  #define PAF(k) __builtin_bit_cast(bf16x8,pw##k)
  #define VFR(i) (bf16x8){vlo[i][0],vlo[i][1],vlo[i][2],vlo[i][3],vhi[i][0],vhi[i][1],vhi[i][2],vhi[i][3]}
  #define PIN(x) asm volatile("":"+v"(x))
  #define MX3(a,b,c) __builtin_fmaxf(__builtin_fmaxf((a),(b)),(c))
  #define MX2(a,b) __builtin_fmaxf((a),(b))
  #define LGKM0() __builtin_amdgcn_s_waitcnt(0xC07F)
  #define GAPA(MF,A0,A1,A2,A3,W0,W1,PW) do{ MF; sacc+=A0; sacc+=A1; sacc+=A2; sacc+=A3; PIN(sacc); W0; W1; PIN(PW); SBAR(); }while(0)
  #define EX(v) __builtin_amdgcn_exp2f(v)
  #define GAPB(MF,X,B) do{ MF; X[B]=EX(X[B]); X[B+1]=EX(X[B+1]); X[B+2]=EX(X[B+2]); X[B+3]=EX(X[B+3]); PIN(X); SBAR(); }while(0)
  #define VRD(i) do{ vlo[i]=vtr(vp_+(((i)>>2)*4096+((i)&3)*1024)); vhi[i]=vtr(vp_+(((i)>>2)*4096+((i)&3)*1024+512)); }while(0)
  #define KRD(G,j) do{ if(G){ kload2(kf,kp0+sl_next*SLOTK,j); SBAR(); } }while(0)
  #define STEP(C0,C1,P0,P1,t,GK,GR,GV,GL) do{ SBAR(); bf16x8 krf0,krf1,krf2,krf3; \
    const lds_cptr vp_=vp0+sl_prev*SLOTV; \
    float sacc=(P0[0]+P0[1]); LGKM0(); \
    C0=__builtin_amdgcn_mfma_f32_32x32x16_bf16(kf[0],qr[0],negm,0,0,0); sacc+=P0[2]; sacc+=P0[3]; sacc+=P0[4]; PIN(sacc); pw0[0]=PKW(P0,0); pw0[1]=PKW(P0,2); PIN(pw0); SBAR(); \
    C1=__builtin_amdgcn_mfma_f32_32x32x16_bf16(kf[1],qr[0],negm,0,0,0); sacc+=P0[5]; sacc+=P0[6]; sacc+=P0[7]; PIN(sacc); pw0[2]=PKW(P0,4); PIN(pw0); SBAR(); \
    C0=__builtin_amdgcn_mfma_f32_32x32x16_bf16(kf[2],qr[1],C0,0,0,0); sacc+=P0[8]; sacc+=P0[9]; sacc+=P0[10]; PIN(sacc); pw0[3]=PKW(P0,6); PIN(pw0); SBAR(); \
    C1=__builtin_amdgcn_mfma_f32_32x32x16_bf16(kf[3],qr[1],C1,0,0,0); sacc+=P0[11]; sacc+=P0[12]; sacc+=P0[13]; PIN(sacc); pw1[0]=PKW(P0,8); pw1[1]=PKW(P0,10); PIN(pw1); SBAR(); \
    { const lds_cptr rp_=rp0+sl_cur*SLOTR; krf0=*(const __attribute__((address_space(3))) bf16x8*)(rp_); krf1=*(const __attribute__((address_space(3))) bf16x8*)(rp_+512); krf2=*(const __attribute__((address_space(3))) bf16x8*)(rp_+2048); krf3=*(const __attribute__((address_space(3))) bf16x8*)(rp_+2560); } SBAR(); \
    C0=__builtin_amdgcn_mfma_f32_32x32x16_bf16(kf[4],qr[2],C0,0,0,0); sacc+=P0[14]; sacc+=P0[15]; PIN(sacc); pw1[2]=PKW(P0,12); PIN(pw1); SBAR(); \
    C1=__builtin_amdgcn_mfma_f32_32x32x16_bf16(kf[5],qr[2],C1,0,0,0); sacc+=P1[0]; sacc+=P1[1]; PIN(sacc); pw1[3]=PKW(P0,14); PIN(pw1); SBAR(); \
    C0=__builtin_amdgcn_mfma_f32_32x32x16_bf16(kf[6],qr[3],C0,0,0,0); sacc+=P1[2]; sacc+=P1[3]; PIN(sacc); pw2[0]=PKW(P1,0); pw2[1]=PKW(P1,2); PIN(pw2); SBAR(); \
    C1=__builtin_amdgcn_mfma_f32_32x32x16_bf16(kf[7],qr[3],C1,0,0,0); sacc+=P1[4]; sacc+=P1[5]; PIN(sacc); pw2[2]=PKW(P1,4); PIN(pw2); SBAR(); \
    LGKM0(); C0=__builtin_amdgcn_mfma_f32_32x32x16_bf16(krf0,qr[4],C0,0,0,0); sacc+=P1[6]; sacc+=P1[7]; sacc+=P1[8]; PIN(sacc); pw2[3]=PKW(P1,6); PIN(pw2); SBAR(); \
    C1=__builtin_amdgcn_mfma_f32_32x32x16_bf16(krf1,qr[4],C1,0,0,0); sacc+=P1[9]; sacc+=P1[10]; sacc+=P1[11]; PIN(sacc); pw3[0]=PKW(P1,8); pw3[1]=PKW(P1,10); PIN(pw3); SBAR(); \
    C0=__builtin_amdgcn_mfma_f32_32x32x16_bf16(krf2,qr[5],C0,0,0,0); sacc+=P1[12]; sacc+=P1[13]; PIN(sacc); pw3[2]=PKW(P1,12); PIN(pw3); SBAR(); \
    C1=__builtin_amdgcn_mfma_f32_32x32x16_bf16(krf3,qr[5],C1,0,0,0); sacc+=P1[14]; sacc+=P1[15]; PIN(sacc); pw3[3]=PKW(P1,14); PIN(pw3); SBAR(); \
    l_reg+=sacc; \
    if(GK){DMA_K((t)+3,sl_cur);} if(GR){DMA_R((t)+2,sl_prev);} if(GV){DMA_V((t)+1,sl_next);} \
    CMASK(C0,C1,t); \
    { float a=MX3(C0[0],C0[1],C1[0]),b=MX3(C0[2],C0[3],C1[1]); a=MX3(a,C1[2],C1[3]); \
      _Pragma("unroll") for(int r=4;r<16;r+=4){a=MX3(a,C0[r],C0[r+1]);b=MX3(b,C0[r+2],C0[r+3]);a=MX3(a,C1[r],C1[r+1]);b=MX3(b,C1[r+2],C1[r+3]);} \
      float rm=MX2(a,b); { auto rr=__builtin_amdgcn_permlane32_swap(__float_as_uint(rm),__float_as_uint(rm),false,false); rm=MX2(__uint_as_float(rr[0]),__uint_as_float(rr[1])); } \
      resc=false; \
      if(__builtin_expect(__any(rm>(float)THRL),0)){ const float dl=__builtin_fmaxf(rm,0.f); mhat+=dl; \
        _Pragma("unroll") for(int r=0;r<16;++r){C0[r]-=dl;C1[r]-=dl;} \
        _Pragma("unroll") for(int r=0;r<16;++r)negm[r]=-mhat; asm volatile("":"+v"(negm)); \
        const float f=__builtin_amdgcn_exp2f(-dl); l_reg*=f; if(hi==0)wsf[r32]=f; resc=true; } } \
    SBAR(); VRD(0); VRD(4); SBAR(); \
    GAPB(o[0]=__builtin_amdgcn_mfma_f32_32x32x16_bf16(PAF(0),VFR(0),o[0],0,0,0), C0,0); VRD(1); SBAR(); \
    GAPB(o[1]=__builtin_amdgcn_mfma_f32_32x32x16_bf16(PAF(0),VFR(4),o[1],0,0,0), C0,4); VRD(5); SBAR(); \
    KRD(GL,0); GAPB(o[0]=__builtin_amdgcn_mfma_f32_32x32x16_bf16(PAF(1),VFR(1),o[0],0,0,0), C0,8); VRD(2); SBAR(); \
    KRD(GL,1); GAPB(o[1]=__builtin_amdgcn_mfma_f32_32x32x16_bf16(PAF(1),VFR(5),o[1],0,0,0), C0,12); VRD(6); SBAR(); \
    KRD(GL,2); GAPB(o[0]=__builtin_amdgcn_mfma_f32_32x32x16_bf16(PAF(2),VFR(2),o[0],0,0,0), C1,0); VRD(3); SBAR(); \
    KRD(GL,3); GAPB(o[1]=__builtin_amdgcn_mfma_f32_32x32x16_bf16(PAF(2),VFR(6),o[1],0,0,0), C1,4); VRD(7); SBAR(); \
    GAPB(o[0]=__builtin_amdgcn_mfma_f32_32x32x16_bf16(PAF(3),VFR(3),o[0],0,0,0), C1,8); \
    GAPB(o[1]=__builtin_amdgcn_mfma_f32_32x32x16_bf16(PAF(3),VFR(7),o[1],0,0,0), C1,12); \
    }while(0)
  int t=1;
  #undef CMASK
  #define CMASK(P0,P1,t) do{}while(0)
  for(;t+5<NT;t+=2){
    STEP(pB0,pB1,pA0,pA1,t,true,true,true,true);     WAIT_BAR(3); RESC(); ROT();
    STEP(pA0,pA1,pB0,pB1,t+1,true,true,true,true);   WAIT_BAR(3); RESC(); ROT();
  }
  #define ENDW(tt) do{ if((tt)+3<NT){WAIT_BAR(3);} else if((tt)+2<NT){WAIT_BAR(2);} else {WAIT_BAR(0);} }while(0)
  for(;t+1<NT;t+=2){
    STEP(pB0,pB1,pA0,pA1,t,(t+3<NT),(t+2<NT),(t+1<NT),(t+1<NT));       ENDW(t);   RESC(); ROT();
    STEP(pA0,pA1,pB0,pB1,t+1,(t+4<NT),(t+3<NT),(t+2<NT),(t+2<NT));     ENDW(t+1); RESC(); ROT();
  }
  STEP(pB0,pB1,pA0,pA1,NT-1,false,false,false,false); RESC();
  { float sacc=pB0[0]+pB0[1]; _Pragma("unroll") for(int r=2;r<16;++r)sacc+=pB0[r]; _Pragma("unroll") for(int r=0;r<16;++r)sacc+=pB1[r]; l_reg+=sacc;
    pw0=(u32x4){PKW(pB0,0),PKW(pB0,2),PKW(pB0,4),PKW(pB0,6)};pw1=(u32x4){PKW(pB0,8),PKW(pB0,10),PKW(pB0,12),PKW(pB0,14)};pw2=(u32x4){PKW(pB1,0),PKW(pB1,2),PKW(pB1,4),PKW(pB1,6)};pw3=(u32x4){PKW(pB1,8),PKW(pB1,10),PKW(pB1,12),PKW(pB1,14)};
    SBAR(); pv(o,vb0+sl_cur*SLOTV,PAF(0),PAF(1),PAF(2),PAF(3)); }
  #undef PKW
  #undef PAF
  #undef VFR
  #undef PIN
  #undef MX3
  #undef GAPA
  #undef GAPB
  #undef EX
  #undef VRD
  #undef KRD
  #undef STEP
  #undef ENDW
  {auto rr=__builtin_amdgcn_permlane32_swap(__float_as_uint(l_reg),__float_as_uint(l_reg),false,false);l_reg=__uint_as_float(rr[0])+__uint_as_float(rr[1]);}
  if(hi==0)wsf[32+r32]=l_reg;asm volatile("s_waitcnt lgkmcnt(0)":::"memory");
  float rli[16];
  #pragma unroll
  for(int r=0;r<16;++r)rli[r]=__builtin_amdgcn_rcpf(wsf[32+crow(r,hi)]);
  bf16*Ow=O+(rowbase+q0+wid*QBLK)*PO+h*DV;
  { bf16*stg=(bf16*)(shm+LDS_OST)+wid*2048;
    #pragma unroll
    for(int r=0;r<16;++r){const int orow=crow(r,hi);
      #pragma unroll
      for(int d0=0;d0<2;++d0)stg[orow*64+d0*32+r32]=__float2bfloat16(o[d0][r]*rli[r]);}
    asm volatile("s_waitcnt lgkmcnt(0)":::"memory");
    #pragma unroll
    for(int i=0;i<4;++i){const int row=i*8+(lane>>3),ch=lane&7; const u32x4 v=*(const u32x4*)(stg+row*64+ch*8); ATTN_STORE16(Ow+(long)row*PO+ch*8,v);} }
  asm volatile("s_waitcnt lgkmcnt(0)\n\ts_barrier":::"memory");
  asm volatile("s_mov_b32 m0, %0"::"s"(m0keep));
  #undef DMA_K
  #undef DMA_V
  #undef CMASK
  #undef START
  #undef RESC
  #undef ROT
}
constexpr int ATTN_LDS_BYTES=LDS_BYTES;
#undef SBAR
#undef WAIT_BAR
}

namespace hy {
typedef float2 cf;
typedef unsigned short bf16_t;
constexpr int N = NFFT, L = SEQ;
constexpr int ZELEMS = 17408;
__device__ __forceinline__ float fadd_(float a, float b) { float r; asm("v_add_f32_e32 %0, %1, %2" : "=v"(r) : "v"(a), "v"(b)); return r; }
__device__ __forceinline__ float fsub_(float a, float b) { float r; asm("v_sub_f32_e32 %0, %1, %2" : "=v"(r) : "v"(a), "v"(b)); return r; }
__device__ __forceinline__ float fmul_(float a, float b) { float r; asm("v_mul_f32_e32 %0, %1, %2" : "=v"(r) : "v"(a), "v"(b)); return r; }
__device__ __forceinline__ float ffma_(float a, float b, float c) { float r; asm("v_fma_f32 %0, %1, %2, %3" : "=v"(r) : "v"(a), "v"(b), "v"(c)); return r; }
__device__ __forceinline__ float fnma_(float a, float b, float c) { float r; asm("v_fma_f32 %0, -%1, %2, %3" : "=v"(r) : "v"(a), "v"(b), "v"(c)); return r; }
__device__ __forceinline__ cf cmul(cf a, cf b) { return make_float2(fnma_(a.y, b.y, fmul_(a.x, b.x)), ffma_(a.x, b.y, fmul_(a.y, b.x))); }
__device__ __forceinline__ cf cadd(cf a, cf b) { return make_float2(fadd_(a.x, b.x), fadd_(a.y, b.y)); }
__device__ __forceinline__ cf csub(cf a, cf b) { return make_float2(fsub_(a.x, b.x), fsub_(a.y, b.y)); }
__device__ __forceinline__ float bf_lo(unsigned w) { return __uint_as_float(w << 16); }
__device__ __forceinline__ float bf_hi(unsigned w) { return __uint_as_float(w & 0xffff0000u); }
__device__ constexpr int BR16[16] = {0, 8, 4, 12, 2, 10, 6, 14, 1, 9, 5, 13, 3, 11, 7, 15};
__device__ constexpr int BR4[4] = {0, 2, 1, 3};
#define bitrev(p, R) (((R) == 16) ? BR16[(p) & 15] : BR4[(p) & 3])
__device__ constexpr float C32[16] = {1.0f, 0.98078528040323043f, 0.92387953251128674f, 0.83146961230254524f, 0.70710678118654752f, 0.55557023301960218f, 0.38268343236508977f, 0.19509032201612825f,
                                      0.0f, -0.19509032201612825f, -0.38268343236508977f, -0.55557023301960218f, -0.70710678118654752f, -0.83146961230254524f, -0.92387953251128674f, -0.98078528040323043f};
__device__ constexpr float S32[16] = {0.0f, 0.19509032201612825f, 0.38268343236508977f, 0.55557023301960218f, 0.70710678118654752f, 0.83146961230254524f, 0.92387953251128674f, 0.98078528040323043f,
                                      1.0f, 0.98078528040323043f, 0.92387953251128674f, 0.83146961230254524f, 0.70710678118654752f, 0.55557023301960218f, 0.38268343236508977f, 0.19509032201612825f};
template <int SGN> __device__ __forceinline__ cf twc(cf d, int tk) {
    if (tk == 0) return d;
    if (tk == 8) return (SGN < 0) ? make_float2(d.y, -d.x) : make_float2(-d.y, d.x);
    const float c = C32[tk], s = (SGN < 0) ? -S32[tk] : S32[tk]; return make_float2(fnma_(d.y, s, fmul_(d.x, c)), ffma_(d.x, s, fmul_(d.y, c)));
}
template <int R, int LEN, int SGN> struct DftStage {
    static __device__ __forceinline__ void run(cf (&v)[R]) {
        constexpr int half = LEN / 2;
#pragma unroll
        for (int blk = 0; blk < R; blk += LEN) {
#pragma unroll
            for (int k = 0; k < half; ++k) {
                const cf a = v[blk + k], b = v[blk + k + half];
                v[blk + k] = cadd(a, b);
                v[blk + k + half] = twc<SGN>(csub(a, b), k * (32 / LEN));
            }
        }
        DftStage<R, LEN / 2, SGN>::run(v);
    }
};
template <int R, int SGN> struct DftStage<R, 1, SGN> { static __device__ __forceinline__ void run(cf (&)[R]) {} };
template <int R, int SGN> __device__ __forceinline__ void dft_reg(cf (&v)[R]) { DftStage<R, R, SGN>::run(v); }
__device__ __forceinline__ void dft16_fwd_halfzero(cf (&v)[16]) {
#pragma unroll
    for (int k = 0; k < 8; ++k) v[k + 8] = twc<-1>(v[k], 2 * k);
    DftStage<16, 8, -1>::run(v);
}
__device__ __forceinline__ void tw_apply_br(cf (&v)[16], cf w1) {
    const cf w2 = cmul(w1, w1), w3 = cmul(w2, w1), w4 = cmul(w2, w2);
    cf c0 = w4, c1 = w1, c2 = w2, c3 = w3;
#pragma unroll
    for (int k = 0; k < 4; ++k) {
        if (k > 0) { v[bitrev(4 * k, 16)] = cmul(v[bitrev(4 * k, 16)], c0); c0 = cmul(c0, w4); }
        v[bitrev(4 * k + 1, 16)] = cmul(v[bitrev(4 * k + 1, 16)], c1); c1 = cmul(c1, w4);
        v[bitrev(4 * k + 2, 16)] = cmul(v[bitrev(4 * k + 2, 16)], c2); c2 = cmul(c2, w4);
        v[bitrev(4 * k + 3, 16)] = cmul(v[bitrev(4 * k + 3, 16)], c3); c3 = cmul(c3, w4);
    }
}
__device__ __forceinline__ void tw_apply_nat(cf (&v)[16], cf w1) {
    const cf w2 = cmul(w1, w1), w3 = cmul(w2, w1), w4 = cmul(w2, w2);
    cf c0 = w4, c1 = w1, c2 = w2, c3 = w3;
#pragma unroll
    for (int k = 0; k < 4; ++k) {
        if (k > 0) { v[4 * k] = cmul(v[4 * k], c0); c0 = cmul(c0, w4); }
        v[4 * k + 1] = cmul(v[4 * k + 1], c1); c1 = cmul(c1, w4);
        v[4 * k + 2] = cmul(v[4 * k + 2], c2); c2 = cmul(c2, w4);
        v[4 * k + 3] = cmul(v[4 * k + 3], c3); c3 = cmul(c3, w4);
    }
}
__device__ __forceinline__ constexpr int eoff1(int q) { return q * 1088; }
__device__ __forceinline__ void bf_geom1(int b, int& base, int& twi) { base = b + (b >> 4); twi = b; }
template <bool HALFZERO> __device__ __forceinline__ void fwd_store1(cf* Z, int base, cf w1, cf (&v)[16]) {
    if (HALFZERO) dft16_fwd_halfzero(v); else dft_reg<16, -1>(v);
    tw_apply_br(v, w1);
#pragma unroll
    for (int p = 0; p < 16; ++p) Z[base + eoff1(p)] = v[bitrev(p, 16)];
}
__device__ __forceinline__ void inv_load1(const cf* Z, int base, cf w1c, cf (&v)[16]) {
#pragma unroll
    for (int p = 0; p < 16; ++p) v[p] = Z[base + eoff1(p)];
    tw_apply_nat(v, w1c);
    dft_reg<16, 1>(v);
}
template <bool FWD> __device__ __forceinline__ void lds_passes(cf* Z, const cf* TW, int tid) {
#pragma unroll 1
    for (int ps = 0; ps < 2; ++ps) {
        int p2 = FWD ? (ps == 0) : (ps == 1); asm volatile("" : "+s"(p2));
        const int shift = p2 ? 6 : 2, bmul = p2 ? 1088 : 68, tws = p2 ? 4 : 8, es = p2 ? 68 : 4, ex = p2 ? 0 : 1;
#pragma unroll
        for (int i = 0; i < 2; ++i) {
            const int b = tid + 512 * i, blk = b >> shift, j = b & ((1 << shift) - 1);
            const int base = bmul * blk + j + (j >> 4);
            cf w = TW[j << tws];
            cf v[16];
            if (FWD) {
#pragma unroll
                for (int q = 0; q < 16; ++q) v[q] = Z[base + q * es + (q >> 2) * ex];
                dft_reg<16, -1>(v);
                tw_apply_br(v, w);
#pragma unroll
                for (int p = 0; p < 16; ++p) Z[base + p * es + (p >> 2) * ex] = v[bitrev(p, 16)];
            } else {
                w.y = -w.y;
#pragma unroll
                for (int p = 0; p < 16; ++p) v[p] = Z[base + p * es + (p >> 2) * ex];
                tw_apply_nat(v, w);
                dft_reg<16, 1>(v);
#pragma unroll
                for (int q = 0; q < 16; ++q) Z[base + q * es + (q >> 2) * ex] = v[bitrev(q, 16)];
            }
        }
        __syncthreads();
    }
}
__device__ __forceinline__ void mid_pass(cf* Z, const cf* Hs, int conv, int tid) {
#pragma unroll 1
    for (int i = 0; i < 2; ++i) {
        const int b = tid + 512 * i, base = 17 * b;
        float4 h[8];
        if (conv) {
#pragma unroll
            for (int g = 0; g < 8; ++g) h[g] = *reinterpret_cast<const float4*>(Hs + 16 * b + 2 * g);
        } else {
#pragma unroll
            for (int g = 0; g < 8; ++g) h[g] = make_float4(0.f, 0.f, 0.f, 0.f);
        }
        cf v[16];
#pragma unroll
        for (int q = 0; q < 16; ++q) v[q] = Z[base + q];
#pragma unroll
        for (int g = 0; g < 4; ++g) { cf u[4] = {v[4 * g], v[4 * g + 1], v[4 * g + 2], v[4 * g + 3]};
            dft_reg<4, -1>(u);
            if (conv) {
                const float4 h0 = h[2 * g], h1 = h[2 * g + 1];
                cf t[4];
                t[0] = cmul(u[bitrev(0, 4)], make_float2(h0.x, h0.y)); t[1] = cmul(u[bitrev(1, 4)], make_float2(h0.z, h0.w));
                t[2] = cmul(u[bitrev(2, 4)], make_float2(h1.x, h1.y)); t[3] = cmul(u[bitrev(3, 4)], make_float2(h1.z, h1.w));
                dft_reg<4, 1>(t);
#pragma unroll
                for (int q = 0; q < 4; ++q) Z[base + 4 * g + q] = t[bitrev(q, 4)];
            } else {
#pragma unroll
                for (int p2 = 0; p2 < 4; ++p2) Z[base + 4 * g + p2] = u[bitrev(p2, 4)];
            }
        }
    }
}

__device__ __forceinline__ cf conv3x2(const unsigned* row, int s, float w0, float w1, float w2, float cb) {
    const unsigned a = (s > 0) ? row[s - 1] : 0u, b = row[s], c = (s < SEQ - 1) ? row[s + 1] : 0u;
    return make_float2(cb + w0 * bf_lo(a) + w1 * bf_lo(b) + w2 * bf_lo(c), cb + w0 * bf_hi(a) + w1 * bf_hi(b) + w2 * bf_hi(c));
}

__device__ __forceinline__ void hyena_channel(int c, cf* Z, const cf* TW, const bf16_t* HYT2, const bf16_t* KT,
                                              const float* conv_w, const float* conv_b, const float* hbias,
                                              cf* Hs, cf* Z1S, bf16_t* HYOT, const int tid) {
    const float w00 = conv_w[0 * 1536 + c], w01 = conv_w[1 * 1536 + c], w02 = conv_w[2 * 1536 + c], cb0 = conv_b[c];
    const float w10 = conv_w[0 * 1536 + 512 + c], w11 = conv_w[1 * 1536 + 512 + c], w12 = conv_w[2 * 1536 + 512 + c], cb1 = conv_b[512 + c];
    const float w20 = conv_w[0 * 1536 + 1024 + c], w21 = conv_w[1 * 1536 + 1024 + c], w22 = conv_w[2 * 1536 + 1024 + c], cb2 = conv_b[1024 + c];
    const float bias0 = hbias[c], bias1 = hbias[512 + c];
    const unsigned* r0 = (const unsigned*)HYT2 + (size_t)c * SEQ; const unsigned* r1 = (const unsigned*)HYT2 + (size_t)(512 + c) * SEQ; const unsigned* r2 = (const unsigned*)HYT2 + (size_t)(1024 + c) * SEQ;
#pragma unroll 1
    for (int round = 0; round < 3; ++round) {
        int it = round; asm volatile("" : "+s"(it));
        if (it == 0) {
            const bf16_t* f0 = KT + (size_t)(0 * 1024 + 0 * 512 + c) * SEQ; const bf16_t* f1 = KT + (size_t)(0 * 1024 + 1 * 512 + c) * SEQ;
            const bf16_t* g0 = KT + (size_t)(1 * 1024 + 0 * 512 + c) * SEQ; const bf16_t* g1 = KT + (size_t)(1 * 1024 + 1 * 512 + c) * SEQ;
#pragma unroll 1
            for (int i = 0; i < 2; ++i) { const int j = tid + 512 * i; cf v[16];
#pragma unroll
                for (int q = 0; q < 8; ++q) { const int n = j + 1024 * q; v[q] = make_float2(__uint_as_float((unsigned)f0[n] << 16), __uint_as_float((unsigned)f1[n] << 16)); }
#pragma unroll
                for (int q = 8; q < 16; ++q) { const int m = L - (j + 1024 * (q - 8));
                    v[q] = (m == L) ? make_float2(0.f, 0.f) : make_float2(__uint_as_float((unsigned)g0[m & (L - 1)] << 16), __uint_as_float((unsigned)g1[m & (L - 1)] << 16)); }
                int base, twi; bf_geom1(j, base, twi);
                fwd_store1<false>(Z, base, TW[twi], v); }
        } else if (it == 1) {
#pragma unroll 1
            for (int i = 0; i < 2; ++i) { const int j = tid + 512 * i; cf v[16];
#pragma unroll
                for (int q = 0; q < 8; ++q) v[q] = conv3x2(r0, j + 1024 * q, w00, w01, w02, cb0);
                int base, twi; bf_geom1(j, base, twi);
                fwd_store1<true>(Z, base, TW[twi], v); }
        }
        __syncthreads();
        lds_passes<true>(Z, TW, tid);
        mid_pass(Z, Hs + (it == 2 ? N : 0), it > 0, tid);
        __syncthreads();
        if (it == 0) {
            const float sc = 0.5f / (float)N;
#pragma unroll 4
            for (int i = 0; i < 32; ++i) { const int pos = tid + 512 * i;
                const int k = (pos >> 10) + (((pos >> 6) & 15) << 4) + (((pos >> 2) & 15) << 8) + ((pos & 3) << 12);
                const int k2 = (N - k) & (N - 1);
                const int pos2 = ((k2 & 15) << 10) + (((k2 >> 4) & 15) << 6) + (((k2 >> 8) & 15) << 2) + (k2 >> 12);
                const cf F = Z[pos + (pos >> 4)], G = Z[pos2 + (pos2 >> 4)];
                Hs[pos] = make_float2((F.x + G.x) * sc, (F.y - G.y) * sc);
                Hs[N + pos] = make_float2((F.y + G.y) * sc, (G.x - F.x) * sc); }
            __syncthreads();
        } else {
            lds_passes<false>(Z, TW, tid);
            if (it == 1) {
#pragma unroll 1
                for (int i = 0; i < 2; ++i) { const int j = tid + 512 * i; int base, twi; bf_geom1(j, base, twi); const cf w = TW[twi];
                    cf v[16]; inv_load1(Z, base, make_float2(w.x, -w.y), v);
                    cf z[16];
#pragma unroll
                    for (int q = 0; q < 8; ++q) { const int s = j + 1024 * q; const cf y = v[bitrev(q, 16)];
                        const cf z0 = conv3x2(r0, s, w00, w01, w02, cb0), x1 = conv3x2(r1, s, w10, w11, w12, cb1);
                        z[q] = make_float2(x1.x * (y.x + z0.x * bias0), x1.y * (y.y + z0.y * bias0));
                        Z1S[s] = z[q]; }
                    fwd_store1<true>(Z, base, w, z); }
            } else {
#pragma unroll 1
                for (int i = 0; i < 2; ++i) { const int j = tid + 512 * i; int base, twi; bf_geom1(j, base, twi); const cf w = TW[twi];
                    cf v[16]; inv_load1(Z, base, make_float2(w.x, -w.y), v);
#pragma unroll
                    for (int q = 0; q < 8; ++q) { const int s = j + 1024 * q; const cf y = v[bitrev(q, 16)]; const cf z1 = Z1S[s];
                        const cf x2 = conv3x2(r2, s, w20, w21, w22, cb2);
                        HYOT[(size_t)c * T + s] = (bf16_t)(pg8::cvt_pk_bf16(x2.x * (y.x + z1.x * bias1), 0.f) & 0xffffu);
                        HYOT[(size_t)c * T + SEQ + s] = (bf16_t)(pg8::cvt_pk_bf16(x2.y * (y.y + z1.y * bias1), 0.f) & 0xffffu); } }
            }
        }
    }
    __syncthreads();
}
}

namespace hy16 {
typedef _Float16 h2 __attribute__((ext_vector_type(2)));
typedef float2 cf;
typedef unsigned short bf16_t;
constexpr int N = NFFT, L = SEQ;
constexpr int ZELEMS = 17408;
constexpr int TWROW = 18;
constexpr int HLW = 2 * 4096 + 2 * 512;
constexpr int LDS_Z = 0, LDS_H = ZELEMS * 4, LDS_T2 = LDS_H + 2 * HLW * 4, LDS_T3 = LDS_T2 + 64 * TWROW * 4, LDS_HX = LDS_T3 + 4 * TWROW * 4, LDS_END = LDS_HX + 16;
constexpr float S_IN = 1.0f / 16.0f, S_H = 1.0f / 8.0f, S_OUT = 1.0f / 128.0f;
constexpr float S_IN2 = 1.0f / 128.0f, S_OUT2 = 1.0f / 16.0f;
using hy::bf_lo; using hy::bf_hi;
__device__ __forceinline__ h2 mk(float re, float im) { h2 r; r.x = (_Float16)re; r.y = (_Float16)im; return r; }
template <bool CONJ> __device__ __forceinline__ h2 cmul(h2 a, h2 b) {
    h2 t, r;
    if (!CONJ) {
        asm("v_pk_mul_f16 %0, %1, %2 op_sel:[0,0] op_sel_hi:[0,1]" : "=v"(t) : "v"(a), "v"(b));
        asm("v_pk_fma_f16 %0, %1, %2, %3 op_sel:[1,1,0] op_sel_hi:[1,0,1] neg_lo:[1,0,0]" : "=v"(r) : "v"(a), "v"(b), "v"(t));
    } else {
        asm("v_pk_mul_f16 %0, %1, %2 op_sel:[0,0] op_sel_hi:[0,1] neg_hi:[1,0]" : "=v"(t) : "v"(a), "v"(b));
        asm("v_pk_fma_f16 %0, %1, %2, %3 op_sel:[1,1,0] op_sel_hi:[1,0,1]" : "=v"(r) : "v"(a), "v"(b), "v"(t));
    }
    return r;
}
template <int SGN> __device__ __forceinline__ h2 muli(h2 a) {
    h2 r; const h2 one = {(_Float16)1.0f, (_Float16)1.0f};
    if (SGN < 0) asm("v_pk_mul_f16 %0, %1, %2 op_sel:[1,0] op_sel_hi:[0,1] neg_hi:[1,0]" : "=v"(r) : "v"(a), "v"(one));
    else         asm("v_pk_mul_f16 %0, %1, %2 op_sel:[1,0] op_sel_hi:[0,1] neg_lo:[1,0]" : "=v"(r) : "v"(a), "v"(one));
    return r;
}
template <int SGN> __device__ __forceinline__ h2 sub_muli(h2 a, h2 b) {
    h2 r;
    if (SGN < 0) asm("v_pk_add_f16 %0, %1, %2 op_sel:[1,1] op_sel_hi:[0,0] neg_lo:[0,1] neg_hi:[1,0]" : "=v"(r) : "v"(a), "v"(b));
    else         asm("v_pk_add_f16 %0, %1, %2 op_sel:[1,1] op_sel_hi:[0,0] neg_lo:[1,0] neg_hi:[0,1]" : "=v"(r) : "v"(a), "v"(b));
    return r;
}
__device__ constexpr int BR16[16] = {0, 8, 4, 12, 2, 10, 6, 14, 1, 9, 5, 13, 3, 11, 7, 15};
__device__ constexpr int BR4[4] = {0, 2, 1, 3};
#define br16(p) BR16[(p) & 15]
#define br4(p) BR4[(p) & 3]
template <int SGN> __device__ __forceinline__ h2 twc(h2 d, int tk) {
    if (tk == 0) return d;
    if (tk == 8) return muli<SGN>(d);
    const h2 w = {(_Float16)hy::C32[tk], (_Float16)((SGN < 0) ? -hy::S32[tk] : hy::S32[tk])};
    return cmul<false>(d, w);
}
template <int R, int LEN, int SGN> struct DftStage {
    static __device__ __forceinline__ void run(h2 (&v)[R]) {
        constexpr int half = LEN / 2;
#pragma unroll
        for (int blk = 0; blk < R; blk += LEN) {
#pragma unroll
            for (int k = 0; k < half; ++k) {
                const h2 a = v[blk + k], b = v[blk + k + half];
                v[blk + k] = a + b;
                v[blk + k + half] = (k * (32 / LEN) == 8) ? sub_muli<SGN>(a, b) : twc<SGN>(a - b, k * (32 / LEN));
            }
        }
        DftStage<R, LEN / 2, SGN>::run(v);
    }
};
template <int R, int SGN> struct DftStage<R, 1, SGN> { static __device__ __forceinline__ void run(h2 (&)[R]) {} };
template <int R, int SGN> __device__ __forceinline__ void dft_reg(h2 (&v)[R]) { DftStage<R, R, SGN>::run(v); }
__device__ __forceinline__ void dft16_fwd_halfzero(h2 (&v)[16]) {
#pragma unroll
    for (int k = 0; k < 8; ++k) v[k + 8] = twc<-1>(v[k], 2 * k);
    DftStage<16, 8, -1>::run(v);
}
__device__ __forceinline__ h2 mk2(_Float16 x, _Float16 y) { h2 r = {x, y}; return r; }
__device__ __forceinline__ void tw_load(const h2* row, h2 (&w)[16]) {
#pragma unroll
    for (int i = 0; i < 8; ++i) { const uint2 u = *reinterpret_cast<const uint2*>(row + 2 * i); w[2 * i] = __builtin_bit_cast(h2, u.x); w[2 * i + 1] = __builtin_bit_cast(h2, u.y); }
}
__device__ __forceinline__ void ld2(const h2* Z, int idx, h2& a, h2& b) { const uint2 u = *reinterpret_cast<const uint2*>(Z + idx); a = __builtin_bit_cast(h2, u.x); b = __builtin_bit_cast(h2, u.y); }
__device__ __forceinline__ void st2(h2* Z, int idx, h2 a, h2 b) { uint2 u; u.x = __builtin_bit_cast(unsigned, a); u.y = __builtin_bit_cast(unsigned, b); *reinterpret_cast<uint2*>(Z + idx) = u; }
__device__ __forceinline__ constexpr int eoff1(int q) { return q * 1088; }
__device__ __forceinline__ int base1(int j) { return j + 2 * (j >> 5); }
template <bool HALFZERO> __device__ __forceinline__ void fwd_store1(h2* Z, const h2 (&wa)[16], const h2 (&wb)[16], int j, h2 (&va)[16], h2 (&vb)[16]) {
    if (HALFZERO) { dft16_fwd_halfzero(va); dft16_fwd_halfzero(vb); } else { dft_reg<16, -1>(va); dft_reg<16, -1>(vb); }
    const int base = base1(j);
    st2(Z, base, va[0], vb[0]);
#pragma unroll
    for (int p = 1; p < 16; ++p) st2(Z, base + eoff1(p), cmul<false>(va[br16(p)], wa[p - 1]), cmul<false>(vb[br16(p)], wb[p - 1]));
}
__device__ __forceinline__ void inv_load1(const h2* Z, const h2 (&wa)[16], const h2 (&wb)[16], int j, h2 (&va)[16], h2 (&vb)[16]) {
    const int base = base1(j);
    ld2(Z, base, va[0], vb[0]);
#pragma unroll
    for (int p = 1; p < 16; ++p) { h2 a, b; ld2(Z, base + eoff1(p), a, b); va[p] = cmul<true>(a, wa[p - 1]); vb[p] = cmul<true>(b, wb[p - 1]); }
    dft_reg<16, 1>(va); dft_reg<16, 1>(vb);
}
__device__ __forceinline__ void wave_lds_sync() { asm volatile("s_waitcnt lgkmcnt(0)" ::: "memory"); __builtin_amdgcn_wave_barrier(); }
template <bool FWD> __device__ __forceinline__ void lds_passes(h2* Z, const h2* T2, const h2* T3, int tid) {
#pragma unroll 1
    for (int ps = 0; ps < 2; ++ps) {
        int p2 = FWD ? (ps == 0) : (ps == 1); asm volatile("" : "+s"(p2));
        const int shift = p2 ? 6 : 2, bmul = p2 ? 1088 : 68, es = p2 ? 68 : 4, ex = p2 ? 0 : 2;
        const h2* TT = p2 ? T2 : T3;
        const int b = 2 * tid, blk = b >> shift, j = b & ((1 << shift) - 1);
        const int base = bmul * blk + j + 2 * (j >> 5);
        h2 wa[16], wb[16]; tw_load(TT + j * TWROW, wa); tw_load(TT + (j + 1) * TWROW, wb);
        h2 va[16], vb[16];
        if (FWD) {
#pragma unroll
            for (int q = 0; q < 16; ++q) ld2(Z, base + q * es + (q >> 3) * ex, va[q], vb[q]);
            dft_reg<16, -1>(va); dft_reg<16, -1>(vb);
            st2(Z, base, va[0], vb[0]);
#pragma unroll
            for (int p = 1; p < 16; ++p) st2(Z, base + p * es + (p >> 3) * ex, cmul<false>(va[br16(p)], wa[p - 1]), cmul<false>(vb[br16(p)], wb[p - 1]));
        } else {
            ld2(Z, base, va[0], vb[0]);
#pragma unroll
            for (int p = 1; p < 16; ++p) { h2 a, c; ld2(Z, base + p * es + (p >> 3) * ex, a, c); va[p] = cmul<true>(a, wa[p - 1]); vb[p] = cmul<true>(c, wb[p - 1]); }
            dft_reg<16, 1>(va); dft_reg<16, 1>(vb);
#pragma unroll
            for (int q = 0; q < 16; ++q) st2(Z, base + q * es + (q >> 3) * ex, va[br16(q)], vb[br16(q)]);
        }
        wave_lds_sync();
    }
}
__device__ __forceinline__ void mid_pass(h2* Z, const h2* HL, const h2* HX, int conv, int tid) {
    const int lo8 = (tid >> 5) + 16 * ((tid >> 1) & 15), r8 = (256 - lo8) & 255;
    const int M2 = ((r8 & 15) << 8) + ((r8 >> 4) << 4) + (lo8 ? 15 : 16) - 8 * (tid & 1);
#pragma unroll 1
    for (int i = 0; i < 2; ++i) {
        const int base = 34 * tid + 16 * i;
        h2 hd[8], hm[8];
        if (conv) {
#pragma unroll
            for (int g = 0; g < 4; ++g) { const int c = 4 * i + g, m2 = M2 - c;
                ld2(HL, 18 * tid + 2 * c, hd[2 * g], hd[2 * g + 1]);
                ld2(HL, 2 * m2 + 2 * (m2 >> 3), hm[2 * g], hm[2 * g + 1]); }
            if (tid + i == 0) { const h2 x = HX[0]; hm[1] = mk2(x.x, -x.y); hm[0] = hd[1]; }
        } else {
#pragma unroll
            for (int g = 0; g < 8; ++g) { hd[g] = mk(0.f, 0.f); hm[g] = mk(0.f, 0.f); }
        }
        h2 v[16];
#pragma unroll
        for (int q = 0; q < 16; q += 2) ld2(Z, base + q, v[q], v[q + 1]);
#pragma unroll
        for (int g = 0; g < 4; ++g) { h2 u[4] = {v[4 * g], v[4 * g + 1], v[4 * g + 2], v[4 * g + 3]};
            dft_reg<4, -1>(u);
            if (conv) {
                h2 t[4];
                t[0] = cmul<false>(u[br4(0)], hd[2 * g]); t[1] = cmul<false>(u[br4(1)], hd[2 * g + 1]);
                t[2] = cmul<true>(u[br4(2)], hm[2 * g + 1]); t[3] = cmul<true>(u[br4(3)], hm[2 * g]);
                dft_reg<4, 1>(t);
                st2(Z, base + 4 * g, t[br4(0)], t[br4(1)]); st2(Z, base + 4 * g + 2, t[br4(2)], t[br4(3)]);
            } else {
                st2(Z, base + 4 * g, u[br4(0)], u[br4(1)]); st2(Z, base + 4 * g + 2, u[br4(2)], u[br4(3)]);
            }
        }
    }
}
__device__ __forceinline__ void build_tables(h2* T2, h2* T3, const cf* TWg, int tid) {
    for (int i = tid; i < 64 * 16; i += 512) { const int j = i >> 4, p = (i & 15) + 1; const cf w = TWg[(16 * j * p) & (N - 1)]; T2[j * TWROW + p - 1] = mk(w.x, w.y); }
    if (tid < 64) { const int j = tid >> 4, p = (tid & 15) + 1; const cf w = TWg[(256 * j * p) & (N - 1)]; T3[j * TWROW + p - 1] = mk(w.x, w.y); }
}
__device__ __forceinline__ void load_tw1(const cf* TWg, int tid, h2 (&wa)[16], h2 (&wb)[16]) {
#pragma unroll
    for (int k = 0; k < 15; ++k) { const cf a = TWg[(2 * tid * (k + 1)) & (N - 1)], b = TWg[((2 * tid + 1) * (k + 1)) & (N - 1)]; wa[k] = mk(a.x, a.y); wb[k] = mk(b.x, b.y); }
    wa[15] = mk(0.f, 0.f); wb[15] = mk(0.f, 0.f);
}

__device__ __forceinline__ void taps_load(const unsigned* row, int s, unsigned (&t)[4]) {
    t[0] = (s > 0) ? row[s - 1] : 0u; const uint2 bc = *reinterpret_cast<const uint2*>(row + s); t[1] = bc.x; t[2] = bc.y; t[3] = (s + 2 < SEQ) ? row[s + 2] : 0u;
}
__device__ __forceinline__ void taps_conv(const unsigned (&t)[4], float w0, float w1, float w2, float cb, cf& z0, cf& z1) {
    z0 = make_float2(cb + w0 * bf_lo(t[0]) + w1 * bf_lo(t[1]) + w2 * bf_lo(t[2]), cb + w0 * bf_hi(t[0]) + w1 * bf_hi(t[1]) + w2 * bf_hi(t[2]));
    z1 = make_float2(cb + w0 * bf_lo(t[1]) + w1 * bf_lo(t[2]) + w2 * bf_lo(t[3]), cb + w0 * bf_hi(t[1]) + w1 * bf_hi(t[2]) + w2 * bf_hi(t[3]));
}
__device__ __forceinline__ void conv3x2_pair(const unsigned* row, int s, float w0, float w1, float w2, float cb, cf& z0, cf& z1) {
    const unsigned a = (s > 0) ? row[s - 1] : 0u; const uint2 bc = *reinterpret_cast<const uint2*>(row + s); const unsigned d = (s + 2 < SEQ) ? row[s + 2] : 0u;
    z0 = make_float2(cb + w0 * bf_lo(a) + w1 * bf_lo(bc.x) + w2 * bf_lo(bc.y), cb + w0 * bf_hi(a) + w1 * bf_hi(bc.x) + w2 * bf_hi(bc.y));
    z1 = make_float2(cb + w0 * bf_lo(bc.x) + w1 * bf_lo(bc.y) + w2 * bf_lo(d), cb + w0 * bf_hi(bc.x) + w1 * bf_hi(bc.y) + w2 * bf_hi(d));
}
__device__ __forceinline__ void hyena_channel(int c, unsigned char* lds, const bf16_t* HYT2, const bf16_t* KT,
                                              const float* conv_w, const float* conv_b, const float* hbias,
                                              const h2 (&w1a)[16], const h2 (&w1b)[16], bf16_t* HYOT, const int tid) {
    h2* Z = (h2*)(lds + LDS_Z); h2* HL = (h2*)(lds + LDS_H); h2* HX = (h2*)(lds + LDS_HX); const h2* T2 = (const h2*)(lds + LDS_T2); const h2* T3 = (const h2*)(lds + LDS_T3);
    const float w00 = conv_w[0 * 1536 + c], w01 = conv_w[1 * 1536 + c], w02 = conv_w[2 * 1536 + c], cb0 = conv_b[c];
    const float w10 = conv_w[0 * 1536 + 512 + c], w11 = conv_w[1 * 1536 + 512 + c], w12 = conv_w[2 * 1536 + 512 + c], cb1 = conv_b[512 + c];
    const float w20 = conv_w[0 * 1536 + 1024 + c], w21 = conv_w[1 * 1536 + 1024 + c], w22 = conv_w[2 * 1536 + 1024 + c], cb2 = conv_b[1024 + c];
    const float bias0 = hbias[c], bias1 = hbias[512 + c];
    const unsigned* r0 = (const unsigned*)HYT2 + (size_t)c * SEQ; const unsigned* r1 = (const unsigned*)HYT2 + (size_t)(512 + c) * SEQ; const unsigned* r2 = (const unsigned*)HYT2 + (size_t)(1024 + c) * SEQ;
    h2 z1a[8], z1b[8];
#pragma unroll
    for (int q = 0; q < 8; ++q) { z1a[q] = mk(0.f, 0.f); z1b[q] = mk(0.f, 0.f); }
#ifndef REP_R0
#define REP_R0 0
#endif
#ifndef REP_SPLIT
#define REP_SPLIT 1
#endif
#pragma unroll 1
    for (int round = -REP_R0; round < 3; ++round) {
        int it = round < 0 ? 0 : round; asm volatile("" : "+s"(it));
        int j = 2 * tid; asm volatile("" : "+v"(j));
        if (it == 0) {
            const unsigned* fp = (const unsigned*)KT + (size_t)c * SEQ; const unsigned* gp = (const unsigned*)KT + (size_t)(512 + c) * SEQ;
            h2 va[16], vb[16];
#pragma unroll
            for (int q = 0; q < 8; ++q) { const uint2 w = *reinterpret_cast<const uint2*>(fp + j + 1024 * q); va[q] = mk(bf_lo(w.x), bf_hi(w.x)); vb[q] = mk(bf_lo(w.y), bf_hi(w.y)); }
#pragma unroll
            for (int q = 8; q < 16; ++q) { const int m = L - (j + 1024 * (q - 8));
                const unsigned wa_ = gp[m & (L - 1)], wb_ = gp[m - 1];
                va[q] = (m == L) ? mk(0.f, 0.f) : mk(bf_lo(wa_), bf_hi(wa_)); vb[q] = mk(bf_lo(wb_), bf_hi(wb_)); }
            fwd_store1<false>(Z, w1a, w1b, j, va, vb);
        }
        __syncthreads();
        lds_passes<true>(Z, T2, T3, tid);
        mid_pass(Z, HL + (it == 2 ? HLW : 0), HX + (it == 2 ? 1 : 0), it > 0, tid);
        if (it == 0) {
            unsigned pz[8][4];
#pragma unroll
            for (int q = 0; q < 8; ++q) taps_load(r0, j + 1024 * q, pz[q]);
            __syncthreads();
            const h2 scv = mk(0.5f * S_H, 0.5f * S_H);
            for (int rs = 0; rs < REP_SPLIT; ++rs) {
#pragma unroll 2
            for (int i = 0; i < 8; ++i) { const int m = tid + 512 * i;
                if (m != 0) {
                    const int klow = (m >> 8) + (((m >> 4) & 15) << 4) + ((m & 15) << 8);
                    const int k2 = 4096 - klow;
                    const int m2 = ((k2 & 15) << 8) + (((k2 >> 4) & 15) << 4) + (k2 >> 8);
                    h2 F0, F1, Ga, Gb; ld2(Z, 4 * m + 2 * (m >> 3), F0, F1); ld2(Z, 4 * m2 + 2 + 2 * (m2 >> 3), Ga, Gb);
                    const h2 cb = mk2(Gb.x, -Gb.y), ca = mk2(Ga.x, -Ga.y);
                    const h2 h00 = (F0 + cb) * scv, h01 = (F1 + ca) * scv;
                    const h2 d0 = F0 - cb, d1 = F1 - ca;
                    const h2 h10 = mk2(d0.y, -d0.x) * scv, h11 = mk2(d1.y, -d1.x) * scv;
                    st2(HL, 2 * m + 2 * (m >> 3), h00, h01); st2(HL, HLW + 2 * m + 2 * (m >> 3), h10, h11);
                }
            }
            if (tid == 0) {
                const h2 F0 = Z[0], F1 = Z[1], F2 = Z[2], F3 = Z[3];
                const h2 c0 = mk2(F0.x, -F0.y), c3 = mk2(F3.x, -F3.y), c2 = mk2(F2.x, -F2.y);
                const h2 e0 = F0 - c0, e1 = F1 - c3, e2 = F2 - c2;
                st2(HL, 0, (F0 + c0) * scv, (F1 + c3) * scv); st2(HL, HLW, mk2(e0.y, -e0.x) * scv, mk2(e1.y, -e1.x) * scv);
                HX[0] = (F2 + c2) * scv; HX[1] = mk2(e2.y, -e2.x) * scv;
            }
            }
            __syncthreads();
            {
                h2 va[16], vb[16];
#pragma unroll
                for (int q = 0; q < 8; ++q) { cf za, zb; taps_conv(pz[q], w00, w01, w02, cb0, za, zb); va[q] = mk(za.x * S_IN, za.y * S_IN); vb[q] = mk(zb.x * S_IN, zb.y * S_IN);
                    z1a[q] = mk(za.x, za.y); z1b[q] = mk(zb.x, zb.y); }
                fwd_store1<true>(Z, w1a, w1b, j, va, vb);
            }
        } else {
            unsigned pa[8][4];
            const unsigned* ra = (it == 1) ? r1 : r2;
#pragma unroll
            for (int q = 0; q < 8; ++q) taps_load(ra, j + 1024 * q, pa[q]);
            wave_lds_sync();
            lds_passes<false>(Z, T2, T3, tid);
            __syncthreads();
            h2 va[16], vb[16]; inv_load1(Z, w1a, w1b, j, va, vb);
            if (it == 1) {
                h2 za[16], zb[16];
#pragma unroll
                for (int q = 0; q < 8; ++q) { const int s = j + 1024 * q; const h2 ya = va[br16(q)], yb = vb[br16(q)];
                    cf x1a, x1b; taps_conv(pa[q], w10, w11, w12, cb1, x1a, x1b);
                    const cf z0a = make_float2((float)z1a[q].x, (float)z1a[q].y), z0b = make_float2((float)z1b[q].x, (float)z1b[q].y);
                    const cf oa = make_float2(x1a.x * ((float)ya.x * S_OUT + z0a.x * bias0), x1a.y * ((float)ya.y * S_OUT + z0a.y * bias0));
                    const cf ob = make_float2(x1b.x * ((float)yb.x * S_OUT + z0b.x * bias0), x1b.y * ((float)yb.y * S_OUT + z0b.y * bias0));
                    z1a[q] = mk(oa.x, oa.y); z1b[q] = mk(ob.x, ob.y);
                    za[q] = mk(oa.x * S_IN2, oa.y * S_IN2); zb[q] = mk(ob.x * S_IN2, ob.y * S_IN2); }
                fwd_store1<true>(Z, w1a, w1b, j, za, zb);
            } else {
#pragma unroll
                for (int q = 0; q < 8; ++q) { const int s = j + 1024 * q; const h2 ya = va[br16(q)], yb = vb[br16(q)];
                    const float z1x = (float)z1a[q].x, z1y = (float)z1a[q].y, z1z = (float)z1b[q].x, z1w = (float)z1b[q].y;
                    cf x2a, x2b; taps_conv(pa[q], w20, w21, w22, cb2, x2a, x2b);
                    const float oa0 = x2a.x * ((float)ya.x * S_OUT2 + z1x * bias1), oa1 = x2a.y * ((float)ya.y * S_OUT2 + z1y * bias1);
                    const float ob0 = x2b.x * ((float)yb.x * S_OUT2 + z1z * bias1), ob1 = x2b.y * ((float)yb.y * S_OUT2 + z1w * bias1);
                    *reinterpret_cast<unsigned*>(HYOT + (unsigned)(((s >> 6) * 512 + c) * 64 + (s & 63))) = pg8::cvt_pk_bf16(oa0, ob0);
                    *reinterpret_cast<unsigned*>(HYOT + (unsigned)((((SEQ + s) >> 6) * 512 + c) * 64 + (s & 63))) = pg8::cvt_pk_bf16(oa1, ob1); }
            }
        }
    }
    __syncthreads();
}
#undef br16
#undef br4
}

#define GAS __attribute__((address_space(1)))
#define LAS __attribute__((address_space(3)))
typedef unsigned short bf16;
typedef unsigned v4u __attribute__((ext_vector_type(4)));
typedef unsigned v2u __attribute__((ext_vector_type(2)));
typedef float f32x4 __attribute__((ext_vector_type(4)));
constexpr int NWAVES = 8, NTHR = 512;
constexpr size_t MiB = 1u << 20;
constexpr size_t WS_MOD = 0  , WS_MODP = 256 * 1024  ;
constexpr size_t WS_SSQQ = 2 * MiB + 256 * 1024, WS_SSQKV = 2 * MiB + 512 * 1024;
constexpr size_t WS_BAR = 128 * 1024;
constexpr size_t WS_TW = 2 * MiB;
constexpr size_t WS_CS = 3 * MiB;
constexpr size_t WS_WTIN = 5 * MiB;
constexpr size_t WS_WTO = 9 * MiB;
constexpr size_t WS_WTQB = 11 * MiB;
constexpr size_t WS_WTKVB = 11 * MiB + 512 * 1024;
constexpr size_t WS_WT3 = 12 * MiB;
constexpr size_t WS_H2 = 13 * MiB;
constexpr size_t WS_AFF = 15 * MiB;
constexpr size_t WS_IDX = 16 * MiB;
constexpr size_t WS_GATE = 16 * MiB + 128 * 1024;
constexpr size_t WS_STATS = 16 * MiB + 256 * 1024;
constexpr size_t WS_INV = 17 * MiB;
constexpr size_t WS_U1 = 18 * MiB;
constexpr size_t WS_HYOT = 18 * MiB;
constexpr size_t WS_AATT = 34 * MiB;
constexpr size_t WS_MIXED = 18 * MiB;
constexpr size_t WS_HYT = 50 * MiB;
constexpr size_t WS_APRIME = 50 * MiB;
constexpr size_t WS_XE = 50 * MiB;
constexpr size_t WS_YE = 210 * MiB;
constexpr size_t WS_KT = 98 * MiB;
constexpr size_t WS_CQ = 130 * MiB;
constexpr size_t WS_CKV = 138 * MiB;
constexpr size_t WS_KRR = 142 * MiB;
constexpr size_t WS_KR = 144 * MiB;
constexpr size_t WS_FFTS = 146 * MiB;
constexpr size_t FFTS_PER_WG = 320 * 1024;
constexpr size_t WS_WTGU = 114 * MiB;
constexpr size_t WS_WTD = 178 * MiB;
constexpr size_t WS_U2 = 210 * MiB;
constexpr size_t WS_HB = 50 * MiB;
constexpr size_t WS_Q = 226 * MiB;
constexpr size_t WS_KV = 250 * MiB;
constexpr size_t WS_X1 = WS_MIXED;
constexpr size_t WS_END = 282 * MiB;
constexpr int LDS_BYTES = 148 * 1024;

struct Params {
    const float* x; const float* c; const int* positions; const float* w_ada; const float* b_ada; const float* w_in; const float* q_norm_g; const float* w_qb;
    const float* kv_norm_g; const float* w_kvb; const float* conv_w; const float* conv_b; const float* filt_w1; const float* filt_b1; const float* filt_freq;
    const float* filt_w2; const float* filt_b2; const float* filt_w3; const float* filt_b3; const float* hyena_decay; const float* hyena_bias;
    const float* attn_out_g; const float* hyena_out_g; const float* w_o; const float* ln1_g; const float* ln1_b; const float* w_router;
    const float* w_gate; const float* w_up; const float* w_down; const float* ln2_g; const float* ln2_b;
    float* out; unsigned char* ws;
};

__device__ __forceinline__ unsigned f2bf(float f) { unsigned u = __builtin_bit_cast(unsigned, f); return (u + 0x7fffu + ((u >> 16) & 1u)) >> 16; }
__device__ __forceinline__ unsigned pk2(float lo, float hi) { return pg8::cvt_pk_bf16(lo, hi); }
__device__ __forceinline__ float bf_lo(unsigned w) { return __uint_as_float(w << 16); }
__device__ __forceinline__ float bf_hi(unsigned w) { return __uint_as_float(w & 0xffff0000u); }
__device__ __forceinline__ float wave_sum(float v) {
#pragma unroll
    for (int o = 1; o < 64; o <<= 1) v += __shfl_xor(v, o);
    return v;
}
struct Ctx { int tid, lane, wave, vcu, G, gw, NGW; unsigned char* lds; };

__device__ __forceinline__ void transpose_item(const float* __restrict__ W, int ldw, int N, bf16* WT, int ldk, int nmul, int nadd, const float* __restrict__ kscale, float* scr, int item, int lane) {
    const int nblk = N / 32, kb = item / nblk, nb = item % nblk, k0 = 64 * kb, n0 = 32 * nb;
#pragma unroll 8
    for (int i = 0; i < 32; ++i) { const int kk = 2 * i + (lane >> 5); float v = W[(size_t)(k0 + kk) * ldw + n0 + (lane & 31)]; if (kscale) v *= kscale[k0 + kk]; scr[kk * 33 + (lane & 31)] = v; }
    asm volatile("s_waitcnt lgkmcnt(0)" ::: "memory");
    const int c = lane & 7;
#pragma unroll
    for (int j = 0; j < 4; ++j) { const int n = (lane >> 3) + 8 * j; const float* s = scr + (8 * c) * 33 + n;
        v4u o; o.x = pk2(s[0 * 33], s[1 * 33]); o.y = pk2(s[2 * 33], s[3 * 33]); o.z = pk2(s[4 * 33], s[5 * 33]); o.w = pk2(s[6 * 33], s[7 * 33]);
        *(v4u*)(WT + (size_t)((n0 + n) * nmul + nadd) * ldk + k0 + 8 * c) = o; }
    asm volatile("s_waitcnt lgkmcnt(0)" ::: "memory");
}

__device__ __forceinline__ void phase0(const Params& P, const Ctx& X) {
    unsigned char* ws = P.ws;
    const int gt = X.vcu * NTHR + X.tid, NGT = X.G * NTHR;
    for (int k = gt; k < NFFT; k += NGT) { float s, c; sincospif(2.0f * (float)k / (float)NFFT, &s, &c); ((float2*)(ws + WS_TW))[k] = make_float2(c, -s); }
    { double* invf = (double*)(X.lds + 131072);
      if (X.tid < 16) { constexpr double INVF[16] = {1.0, 0.5623413251903491, 0.31622776601683794, 0.1778279410038923, 0.1, 0.05623413251903491, 0.03162277660168379, 0.01778279410038923, 0.01, 0.005623413251903491, 0.0031622776601683794, 0.0017782794100389228, 0.001, 0.0005623413251903491, 0.00031622776601683794, 0.00017782794100389227};
          invf[X.tid] = INVF[X.tid]; }
      __syncthreads();
      for (int i = gt; i < T * 16; i += NGT) { const int t = i >> 4, f = i & 15; const double ang = (double)P.positions[t] * invf[f];
          const double k = rint(ang * 0.15915494309189535); const float r = (float)(ang - k * 6.283185307179586476925);
          float sn, cs; sincosf(r, &sn, &cs); ((float2*)(ws + WS_CS))[i] = make_float2(cs, sn); } }
    for (int i = gt; i < 96 * 1024 / 8; i += NGT) ((v4u*)(ws + WS_WTIN + (size_t)IN_COLS * 1024 * 2))[i] = (v4u){0u, 0u, 0u, 0u};
    for (int i = gt; i < 2048 * 8; i += NGT) { const int r = i >> 3, cc = i & 7; ((v4u*)(ws + WS_WT3 + (size_t)r * 256 + 128))[cc] = (v4u){0u, 0u, 0u, 0u}; }
    for (int i = gt; i < 8192 * 8; i += NGT) { const int r = i >> 3, cc = i & 7; ((v4u*)(ws + WS_H2 + (size_t)r * 256 + 128))[cc] = (v4u){0u, 0u, 0u, 0u}; }
    float* scr = (float*)(X.lds + X.wave * 16384);
    {
        constexpr int I_IN = (1024 / 64) * (IN_COLS / 32), I_O = 16 * 32, I_QB = (256 / 64) * (768 / 32), I_KVB = (128 / 64) * (1024 / 32), I_3 = 1 * (2048 / 32);
        constexpr int NIT = I_IN + I_O + I_QB + I_KVB + I_3;
        for (int it = X.gw; it < NIT; it += X.NGW) {
            int r = it;
            if (r < I_IN) { transpose_item(P.w_in, IN_COLS, IN_COLS, (bf16*)(ws + WS_WTIN), 1024, 1, 0, nullptr, scr, r, X.lane); continue; } r -= I_IN;
            if (r < I_O) { transpose_item(P.w_o, 1024, 1024, (bf16*)(ws + WS_WTO), 1024, 1, 0, nullptr, scr, r, X.lane); continue; } r -= I_O;
            if (r < I_QB) { transpose_item(P.w_qb, 768, 768, (bf16*)(ws + WS_WTQB), 256, 1, 0, P.q_norm_g, scr, r, X.lane); continue; } r -= I_QB;
            if (r < I_KVB) { transpose_item(P.w_kvb, 1024, 1024, (bf16*)(ws + WS_WTKVB), 128, 1, 0, P.kv_norm_g, scr, r, X.lane); continue; } r -= I_KVB;
            { const int n0 = 32 * r, dir = n0 >> 10, o = (n0 >> 9) & 1;
              transpose_item(P.filt_w3, 2048, 2048, (bf16*)(ws + WS_WT3), 128, 2, o - (dir + o) * 1024, nullptr, scr, r, X.lane); }
        }
    }
    for (int l = X.gw; l < SEQ; l += X.NGW) {
        const int j = X.lane;
        float feat;
        { const float pos = (float)l; const int i = j;
          if (i == 0) feat = pos / (float)(SEQ - 1);
          else if (i <= 32) { const int kk = (i - 1) & 15; const float fk = 1e-4f + (float)kk * ((15.0f - 1e-4f) / 15.0f);
              const float ph = (6.283185307179586f / (float)SEQ) * pos * fk; feat = (i <= 16) ? cosf(ph) : -sinf(ph); }
          else feat = 0.f; }
        float a = P.filt_b1[j];
#pragma unroll
        for (int i = 0; i < FEMB; ++i) a += __uint_as_float(__builtin_amdgcn_readlane(__float_as_uint(feat), i)) * P.filt_w1[i * 64 + j];
        const float fr = P.filt_freq[j];
        const float h1 = sinf(fr * a);
        float b2 = P.filt_b2[j];
#pragma unroll
        for (int i = 0; i < 64; ++i) b2 += __uint_as_float(__builtin_amdgcn_readlane(__float_as_uint(h1), i)) * P.filt_w2[i * 64 + j];
        const float h2 = sinf(fr * b2);
        ((bf16*)(ws + WS_H2))[(size_t)l * 128 + j] = (bf16)f2bf(h2);
    }
    for (int it = X.gw; it < 32 * 24; it += X.NGW) {
        const int kc = it / 24, nc = it % 24, n = nc * 256 + X.lane * 4;
        f32x4 a0 = {0.f, 0.f, 0.f, 0.f}, a1 = {0.f, 0.f, 0.f, 0.f};
#pragma unroll 8
        for (int kk = 0; kk < 32; ++kk) { const int k = kc * 32 + kk; const f32x4 w = *(const f32x4*)(P.w_ada + (size_t)k * 6144 + n);
            const float c0 = P.c[k], c1 = P.c[1024 + k]; const float s0 = c0 / (1.f + __expf(-c0)), s1 = c1 / (1.f + __expf(-c1));
            a0 += w * s0; a1 += w * s1; }
        float* mp = (float*)(ws + WS_MODP);
        *(f32x4*)(mp + ((size_t)kc * 2 + 0) * 6144 + n) = a0; *(f32x4*)(mp + ((size_t)kc * 2 + 1) * 6144 + n) = a1;
    }
}

__device__ __forceinline__ void phase1(const Params& P, const Ctx& X) {
    unsigned char* ws = P.ws;
    float* modl = (float*)X.lds;
    const float* mp = (const float*)(ws + WS_MODP);
    f32x4 xv[8][4];
#pragma unroll
    for (int r = 0; r < 8; ++r) { const int m = X.gw + r * X.NGW;
        if (m < T) { const f32x4* xr = (const f32x4*)(P.x + (size_t)m * DM) + X.lane;
#pragma unroll
            for (int j = 0; j < 4; ++j) xv[r][j] = xr[64 * j]; } }
    for (int i = X.tid; i < 4096; i += NTHR) { const int b = i >> 11, n = i & 2047;
        float part[32];
#pragma unroll
        for (int kc = 0; kc < 32; ++kc) part[kc] = mp[((size_t)kc * 2 + b) * 6144 + n];
        float s = P.b_ada[n];
#pragma unroll
        for (int kc = 0; kc < 32; ++kc) s += part[kc];
        modl[i] = s; }
    for (int i0 = X.vcu * 48; i0 < 2 * 6144; i0 += X.G * 48) { const int i = i0 + X.tid;
      if (X.tid < 48 && i < 2 * 6144) { const int b = i / 6144, n = i % 6144;
        float part[32];
#pragma unroll
        for (int kc = 0; kc < 32; ++kc) part[kc] = mp[((size_t)kc * 2 + b) * 6144 + n];
        float s2 = P.b_ada[n];
#pragma unroll
        for (int kc = 0; kc < 32; ++kc) s2 += part[kc];
        ((float*)(ws + WS_MOD))[i] = s2; } }
    __syncthreads();
#pragma unroll
    for (int r = 0; r < 8; ++r) { const int m = X.gw + r * X.NGW;
        if (m < T) { const int b = m / SEQ; const float* sh = modl + b * 2048; const float* sc = sh + 1024;
            unsigned long long* o8 = (unsigned long long*)(ws + WS_U1 + (size_t)(2 * (m % SEQ) + b) * DM * 2) + X.lane;
#pragma unroll
            for (int j = 0; j < 4; ++j) { const f32x4 v = xv[r][j]; const int c0 = 4 * X.lane + 256 * j;
                const float u0 = v.x * (1.f + sc[c0]) + sh[c0], u1 = v.y * (1.f + sc[c0 + 1]) + sh[c0 + 1], u2 = v.z * (1.f + sc[c0 + 2]) + sh[c0 + 2], u3 = v.w * (1.f + sc[c0 + 3]) + sh[c0 + 3];
                o8[64 * j] = (unsigned long long)pk2(u0, u1) | ((unsigned long long)pk2(u2, u3) << 32); } } }
#pragma unroll 4
    for (int m = X.gw + 8 * X.NGW; m < T; m += X.NGW) {
        const int b = m / SEQ; const float* sh = modl + b * 2048; const float* sc = sh + 1024;
        const f32x4* xr = (const f32x4*)(P.x + (size_t)m * DM) + X.lane;
        unsigned long long* o8 = (unsigned long long*)(ws + WS_U1 + (size_t)(2 * (m % SEQ) + b) * DM * 2) + X.lane;
#pragma unroll
        for (int j = 0; j < 4; ++j) { const f32x4 v = xr[64 * j]; const int c0 = 4 * X.lane + 256 * j;
            const float u0 = v.x * (1.f + sc[c0]) + sh[c0], u1 = v.y * (1.f + sc[c0 + 1]) + sh[c0 + 1], u2 = v.z * (1.f + sc[c0 + 2]) + sh[c0 + 2], u3 = v.w * (1.f + sc[c0 + 3]) + sh[c0 + 3];
            o8[64 * j] = (unsigned long long)pk2(u0, u1) | ((unsigned long long)pk2(u2, u3) << 32); }
    }
    __syncthreads();
}

__device__ __forceinline__ void krope_pass(const Params& P, const Ctx& X) {
    unsigned char* ws = P.ws;
    const int gt = X.vcu * NTHR + X.tid, NGT = X.G * NTHR;
    const float* krr = (const float*)(ws + WS_KRR); const float2* cs = (const float2*)(ws + WS_CS); bf16* kr = (bf16*)(ws + WS_KR);
    for (int i = gt; i < T * 16; i += NGT) { const int t = i >> 4, f = i & 15;
        const float x1 = krr[t * 32 + f], x2 = krr[t * 32 + 16 + f]; const float2 c = cs[i];
        kr[t * 32 + f] = (bf16)f2bf(x1 * c.x - x2 * c.y); kr[t * 32 + 16 + f] = (bf16)f2bf(x2 * c.x + x1 * c.y); }
}

__device__ __forceinline__ void phase5(const Params& P, const Ctx& X) {
    unsigned char* ws = P.ws;
    const bf16* hyot = (const bf16*)(ws + WS_HYOT); const bf16* aatt = (const bf16*)(ws + WS_AATT); bf16* ap = (bf16*)(ws + WS_APRIME);
    float* red = (float*)X.lds;
    for (int tile = X.vcu; tile < T / 64; tile += X.G) {
        const int t0 = tile * 64;
        { const int tl = X.tid & 63, cgp = X.tid >> 6; float v[64]; float ss = 0.f;
          unsigned char* raw = X.lds + 71680;
          { const int oct = X.tid & 7, c0 = X.tid >> 3; v4u tmp[8];
#pragma unroll
            for (int i = 0; i < 8; ++i) tmp[i] = *(const v4u*)(hyot + ((size_t)tile * 512 + c0 + 64 * i) * 64 + oct * 8);
#pragma unroll
            for (int i = 0; i < 8; ++i) *(v4u*)(raw + (c0 + 64 * i) * 144 + oct * 16) = tmp[i]; }
          __syncthreads();
#pragma unroll
          for (int i = 0; i < 64; ++i) { v[i] = __uint_as_float(((unsigned)*(const unsigned short*)(raw + (cgp * 64 + i) * 144 + tl * 2)) << 16); ss += v[i] * v[i]; }
          red[cgp * 64 + tl] = ss;
          __syncthreads();
          float tot = 0.f;
#pragma unroll
          for (int g = 0; g < 8; ++g) tot += red[g * 64 + tl];
          const float rs = __builtin_amdgcn_rsqf(tot * (1.0f / 512.0f) + EPS);
          const float* gg = P.hyena_out_g + cgp * 64;
          unsigned char* stg = X.lds + 4096;
          v4u* dst = (v4u*)(stg + (size_t)tl * 1040 + cgp * 128);
#pragma unroll
          for (int i = 0; i < 8; ++i) { v4u o; o.x = pk2(v[8 * i] * rs * gg[8 * i], v[8 * i + 1] * rs * gg[8 * i + 1]); o.y = pk2(v[8 * i + 2] * rs * gg[8 * i + 2], v[8 * i + 3] * rs * gg[8 * i + 3]);
              o.z = pk2(v[8 * i + 4] * rs * gg[8 * i + 4], v[8 * i + 5] * rs * gg[8 * i + 5]); o.w = pk2(v[8 * i + 6] * rs * gg[8 * i + 6], v[8 * i + 7] * rs * gg[8 * i + 7]); dst[i] = o; }
          __syncthreads();
#pragma unroll
          for (int k = 0; k < 8; ++k) { const int r = X.wave + 8 * k; const v4u o = *(const v4u*)(stg + (size_t)r * 1040 + X.lane * 16);
              *(v4u*)(ap + (size_t)(t0 + r) * DM + 512 + X.lane * 8) = o; }
          __syncthreads(); }
        { v4u w[8]; float ss[8];
#pragma unroll
          for (int k = 0; k < 8; ++k) w[k] = *(const v4u*)(aatt + (size_t)(t0 + X.wave + 8 * k) * 512 + X.lane * 8);
#pragma unroll
          for (int k = 0; k < 8; ++k) { const float f0 = bf_lo(w[k].x), f1 = bf_hi(w[k].x), f2 = bf_lo(w[k].y), f3 = bf_hi(w[k].y), f4 = bf_lo(w[k].z), f5 = bf_hi(w[k].z), f6 = bf_lo(w[k].w), f7 = bf_hi(w[k].w);
              ss[k] = ((f0 * f0 + f1 * f1) + (f2 * f2 + f3 * f3)) + ((f4 * f4 + f5 * f5) + (f6 * f6 + f7 * f7)); }
#pragma unroll
          for (int o = 1; o < 64; o <<= 1) {
#pragma unroll
              for (int k = 0; k < 8; ++k) ss[k] += __shfl_xor(ss[k], o); }
          const float* gg = P.attn_out_g + X.lane * 8;
          const f32x4 g0 = *(const f32x4*)gg, g1 = *(const f32x4*)(gg + 4);
#pragma unroll
          for (int k = 0; k < 8; ++k) { const float rs = __builtin_amdgcn_rsqf(ss[k] * (1.0f / 512.0f) + EPS);
              v4u o; o.x = pk2(bf_lo(w[k].x) * rs * g0.x, bf_hi(w[k].x) * rs * g0.y); o.y = pk2(bf_lo(w[k].y) * rs * g0.z, bf_hi(w[k].y) * rs * g0.w);
              o.z = pk2(bf_lo(w[k].z) * rs * g1.x, bf_hi(w[k].z) * rs * g1.y); o.w = pk2(bf_lo(w[k].w) * rs * g1.z, bf_hi(w[k].w) * rs * g1.w);
              *(v4u*)(ap + (size_t)(t0 + X.wave + 8 * k) * DM + X.lane * 8) = o; } }
    }
}

struct Y1Raw { f32x4 x[4]; v2u m[4]; };
__device__ __forceinline__ void load_raw(const Params& P, const unsigned char* ws, int m, int lane, Y1Raw& r) {
    const f32x4* xr = (const f32x4*)(P.x + (size_t)m * DM) + lane;
    const v2u* mr = (const v2u*)(ws + WS_MIXED + (size_t)m * DM * 2) + lane;
#pragma unroll
    for (int j = 0; j < 4; ++j) { r.x[j] = xr[64 * j]; r.m[j] = mr[64 * j]; }
}
__device__ __forceinline__ void make_y1(const Y1Raw& r, int lane, const float* mod_b, f32x4 (&y)[4]) {
    const float* g1 = mod_b + 2 * 1024;
#pragma unroll
    for (int j = 0; j < 4; ++j) { const f32x4 xv = r.x[j]; const v2u mw = r.m[j]; const f32x4 gv = *(const f32x4*)(g1 + 4 * lane + 256 * j);
        y[j].x = DN_ALPHA * xv.x + gv.x * bf_lo(mw.x); y[j].y = DN_ALPHA * xv.y + gv.y * bf_hi(mw.x); y[j].z = DN_ALPHA * xv.z + gv.z * bf_lo(mw.y); y[j].w = DN_ALPHA * xv.w + gv.w * bf_hi(mw.y); }
}
__device__ __forceinline__ void load_y1(const Params& P, const unsigned char* ws, int m, int lane, const float* mod_b, f32x4 (&y)[4]) {
    Y1Raw r; load_raw(P, ws, m, lane, r); make_y1(r, lane, mod_b, y);
}
__device__ __forceinline__ void row_stats(const f32x4 (&y)[4], float& mean, float& rstd) {
    float s = 0.f, q = 0.f;
#pragma unroll
    for (int j = 0; j < 4; ++j) { s += (y[j].x + y[j].y) + (y[j].z + y[j].w); q += (y[j].x * y[j].x + y[j].y * y[j].y) + (y[j].z * y[j].z + y[j].w * y[j].w); }
#pragma unroll
    for (int o = 1; o < 64; o <<= 1) { s += __shfl_xor(s, o); q += __shfl_xor(q, o); }
    mean = s * (1.0f / DM); const float var = fmaxf(q * (1.0f / DM) - mean * mean, 0.f); rstd = 1.0f / sqrtf(var + EPS);
}
__device__ __forceinline__ void phase7(const Params& P, const Ctx& X) {
    unsigned char* ws = P.ws;
    float* wr = (float*)X.lds;
    for (int i = X.tid; i < 1024 * 16; i += NTHR) wr[(i & 15) * 1024 + (i >> 4)] = P.w_router[i];
    __syncthreads();
    const float* mod = (const float*)(ws + WS_MOD);
    int m = X.gw;
    Y1Raw raw; if (m < T) load_raw(P, ws, m, X.lane, raw);
    for (; m < T; m += X.NGW) {
        const int b = m / SEQ; const float* mb = mod + b * 6144;
        f32x4 y[4]; make_y1(raw, X.lane, mb, y);
        if (m + X.NGW < T) load_raw(P, ws, m + X.NGW, X.lane, raw);
        float mean, rstd; row_stats(y, mean, rstd);
        if (X.lane == 0) ((float2*)(ws + WS_STATS))[m] = make_float2(mean, rstd);
        float lg[16];
#pragma unroll
        for (int e = 0; e < 16; ++e) lg[e] = 0.f;
        unsigned long long* o8 = (unsigned long long*)(ws + WS_U2 + (size_t)m * DM * 2) + X.lane;
        unsigned long long* x8 = (unsigned long long*)(ws + WS_X1 + (size_t)m * DM * 2) + X.lane;
#pragma unroll
        for (int j = 0; j < 4; ++j) { const int c0 = 4 * X.lane + 256 * j;
            const f32x4 g = *(const f32x4*)(P.ln1_g + c0), bb = *(const f32x4*)(P.ln1_b + c0), sh = *(const f32x4*)(mb + 3 * 1024 + c0), sc = *(const f32x4*)(mb + 4 * 1024 + c0);
            f32x4 u; u = ((y[j] - mean) * rstd * g + bb);
            x8[64 * j] = (unsigned long long)pk2(u.x, u.y) | ((unsigned long long)pk2(u.z, u.w) << 32);
            u = u * (sc + 1.0f) + sh;
            o8[64 * j] = (unsigned long long)pk2(u.x, u.y) | ((unsigned long long)pk2(u.z, u.w) << 32);
#pragma unroll
            for (int e = 0; e < 16; ++e) { const f32x4 w = *(const f32x4*)(wr + e * 1024 + c0); lg[e] += (u.x * w.x + u.y * w.y) + (u.z * w.z + u.w * w.w); } }
#pragma unroll
        for (int n = 8, B = 32; n >= 1; n >>= 1, B >>= 1) { const bool up = (X.lane & B) != 0;
#pragma unroll
            for (int i = 0; i < n; ++i) { const float lo = lg[i], hi = lg[i + n]; const float send = up ? lo : hi, keep = up ? hi : lo; lg[i] = keep + __shfl_xor(send, B); } }
        float lv = lg[0]; lv += __shfl_xor(lv, 2); lv += __shfl_xor(lv, 1);
        float mx = lv;
#pragma unroll
        for (int o = 4; o < 64; o <<= 1) mx = fmaxf(mx, __shfl_xor(mx, o));
        const float ex = expf(lv - mx); float den = ex;
#pragma unroll
        for (int o = 4; o < 64; o <<= 1) den += __shfl_xor(den, o);
        const int e = ((X.lane >> 5) & 1) * 8 + ((X.lane >> 4) & 1) * 4 + ((X.lane >> 3) & 1) * 2 + ((X.lane >> 2) & 1);
        if ((X.lane & 3) == 0) ((float*)(ws + WS_AFF))[(size_t)m * 16 + e] = ex / den;
    }
    __syncthreads();
}

__device__ __forceinline__ int block_excl_scan(int v, int& total, volatile int* sh, const Ctx& X) {
    int inc = v;
#pragma unroll
    for (int o = 1; o < 64; o <<= 1) { const int t = __shfl_up(inc, o); if (X.lane >= o) inc += t; }
    __syncthreads();
    if (X.lane == 63) sh[X.wave] = inc;
    __syncthreads();
    int base = 0, tot = 0;
#pragma unroll
    for (int w = 0; w < NWAVES; ++w) { const int c = sh[w]; if (w < X.wave) base += c; tot += c; }
    total = tot;
    return base + inc - v;
}
__device__ __forceinline__ void topk_be(const Params& P, const Ctx& X, int be) {
    unsigned char* ws = P.ws;
    const int b = be >> 4, e = be & 15;
    volatile int* sh = (volatile int*)X.lds;
    const float* aff = (const float*)(ws + WS_AFF) + ((size_t)b * SEQ + 16 * X.tid) * 16 + e;
    unsigned u[16];
#pragma unroll
    for (int i = 0; i < 16; ++i) u[i] = __float_as_uint(aff[i * 16]);
    unsigned Tv = 0u;
    for (int bit = 30; bit >= 0; --bit) {
        const unsigned cand = Tv | (1u << bit);
        int c = 0;
#pragma unroll
        for (int i = 0; i < 16; ++i) c += (u[i] >= cand) ? 1 : 0;
        c = (int)wave_sum((float)c);
        volatile int* slot = sh + 16 + 16 * (bit & 1);
        if (X.lane == 0) slot[X.wave] = c;
        __syncthreads();
        int tot = 0;
#pragma unroll
        for (int w = 0; w < NWAVES; ++w) tot += slot[w];
        if (tot >= CAP) Tv = cand;
    }
    int ngt = 0, neq = 0;
#pragma unroll
    for (int i = 0; i < 16; ++i) { ngt += (u[i] > Tv) ? 1 : 0; neq += (u[i] == Tv) ? 1 : 0; }
    int tot_gt, tot_eq;
    const int eq_before = block_excl_scan(neq, tot_eq, sh, X);
    (void)block_excl_scan(ngt, tot_gt, sh, X);
    const int need_eq = CAP - tot_gt;
    int nsel = 0; unsigned selmask = 0u; int er = eq_before;
#pragma unroll
    for (int i = 0; i < 16; ++i) { bool sel = u[i] > Tv; if (u[i] == Tv) { sel = er < need_eq; ++er; } if (sel) { selmask |= 1u << i; ++nsel; } }
    int tot_sel;
    int slot0 = block_excl_scan(nsel, tot_sel, sh, X);
    int* idx = (int*)(ws + WS_IDX) + be * CAP; float* gate = (float*)(ws + WS_GATE) + be * CAP; int* inv = (int*)(ws + WS_INV) + ((size_t)b * SEQ + 16 * X.tid) * 16 + e;
#pragma unroll
    for (int i = 0; i < 16; ++i) { const bool sel = (selmask >> i) & 1u;
        if (sel) { idx[slot0] = 16 * X.tid + i; gate[slot0] = __uint_as_float(u[i]); }
        inv[i * 16] = sel ? slot0 : -1;
        slot0 += sel ? 1 : 0; }
    __syncthreads();
}

__device__ __forceinline__ void transpose_item64(const float* __restrict__ W, int ldw, bf16* WT, int ldk, int nmul, int nadd, float* scr, int k0, int n0, int lane) {
    f32x4 v[16];
    const int kr = lane >> 4, nc = 4 * (lane & 15);
#pragma unroll
    for (int i = 0; i < 16; ++i) v[i] = *(const f32x4*)(W + (size_t)(k0 + 4 * i + kr) * ldw + n0 + nc);
#pragma unroll
    for (int i = 0; i < 16; ++i) { const int k = 4 * i + kr;
        scr[(nc + 0) * 65 + k] = v[i].x; scr[(nc + 1) * 65 + k] = v[i].y; scr[(nc + 2) * 65 + k] = v[i].z; scr[(nc + 3) * 65 + k] = v[i].w; }
    asm volatile("s_waitcnt lgkmcnt(0)" ::: "memory");
    const int c = lane & 7;
#pragma unroll
    for (int j = 0; j < 8; ++j) { const int n = 8 * j + (lane >> 3); const float* sp = scr + n * 65 + 8 * c;
        v4u o; o.x = pk2(sp[0], sp[1]); o.y = pk2(sp[2], sp[3]); o.z = pk2(sp[4], sp[5]); o.w = pk2(sp[6], sp[7]);
        *(v4u*)(WT + (size_t)((n0 + n) * nmul + nadd) * ldk + k0 + 8 * c) = o; }
    asm volatile("s_waitcnt lgkmcnt(0)" ::: "memory");
}
__device__ __forceinline__ void expert_weight_copies(const Params& P, const Ctx& X, int wg_rel, int nwg) {
    unsigned char* ws = P.ws;
    float* scr = (float*)(X.lds + X.wave * 16640);
    constexpr int I_E = 16 * 16;
    const int gw = wg_rel * NWAVES + X.wave, ngw = nwg * NWAVES;
    for (int it = gw; it < 48 * I_E; it += ngw) {
        const int mat = it / I_E, r = it % I_E, e = mat / 3, which = mat % 3;
        const int pnl = r >> 3, w8 = r & 7, k0 = 256 * (pnl >> 3) + 64 * (w8 >> 1), n0 = 128 * (pnl & 7) + 64 * (w8 & 1);
        if (which == 0) transpose_item64(P.w_gate + (size_t)e * 1048576, 1024, (bf16*)(ws + WS_WTGU) + (size_t)e * 2048 * 1024, 1024, 2, 0, scr, k0, n0, X.lane);
        else if (which == 1) transpose_item64(P.w_up + (size_t)e * 1048576, 1024, (bf16*)(ws + WS_WTGU) + (size_t)e * 2048 * 1024, 1024, 2, 1, scr, k0, n0, X.lane);
        else transpose_item64(P.w_down + (size_t)e * 1048576, 1024, (bf16*)(ws + WS_WTD) + (size_t)e * 1024 * 1024, 1024, 1, 0, scr, k0, n0, X.lane);
    }
}

__device__ __forceinline__ void phase9(const Params& P, const Ctx& X) {
    unsigned char* ws = P.ws;
    const int* idx = (const int*)(ws + WS_IDX);
#pragma unroll 4
    for (int r = X.gw; r < 32 * CAP; r += X.NGW) { const int b = r >> 14; const int s = idx[r];
        const v4u* src = (const v4u*)(ws + WS_U2 + ((size_t)b * SEQ + s) * DM * 2) + X.lane; v4u* dst = (v4u*)(ws + WS_XE + (size_t)r * DM * 2) + X.lane;
        dst[0] = src[0]; dst[64] = src[64]; }
}

__device__ __forceinline__ void phase12(const Params& P, const Ctx& X) {
    unsigned char* ws = P.ws;
    const float* mod = (const float*)(ws + WS_MOD); const int* inv = (const int*)(ws + WS_INV);
    int m = X.gw;
    int myinv = (m < T && X.lane < 16) ? inv[(size_t)m * 16 + X.lane] : -1;
    v2u x1r[4];
    if (m < T) { const v2u* xp = (const v2u*)(ws + WS_X1 + (size_t)m * DM * 2) + X.lane;
#pragma unroll
        for (int j = 0; j < 4; ++j) x1r[j] = xp[64 * j]; }
    for (; m < T; m += X.NGW) {
        const int b = m / SEQ; const float* mb = mod + b * 6144;
        unsigned msk = (unsigned)(__ballot(myinv >= 0) & 0xffffull);
        const int cnt = __popc(msk);
        int sl[4];
#pragma unroll
        for (int i = 0; i < 4; ++i) { sl[i] = -1; if (msk) { const int e = __ffs(msk) - 1; msk &= msk - 1; sl[i] = (b * 16 + e) * CAP + __shfl(myinv, e); } }
        v2u yr[4][4];
#pragma unroll
        for (int i = 0; i < 4; ++i) if (cnt > i) { const v2u* p = (const v2u*)(ws + WS_YE + (size_t)sl[i] * DM * 2) + X.lane;
#pragma unroll
            for (int j = 0; j < 4; ++j) yr[i][j] = p[64 * j]; }
        f32x4 y[4];
#pragma unroll
        for (int j = 0; j < 4; ++j) { y[j].x = bf_lo(x1r[j].x); y[j].y = bf_hi(x1r[j].x); y[j].z = bf_lo(x1r[j].y); y[j].w = bf_hi(x1r[j].y); }
        const int nm = m + X.NGW;
        if (nm < T) { const v2u* xp = (const v2u*)(ws + WS_X1 + (size_t)nm * DM * 2) + X.lane;
#pragma unroll
            for (int j = 0; j < 4; ++j) x1r[j] = xp[64 * j]; }
        const int ninv = (nm < T && X.lane < 16) ? inv[(size_t)nm * 16 + X.lane] : -1;
        f32x4 f[4];
#pragma unroll
        for (int j = 0; j < 4; ++j) f[j] = (f32x4){0.f, 0.f, 0.f, 0.f};
#pragma unroll
        for (int i = 0; i < 4; ++i) if (cnt > i) {
#pragma unroll
            for (int j = 0; j < 4; ++j) { const v2u w = yr[i][j]; f[j].x += bf_lo(w.x); f[j].y += bf_hi(w.x); f[j].z += bf_lo(w.y); f[j].w += bf_hi(w.y); } }
        while (msk) { const int e = __ffs(msk) - 1; msk &= msk - 1; const int r = (b * 16 + e) * CAP + __shfl(myinv, e);
            const v2u* p = (const v2u*)(ws + WS_YE + (size_t)r * DM * 2) + X.lane;
#pragma unroll
            for (int j = 0; j < 4; ++j) { const v2u w = p[64 * j]; f[j].x += bf_lo(w.x); f[j].y += bf_hi(w.x); f[j].z += bf_lo(w.y); f[j].w += bf_hi(w.y); } }
#pragma unroll
        for (int j = 0; j < 4; ++j) { const int c0 = 4 * X.lane + 256 * j;
            const f32x4 g2 = *(const f32x4*)(mb + 5 * 1024 + c0);
            y[j] = y[j] * DN_ALPHA + g2 * f[j]; }
        float mean, rstd; row_stats(y, mean, rstd);
#pragma unroll
        for (int j = 0; j < 4; ++j) y[j] = y[j] - mean;
        f32x4* orow = (f32x4*)(P.out + (size_t)m * DM) + X.lane;
#pragma unroll
        for (int j = 0; j < 4; ++j) { const int c0 = 4 * X.lane + 256 * j; const f32x4 g = *(const f32x4*)(P.ln2_g + c0), bb = *(const f32x4*)(P.ln2_b + c0);
            orow[64 * j] = y[j] * rstd * g + bb; }
        myinv = ninv;
    }
}

#ifndef DBG_LAST_PHASE
#define DBG_LAST_PHASE 99
#endif
#define XB_TMO      128
#define XB_XCNT(j)  (256  + 64 * (j))
#define XB_XSUB(j)  (1280 + 64 * (j))
#define XB_XGEN(j)  (2304 + 64 * (j))
#define XB_TOP      3328
#define XB_TOPGEN   3392
#define XCD_BAR_WORDS 3456
#define XB_SPIN_CAP (1u << 18)

__device__ __forceinline__ unsigned xb_ld(unsigned* p)              { return __hip_atomic_load(p, __ATOMIC_RELAXED, __HIP_MEMORY_SCOPE_AGENT); }
__device__ __forceinline__ unsigned xb_add(unsigned* p, unsigned v) { return __hip_atomic_fetch_add(p, v, __ATOMIC_RELAXED, __HIP_MEMORY_SCOPE_AGENT); }
__device__ __forceinline__ unsigned xb_xcc_id() { return (unsigned)__builtin_amdgcn_s_getreg((3 << 11) | 20) & 0xFu; }
#define XB_SPIN(cond, bar) do { unsigned _sp = 0; while (cond) { __builtin_amdgcn_s_sleep(1); \
    if ((++_sp & 255u) == 0u) { if (xb_ld(&(bar)[XB_TMO])) break; if (_sp > XB_SPIN_CAP) { atomicAdd(&(bar)[XB_TMO], 1u); break; } } } } while (0)

struct XcdBarrier {
    unsigned* bar; unsigned x;
    volatile LAS unsigned* st;
};

__device__ __forceinline__ XcdBarrier xcd_barrier_post(unsigned* bar, volatile LAS unsigned* st) {
    XcdBarrier b; b.bar = bar; b.x = xb_xcc_id(); b.st = st;
    if (threadIdx.x == 0) (void)xb_add(&bar[XB_XCNT(b.x)], 1u);
    return b;
}
__device__ __forceinline__ void xcd_barrier_complete(unsigned* bar, unsigned x, unsigned& nloc, unsigned& nx) {
    const unsigned G = gridDim.x * gridDim.y * gridDim.z;
    unsigned sum, cnt, mine, sp = 0u;
    for (;;) {
        sum = 0u; cnt = 0u; mine = 0u;
#pragma unroll
        for (unsigned j = 0; j < 16; ++j) { const unsigned c = xb_ld(&bar[XB_XCNT(j)]); sum += c; cnt += (c > 0u) ? 1u : 0u; mine = (j == x) ? c : mine; }
        if (sum == G) break;
        __builtin_amdgcn_s_sleep(1);
        if ((++sp & 255u) == 0u) { if (xb_ld(&bar[XB_TMO])) break; if (sp > XB_SPIN_CAP) { atomicAdd(&bar[XB_TMO], 1u); break; } }
    }
    nloc = mine > 0u ? mine : 1u; nx = cnt > 0u ? cnt : 1u;
}

__device__ __forceinline__ void xcd_barrier(const XcdBarrier& b) {
    asm volatile("s_waitcnt vmcnt(0)" ::: "memory");
    __syncthreads();
    if (threadIdx.x == 0) {
        unsigned* bar = b.bar;
        __builtin_amdgcn_s_waitcnt(0);
        unsigned nloc = b.st[0], nx = b.st[1];
        if (nloc == 0u) { xcd_barrier_complete(bar, b.x, nloc, nx); b.st[0] = nloc; b.st[1] = nx; }
        const unsigned old = xb_add(&bar[XB_XSUB(b.x)], 1u);
        const unsigned gen = old / nloc;
        if (old + 1u == (gen + 1u) * nloc) {
            __builtin_amdgcn_fence(__ATOMIC_RELEASE, "agent");
            asm volatile("s_waitcnt vmcnt(0)" ::: "memory");
            const unsigned og = xb_add(&bar[XB_TOP], 1u);
            const unsigned tg = og / nx;
            if (og + 1u == (tg + 1u) * nx) xb_add(&bar[XB_TOPGEN], 1u);
            else XB_SPIN(xb_ld(&bar[XB_TOPGEN]) == tg, bar);
            __builtin_amdgcn_fence(__ATOMIC_ACQUIRE, "agent");
            xb_add(&bar[XB_XGEN(b.x)], 1u);
            asm volatile("s_waitcnt vmcnt(0)" ::: "memory");
        } else {
            XB_SPIN(xb_ld(&bar[XB_XGEN(b.x)]) == gen, bar);
            __builtin_amdgcn_fence(__ATOMIC_ACQUIRE, "agent");
            asm volatile("s_waitcnt vmcnt(0)" ::: "memory");
        }
    }
    __syncthreads();
}

#ifndef ATTN_V2
#define ATTN_V2 1
#endif
#ifndef P6_ALIGN
#define P6_ALIGN true
#endif
#ifndef EXP_WGM
#define EXP_WGM 4
#endif
#ifndef HY16
#define HY16 1
#endif
#ifndef REP_P0
#define REP_P0 1
#endif
#ifndef REP_P1
#define REP_P1 1
#endif
#ifndef REP_P2
#define REP_P2 1
#endif
#ifndef REP_P3
#define REP_P3 1
#endif
#ifndef REP_P4
#define REP_P4 1
#endif
#ifndef REP_P5
#define REP_P5 1
#endif
#ifndef REP_P6
#define REP_P6 1
#endif
#ifndef REP_P7
#define REP_P7 1
#endif
#ifndef REP_P8
#define REP_P8 1
#endif
#ifndef REP_P9
#define REP_P9 1
#endif
#ifndef REP_P10
#define REP_P10 1
#endif
#ifndef REP_P11
#define REP_P11 1
#endif
#ifndef REP_P12
#define REP_P12 1
#endif
#ifndef REP_HY
#define REP_HY 1
#endif
typedef const __attribute__((address_space(4))) Params* KParams;
__device__ __forceinline__ KParams launder_kp(KParams p) { asm volatile("" : "+s"(p)); return p; }
__device__ __forceinline__ Params load_params(KParams p) { Params r{};
#if defined(__HIP_DEVICE_COMPILE__)
    r = *launder_kp(p);
#endif
    return r; }
#define LOADP() const Params P = load_params(kp); unsigned char* ws = P.ws; MKCTX()
__global__ void __launch_bounds__(NTHR, 2) fwd_megakernel(Params Pv) {
    extern __shared__ __attribute__((aligned(16))) unsigned char lds[];
    cg::grid_group grid = cg::this_grid();
    const int wave0 = __builtin_amdgcn_readfirstlane(threadIdx.x >> 6);
#define MKCTX() Ctx X; { int w_ = wave0; asm volatile("" : "+s"(w_)); X.wave = w_; unsigned m_ = ~0u; asm volatile("" : "+s"(m_)); X.lane = __builtin_amdgcn_mbcnt_hi(m_, __builtin_amdgcn_mbcnt_lo(m_, 0u)); X.tid = w_ * 64 + X.lane; \
    X.G = gridDim.x; const int bx_ = blockIdx.x; X.vcu = (X.G % 8 == 0) ? (bx_ % 8) * (X.G / 8) + bx_ / 8 : bx_; X.gw = X.vcu * NWAVES + X.wave; X.NGW = X.G * NWAVES; X.lds = lds; }
    KParams kp = (KParams)__builtin_amdgcn_kernarg_segment_ptr();
    volatile LAS unsigned* bar_st = (volatile LAS unsigned*)((LAS unsigned char*)lds + (LDS_BYTES - 64));
    if (threadIdx.x < 2) bar_st[threadIdx.x] = 0u;
    __syncthreads();
    XcdBarrier xbar; xbar.bar = nullptr; xbar.x = 0; xbar.st = bar_st;
    PG8_LAS unsigned char* ring = (PG8_LAS unsigned char*)lds;

    for (int rep = 0; rep < REP_P0; ++rep) {
    { LOADP(); if (blockIdx.x == 0) for (int i = X.tid; i < XCD_BAR_WORDS; i += NTHR) ((unsigned*)(ws + WS_BAR))[i] = 0u; phase0(P, X); }
    grid.sync(); if (rep + 1 == REP_P0) { LOADP(); (void)X; xbar = xcd_barrier_post((unsigned*)(ws + WS_BAR), bar_st); }
    }
    for (int rep = 0; rep < REP_P1; ++rep) {
    { LOADP(); (void)ws; phase1(P, X); }
    xcd_barrier(xbar);
    }
    for (int rep = 0; rep < REP_P2; ++rep) {
    { LOADP();
        { pg8::Gemm g{(const pg8::bf16_t*)(ws + WS_U1), (const pg8::bf16_t*)(ws + WS_WTIN), T, IN_PAD, 1024, 1024, 1024, 1 << 30, 1, 0, nullptr, 0, 0};
          pg8::StaticOrder S; S.init(T, IN_PAD, X.G, (int)blockIdx.x);
          epi::EpiIn E{(pg8::bf16_t*)(ws + WS_CQ), (pg8::bf16_t*)(ws + WS_CKV), (float*)(ws + WS_KRR), (pg8::bf16_t*)(ws + WS_HYT), (float*)(ws + (rep ? WS_FFTS : WS_SSQQ)), (float*)(ws + (rep ? WS_FFTS + 65536 : WS_SSQKV)), ring + pg8::STAGE_BYTES};
          pg8::gemm_phase<epi::EpiIn, pg8::StaticOrder, true, true>(ring, g, S, E, X.tid); }
        __syncthreads();
        { pg8::Gemm g{(const pg8::bf16_t*)(ws + WS_H2), (const pg8::bf16_t*)(ws + WS_WT3), SEQ, 2048, 128, 128, 128, 1 << 30, 1, 0, nullptr, 0, 0};
          pg8::StaticOrder S; S.init(SEQ, 2048, X.G, (int)blockIdx.x);
          epi::EpiFilt E{(unsigned*)(ws + WS_KT), P.filt_b3, P.hyena_decay};
          pg8::gemm_phase<epi::EpiFilt, pg8::StaticOrder, true, true>(ring, g, S, E, X.tid); }
    }
    xcd_barrier(xbar);
    }
    for (int rep = 0; rep < REP_P3; ++rep) {
    { LOADP();
        { pg8::Gemm g{(const pg8::bf16_t*)(ws + WS_CQ), (const pg8::bf16_t*)(ws + WS_WTQB), T, 768, 256, 256, 256, 1 << 30, 1, 0, nullptr, 0, 0};
          pg8::StaticOrder S; S.init(T, 768, X.G, (int)blockIdx.x);
          epi::EpiRowScale E{(pg8::bf16_t*)(ws + WS_Q), 768, (const float*)(ws + WS_SSQQ), 1.0f / 256.0f, ATTN_V2 ? attn2::C2 : 1.0f};
          pg8::gemm_phase<epi::EpiRowScale, pg8::StaticOrder, true, true>(ring, g, S, E, X.tid); }
        __syncthreads();
        { pg8::Gemm g{(const pg8::bf16_t*)(ws + WS_CKV), (const pg8::bf16_t*)(ws + WS_WTKVB), T, 1024, 128, 128, 128, 1 << 30, 1, 0, nullptr, 0, 0};
          pg8::StaticOrder S; S.init(T, 1024, X.G, (int)blockIdx.x);
          epi::EpiRowScale E{(pg8::bf16_t*)(ws + WS_KV), 1024, (const float*)(ws + WS_SSQKV), 1.0f / 128.0f, 1.0f};
          pg8::gemm_phase<epi::EpiRowScale, pg8::StaticOrder, true, true>(ring, g, S, E, X.tid); }
        __syncthreads();
        krope_pass(P, X);
        __syncthreads();
#if HY16
        hy16::build_tables((hy16::h2*)(lds + hy16::LDS_T2), (hy16::h2*)(lds + hy16::LDS_T3), (const hy16::cf*)(ws + WS_TW), X.tid);
        hy16::h2 w1a[16], w1b[16]; hy16::load_tw1((const hy16::cf*)(ws + WS_TW), X.tid, w1a, w1b);
        __syncthreads();
        if ((X.tid >> 6) < 4) __builtin_amdgcn_s_setprio(2);
        for (int rh = 0; rh < REP_HY; ++rh)
        for (int c = X.vcu; c < HW; c += X.G) {
            hy16::hyena_channel(c, lds, (const hy16::bf16_t*)(ws + WS_HYT), (const hy16::bf16_t*)(ws + WS_KT), P.conv_w, P.conv_b, P.hyena_bias,
                                w1a, w1b, (hy16::bf16_t*)(ws + WS_HYOT), X.tid);
        }
        __builtin_amdgcn_s_setprio(0);
    }
#else
        { hy::cf* twl = (hy::cf*)(lds + hy::ZELEMS * 8);
          for (int i = X.tid; i < 1024; i += NTHR) twl[i] = ((const hy::cf*)(ws + WS_TW))[i]; }
        __syncthreads();
        for (int rh = 0; rh < REP_HY; ++rh)
        for (int c = X.vcu; c < HW; c += X.G) {
            unsigned char* fs = ws + WS_FFTS + (size_t)blockIdx.x * FFTS_PER_WG;
            hy::hyena_channel(c, (hy::cf*)lds, (const hy::cf*)(lds + hy::ZELEMS * 8), (const hy::bf16_t*)(ws + WS_HYT), (const hy::bf16_t*)(ws + WS_KT), P.conv_w, P.conv_b, P.hyena_bias,
                              (hy::cf*)fs, (hy::cf*)(fs + 256 * 1024), (hy::bf16_t*)(ws + WS_HYOT), X.tid);
        }
    }
#endif
    xcd_barrier(xbar);
    }
    for (int rep = 0; rep < REP_P4; ++rep) {
    { LOADP();
        for (int u = X.vcu; u < BATCH * NH * (SEQ / 256); u += X.G) {
            const int bh = u >> 5, qb = u & 31, b = bh >> 3, h = bh & 7;
#if ATTN_V2
#ifdef ATTN_PRIO
            if (X.wave < 4) __builtin_amdgcn_s_setprio(ATTN_PRIO);
#endif
            attn2::attn_unit<8>(b, h, qb, (const attn2::bf16*)(ws + WS_Q), (const attn2::bf16*)(ws + WS_KV), (const attn2::bf16*)(ws + WS_KR), (const float*)(ws + WS_CS),
                                (attn2::bf16*)(ws + WS_AATT), (char*)lds, X.tid);
#ifdef ATTN_PRIO
            __builtin_amdgcn_s_setprio(0);
#endif
#else
            attn::attn_unit((const attn::bf16_t*)(ws + WS_Q), (const attn::bf16_t*)(ws + WS_KV), (const attn::bf16_t*)(ws + WS_KR), (const float*)(ws + WS_CS),
                            (attn::bf16_t*)(ws + WS_AATT), h, (long)b * SEQ + qb * 256, (long)b * SEQ, SEQ, (char*)lds, X.tid);
#endif
        }
    }
    xcd_barrier(xbar);
    }
    for (int rep = 0; rep < REP_P5; ++rep) {
    { LOADP(); (void)ws; phase5(P, X); }
    xcd_barrier(xbar);
    }
    for (int rep = 0; rep < REP_P6; ++rep) {
    { LOADP();
        pg8::Gemm g{(const pg8::bf16_t*)(ws + WS_APRIME), (const pg8::bf16_t*)(ws + WS_WTO), T, 1024, 1024, 1024, 1024, 1 << 30, 1, 0, nullptr, 0, 0};
        pg8::StaticOrder S; S.init(T, 1024, X.G, (int)blockIdx.x);
        epi::EpiRowScale E{(pg8::bf16_t*)(ws + WS_MIXED), 1024, nullptr, 0.f, 1.0f};
        pg8::gemm_phase<epi::EpiRowScale, pg8::StaticOrder, P6_ALIGN, true>(ring, g, S, E, X.tid);
    }
    xcd_barrier(xbar);
    }
    for (int rep = 0; rep < REP_P7; ++rep) {
    { LOADP(); (void)ws; phase7(P, X); }
    xcd_barrier(xbar);
    }
    for (int rep = 0; rep < REP_P8; ++rep) {
    { LOADP();
#ifndef REP_TOPK
#define REP_TOPK 1
#endif
#ifndef REP_CONV
#define REP_CONV 1
#endif
        if (X.G >= 64) { if (blockIdx.x < 32) { for (int q = 0; q < REP_TOPK; ++q) topk_be(P, X, blockIdx.x); } else { for (int q = 0; q < REP_CONV; ++q) expert_weight_copies(P, X, blockIdx.x - 32, X.G - 32); } }
        else { for (int be = blockIdx.x; be < 32; be += X.G) topk_be(P, X, be); expert_weight_copies(P, X, blockIdx.x, X.G); }
    }
    xcd_barrier(xbar);
    }
    for (int rep = 0; rep < REP_P10; ++rep) {
    { LOADP();
        pg8::Gemm g{(const pg8::bf16_t*)(ws + WS_U2), (const pg8::bf16_t*)(ws + WS_WTGU), 32 * CAP, 2048, 1024, 1024, 1024, 4, 16, (size_t)2048 * 1024 * 2, (const int*)(ws + WS_IDX), 14, SEQ};
        pg8::StaticOrder S; S.init(32 * CAP, 2048, X.G, (int)blockIdx.x, EXP_WGM);
        epi::EpiGU E{(pg8::bf16_t*)(ws + WS_HB)};
        pg8::gemm_phase<epi::EpiGU, pg8::StaticOrder, true, true, true>(ring, g, S, E, X.tid);
    }
    xcd_barrier(xbar);
    }
    for (int rep = 0; rep < REP_P11; ++rep) {
    { LOADP();
        pg8::Gemm g{(const pg8::bf16_t*)(ws + WS_HB), (const pg8::bf16_t*)(ws + WS_WTD), 32 * CAP, 1024, 1024, 1024, 1024, 4, 16, (size_t)1024 * 1024 * 2, nullptr, 0, 0};
        pg8::StaticOrder S; S.init(32 * CAP, 1024, X.G, (int)blockIdx.x, EXP_WGM);
        epi::EpiDown E{(pg8::bf16_t*)(ws + WS_YE), (const float*)(ws + WS_GATE)};
        pg8::gemm_phase<epi::EpiDown, pg8::StaticOrder, true, true>(ring, g, S, E, X.tid);
    }
    xcd_barrier(xbar);
    }
#ifdef REP_SYNC
    for (int rs = 0; rs < REP_SYNC; ++rs) xcd_barrier(xbar);
#endif
    for (int rep = 0; rep < REP_P12; ++rep) {
    { LOADP(); (void)ws; phase12(P, X); }
        if (rep + 1 < REP_P12) xcd_barrier(xbar);
    }
}

extern "C" void kernel_launch(void* const* d_in, const int* in_sizes, int n_in, void* d_out, int out_size, void* d_ws, size_t ws_size, hipStream_t stream) {
    static int grid = 0;
    if (grid == 0) {
        if (n_in != 32 || in_sizes[0] != T * DM || out_size != T * DM || ws_size < WS_END) {
            fprintf(stderr, "kernel_launch: unexpected shapes: n_in %d in0 %d out %d ws %zu (need >= %zu)\n", n_in, n_in > 0 ? in_sizes[0] : -1, out_size, ws_size, (size_t)WS_END); grid = -1; return; }
        int dev = 0, cus = 0, per_cu = 0;
        hipGetDevice(&dev); hipDeviceGetAttribute(&cus, hipDeviceAttributeMultiprocessorCount, dev);
        if (hipFuncSetAttribute((const void*)fwd_megakernel, hipFuncAttributeMaxDynamicSharedMemorySize, LDS_BYTES) != hipSuccess) { fprintf(stderr, "kernel_launch: hipFuncSetAttribute failed\n"); grid = -1; return; }
        if (hipOccupancyMaxActiveBlocksPerMultiprocessor(&per_cu, (const void*)fwd_megakernel, NTHR, LDS_BYTES) != hipSuccess || per_cu < 1) { fprintf(stderr, "kernel_launch: occupancy query failed (%d)\n", per_cu); (void)hipGetLastError(); per_cu = 1; }
        grid = cus * 1;
        fprintf(stderr, "kernel_launch: cus %d per_cu %d grid %d ws %zu\n", cus, per_cu, grid, ws_size);
    }
    if (grid < 0) return;
    Params p{};
    const float** pf = (const float**)&p;
    p.x = (const float*)d_in[0]; p.c = (const float*)d_in[1]; p.positions = (const int*)d_in[2];
    p.w_ada = (const float*)d_in[3]; p.b_ada = (const float*)d_in[4]; p.w_in = (const float*)d_in[5]; p.q_norm_g = (const float*)d_in[6]; p.w_qb = (const float*)d_in[7];
    p.kv_norm_g = (const float*)d_in[8]; p.w_kvb = (const float*)d_in[9]; p.conv_w = (const float*)d_in[10]; p.conv_b = (const float*)d_in[11];
    p.filt_w1 = (const float*)d_in[12]; p.filt_b1 = (const float*)d_in[13]; p.filt_freq = (const float*)d_in[14]; p.filt_w2 = (const float*)d_in[15]; p.filt_b2 = (const float*)d_in[16];
    p.filt_w3 = (const float*)d_in[17]; p.filt_b3 = (const float*)d_in[18]; p.hyena_decay = (const float*)d_in[19]; p.hyena_bias = (const float*)d_in[20];
    p.attn_out_g = (const float*)d_in[21]; p.hyena_out_g = (const float*)d_in[22]; p.w_o = (const float*)d_in[23]; p.ln1_g = (const float*)d_in[24]; p.ln1_b = (const float*)d_in[25];
    p.w_router = (const float*)d_in[26]; p.w_gate = (const float*)d_in[27]; p.w_up = (const float*)d_in[28]; p.w_down = (const float*)d_in[29]; p.ln2_g = (const float*)d_in[30]; p.ln2_b = (const float*)d_in[31];
    p.out = (float*)d_out; p.ws = (unsigned char*)d_ws; (void)pf;
    void* args[] = {&p};
    hipError_t e = hipLaunchCooperativeKernel((const void*)fwd_megakernel, dim3(grid), dim3(NTHR), args, LDS_BYTES, stream);
    if (e != hipSuccess) fprintf(stderr, "kernel_launch: cooperative launch failed: %s (grid %d)\n", hipGetErrorString(e), grid);
}
```

```cpp
#include <hip/hip_runtime.h>
#include <hip/hip_cooperative_groups.h>
#include <hip/hip_bf16.h>
#include <cstdio>
#include <cstdint>
#include <cmath>
namespace cg = cooperative_groups;

constexpr int BATCH = 2, SEQ = 8192, DM = 1024, T = BATCH * SEQ;
constexpr int NH = 8, QKD = 96, VD = 64, NOPE = 64, ROPE = 32;
constexpr int QLR = 256, KVLR = 128;
constexpr int HW = 512;
constexpr int IN_COLS = 1952, IN_PAD = 2048;
constexpr int NEXP = 16, CAP = 1024, EFF = 1024;
constexpr int FEMB = 33, FORD = 64;
constexpr float EPS = 1e-5f;
constexpr float DN_ALPHA = 1.189207115002721f;
constexpr int NFFT = 2 * SEQ;

namespace pg8 {
#define PG8_LAS __attribute__((address_space(3)))
typedef unsigned short bf16_t;
typedef short bf16x8 __attribute__((ext_vector_type(8)));
typedef float f32x4 __attribute__((ext_vector_type(4)));
typedef unsigned u32x4 __attribute__((ext_vector_type(4)));
constexpr int BM = 256, BK = 64, HALF = 128, HTB = HALF * BK * 2  , STAGE_BYTES = 8 * HTB, NXCD = 8, WGM = 8;

__host__ __device__ __forceinline__ int lds_byte(int r, int c) { const int st = (r >> 4) * 2 + (c >> 5), rr = r & 15, cc = c & 31, ob = rr * 64 + cc * 2; return st * 1024 + (ob ^ (((ob >> 9) & 1) << 5)); }
__host__ __device__ __forceinline__ void stage_rc(int b, int& R, int& C) { const int st = b / 1024, sb = b % 1024, swz = sb ^ (((sb >> 9) & 1) << 5); R = (st >> 1) * 16 + swz / 64; C = (st & 1) * 32 + (swz % 64) / 2; }
__host__ __device__ __forceinline__ int perm32(int rho) { const int n = rho >> 4, i = rho & 15; return 8 * (i >> 2) + 4 * n + (i & 3); }

struct Unit { int pm, pn; };
struct Gemm { const bf16_t* A; const bf16_t* Bt; int M, N, K; int lda, ldb; int pm_per_grp, grp_mod; size_t b_grp_bytes; const int* gidx; int g_shift, g_src; };

struct StaticOrder {
    int nM, nN, nwg, G, c, wgm;
    __host__ __device__ void init(int M, int N, int G_, int c_, int wgm_ = WGM) { nM = M / BM; nN = N / BM; nwg = nM * nN; G = G_; c = c_; wgm = wgm_; }
    __host__ __device__ bool next(int i, Unit& u) const {
        const long L = (long)i * G + c; if (L >= nwg) return false;
        int wgid = (int)L; { const int q = nwg / NXCD, r = nwg % NXCD, xcd = wgid % NXCD, off = wgid / NXCD; wgid = (xcd < r ? xcd * (q + 1) : r * (q + 1) + (xcd - r) * q) + off; }
        const int nig = wgm * nN, gid = wgid / nig, fm = gid * wgm, gsz = (nM - fm) < wgm ? (nM - fm) : wgm;
        u.pm = fm + ((wgid % nig) % gsz); u.pn = (wgid % nig) / gsz; return true;
    }
    __device__ __forceinline__ void a_ready(const Unit&) const {}
    __device__ __forceinline__ void done(const Unit&) const {}
};

__device__ __forceinline__ unsigned cvt_pk_bf16(float lo, float hi) { unsigned r; asm volatile("v_cvt_pk_bf16_f32 %0, %1, %2" : "=v"(r) : "v"(lo), "v"(hi)); return r; }
typedef float f32x2 __attribute__((ext_vector_type(2)));
__device__ __forceinline__ f32x2 gelu_pk(f32x2 v) {
    const f32x2 av = __builtin_elementwise_abs(v), d = av * 0.2316418882f + 1.0f;
    f32x2 t; t.x = __builtin_amdgcn_rcpf(d.x); t.y = __builtin_amdgcn_rcpf(d.y);
    f32x2 q = t * 0.5307027145f + (-0.7265760135f); q = q * t + 0.7107068705f; q = q * t + (-0.142248368f); q = q * t + 0.127414796f; q = q * t;
    const f32x2 s = (v * v) * (-0.72134752044f);
    f32x2 e; e.x = __builtin_amdgcn_exp2f(s.x); e.y = __builtin_amdgcn_exp2f(s.y);
    const f32x2 m = v * (q * e), r = v - m;
    f32x2 o; o.x = v.x < 0.f ? m.x : r.x; o.y = v.y < 0.f ? m.y : r.y; return o;
}

template <int ACT  > struct EpiBf16 {
    static constexpr bool PERM = true, AFTER_DRAIN = false; static_assert(ACT == 0 || ACT == 1, "EpiBf16: ACT is 0 (none) or 1 (gelu_pk)");
    bf16_t* O; int ldc; const float* bias; int split_cols; size_t split_stride; float scale0;
    __device__ __forceinline__ void operator()(const f32x4 (&acc)[2][2][4][2], const Unit& u, int wr, int wc, int fr, int fq) const {
        const int row0 = u.pm * BM + wr * 64 + fr; int colt = u.pn * BM; bf16_t* base = O;
        float sc = 1.f; if (split_cols) { const int t = colt / split_cols; base += (size_t)t * split_stride; colt -= t * split_cols; if (t == 0) sc = scale0; }
        const int col0 = colt + wc * 32 + 8 * fq, bcol0 = u.pn * BM + wc * 32 + 8 * fq;
        f32x4 bv[2][2];
#pragma unroll
        for (int bj = 0; bj < 2; ++bj)
#pragma unroll
            for (int n = 0; n < 2; ++n) bv[bj][n] = bias ? *(const f32x4*)(bias + bcol0 + bj * HALF + 4 * n) : (f32x4){0.f, 0.f, 0.f, 0.f};
#pragma unroll
        for (int ai = 0; ai < 2; ++ai)
#pragma unroll
            for (int m = 0; m < 4; ++m) { bf16_t* rowp = base + (size_t)(row0 + ai * HALF + m * 16) * ldc + col0;
#pragma unroll
                for (int bj = 0; bj < 2; ++bj) { f32x4 v0 = acc[ai][bj][m][0] + bv[bj][0], v1 = acc[ai][bj][m][1] + bv[bj][1];
                    if (ACT == 1) { f32x2 a = gelu_pk((f32x2){v0[0], v0[1]}), b = gelu_pk((f32x2){v0[2], v0[3]}), c = gelu_pk((f32x2){v1[0], v1[1]}), d = gelu_pk((f32x2){v1[2], v1[3]});
                        v0 = (f32x4){a.x, a.y, b.x, b.y}; v1 = (f32x4){c.x, c.y, d.x, d.y}; }
                    v0 = v0 * sc; v1 = v1 * sc; u32x4 w; w.x = cvt_pk_bf16(v0[0], v0[1]); w.y = cvt_pk_bf16(v0[2], v0[3]); w.z = cvt_pk_bf16(v1[0], v1[1]); w.w = cvt_pk_bf16(v1[2], v1[3]);
                    *(u32x4*)(rowp + bj * HALF) = w; } }
    }
};

struct PanelStats {
    unsigned* xbuf;
    unsigned* cnt;
    unsigned* tmo;
    int ntn; float eps;
    unsigned code;
    __device__ __forceinline__ bool run(const f32x4 (&v)[2][2][4][2], const Unit& u, int wr, int wc, int fr, int fq, PG8_LAS unsigned char* lds, int wid, int lane) const {
        typedef float f32x2v __attribute__((ext_vector_type(2)));
        PG8_LAS f32x2v* P = (PG8_LAS f32x2v*)lds;
        PG8_LAS f32x2v* S = (PG8_LAS f32x2v*)(lds + 8192);
        PG8_LAS unsigned* flag = (PG8_LAS unsigned*)(lds + 8192 + 2048);
#pragma unroll
        for (int ai = 0; ai < 2; ++ai)
#pragma unroll
            for (int m = 0; m < 4; ++m) {
                float s = 0.f;
#pragma unroll
                for (int bj = 0; bj < 2; ++bj)
#pragma unroll
                    for (int n = 0; n < 2; ++n) { const f32x4 x = v[ai][bj][m][n]; s += (x[0] + x[1]) + (x[2] + x[3]); }
                s += __shfl_xor(s, 16); s += __shfl_xor(s, 32);
                const float mw = s * (1.0f / 64.0f); float q = 0.f;
#pragma unroll
                for (int bj = 0; bj < 2; ++bj)
#pragma unroll
                    for (int n = 0; n < 2; ++n) { const f32x4 d = v[ai][bj][m][n] - mw; q += (d[0] * d[0] + d[1] * d[1]) + (d[2] * d[2] + d[3] * d[3]); }
                q += __shfl_xor(q, 16); q += __shfl_xor(q, 32);
                if (fq == 0) P[(ai * HALF + wr * 64 + m * 16 + fr) * 4 + wc] = (f32x2v){mw, q};
            }
        asm volatile("s_waitcnt lgkmcnt(0)" ::: "memory"); __builtin_amdgcn_s_barrier(); asm volatile("" ::: "memory");
#if defined(BROKEN_EXCHANGE_NO_WAIT)
#warning BROKEN CONTROL BUILD: the row-statistics exchange does not wait; results are wrong by design
        if (blockIdx.x >= 64) { const long long t0_ = clock64(); while (clock64() - t0_ < 60000) __builtin_amdgcn_s_sleep(8); }
#endif
        const int row = wid * 32 + (lane & 31);
        if (lane < 32) {
            const f32x2v a = P[row * 4 + 0], b = P[row * 4 + 1], c = P[row * 4 + 2], d = P[row * 4 + 3];
            const float mt = (a.x + b.x + c.x + d.x) * 0.25f;
            const float da = a.x - mt, db = b.x - mt, dc = c.x - mt, dd = d.x - mt;
            const float m2 = (a.y + b.y) + (c.y + d.y) + 64.0f * ((da * da + db * db) + (dc * dc + dd * dd));
            unsigned long long* slot = (unsigned long long*)xbuf + ((size_t)(u.pm * BM + row) * 4 + u.pn);
            __hip_atomic_store(slot, ((unsigned long long)__float_as_uint(m2) << 32) | __float_as_uint(mt), __ATOMIC_RELAXED, __HIP_MEMORY_SCOPE_AGENT);
        }
        asm volatile("s_waitcnt vmcnt(0)" ::: "memory");
        if (lane == 0) __hip_atomic_fetch_add(cnt + 64 * u.pm, 1u, __ATOMIC_RELAXED, __HIP_MEMORY_SCOPE_AGENT);
        if (wid == 0) {
            bool dead = false; const unsigned long long t0 = __builtin_amdgcn_s_memrealtime(); const unsigned want = 8u * (unsigned)ntn;
            for (;;) {
#if defined(BROKEN_EXCHANGE_NO_WAIT)
                break;
#endif
                if ((unsigned)__builtin_amdgcn_readfirstlane(__hip_atomic_load(cnt + 64 * u.pm, __ATOMIC_RELAXED, __HIP_MEMORY_SCOPE_AGENT)) >= want) break;
                if (__builtin_amdgcn_s_memrealtime() - t0 > 2000000ull) {
                    if (lane == 0) { unsigned expect = 0u; __hip_atomic_compare_exchange_strong(tmo + 1, &expect, code | (unsigned)(u.pm & 0xff), __ATOMIC_RELAXED, __ATOMIC_RELAXED, __HIP_MEMORY_SCOPE_AGENT);
                                     __hip_atomic_store(tmo, 1u, __ATOMIC_RELAXED, __HIP_MEMORY_SCOPE_AGENT); }
                    dead = true; break; }
                __builtin_amdgcn_s_sleep(2);
            }
            __builtin_amdgcn_fence(__ATOMIC_ACQUIRE, "agent");
            if (lane == 0) flag[0] = dead ? 1u : 0u;
        }
        asm volatile("s_waitcnt vmcnt(0) lgkmcnt(0)" ::: "memory"); __builtin_amdgcn_s_barrier(); asm volatile("" ::: "memory");
        const bool bad = flag[0] != 0u;
        if (lane < 32) {
            const unsigned long long* slot = (const unsigned long long*)xbuf + (size_t)(u.pm * BM + row) * 4; float mt[4], m2[4]; float ms = 0.f;
#pragma unroll
            for (int t = 0; t < 4; ++t) { if (t < ntn) { const unsigned long long w = __hip_atomic_load(slot + t, __ATOMIC_RELAXED, __HIP_MEMORY_SCOPE_AGENT); mt[t] = __uint_as_float((unsigned)w); m2[t] = __uint_as_float((unsigned)(w >> 32)); } else { mt[t] = 0.f; m2[t] = 0.f; } ms += mt[t]; }
            const float mean = ms / (float)ntn; float q = 0.f;
#pragma unroll
            for (int t = 0; t < 4; ++t) if (t < ntn) { const float dm = mt[t] - mean; q += m2[t] + 256.0f * dm * dm; }
            S[row] = (f32x2v){mean, 1.0f / sqrtf(q / (256.0f * (float)ntn) + eps)};
        }
        asm volatile("s_waitcnt lgkmcnt(0)" ::: "memory"); __builtin_amdgcn_s_barrier(); asm volatile("" ::: "memory");
        return bad;
    }
};
struct EpiLnRes {
    static constexpr bool PERM = false, AFTER_DRAIN = true;
    const float* base; float* out; int ldc; const float* bias; PanelStats st; unsigned poison;
    __device__ __forceinline__ void fused(f32x4 (&acc)[2][2][4][2], const Unit& u, int wr, int wc, int fr, int fq, PG8_LAS unsigned char* lds, int wid, int lane) const {
        typedef float f32x2v __attribute__((ext_vector_type(2)));
        const PG8_LAS f32x2v* S = (const PG8_LAS f32x2v*)(lds + 8192);
        const int col0 = u.pn * BM + wc * 32 + 4 * fq;
#pragma unroll
        for (int bj = 0; bj < 2; ++bj)
#pragma unroll
            for (int n = 0; n < 2; ++n) { const f32x4 bv = bias ? *(const f32x4*)(bias + col0 + bj * HALF + n * 16) : (f32x4){0.f, 0.f, 0.f, 0.f};
#pragma unroll
                for (int ai = 0; ai < 2; ++ai)
#pragma unroll
                    for (int m = 0; m < 4; ++m) acc[ai][bj][m][n] += bv; }
        f32x4 pre[4][2][2];
#pragma unroll
        for (int m = 0; m < 4; ++m) { const size_t off = (size_t)(u.pm * BM + wr * 64 + m * 16 + fr) * ldc + col0;
#pragma unroll
            for (int bj = 0; bj < 2; ++bj)
#pragma unroll
                for (int n = 0; n < 2; ++n) pre[m][bj][n] = *(const f32x4*)(base + off + bj * HALF + n * 16); }
        const bool bad = st.run(acc, u, wr, wc, fr, fq, lds, wid, lane) || poison != 0u;
        const float qnan = __builtin_nanf("");
#pragma unroll
        for (int ai = 0; ai < 2; ++ai)
#pragma unroll
            for (int m = 0; m < 4; ++m) { const int r = ai * HALF + wr * 64 + m * 16 + fr; const f32x2v sr = S[r]; const size_t off = (size_t)(u.pm * BM + r) * ldc + col0;
#pragma unroll
                for (int bj = 0; bj < 2; ++bj)
#pragma unroll
                    for (int n = 0; n < 2; ++n) { const f32x4 bs = ai == 0 ? pre[m][bj][n] : *(const f32x4*)(base + off + bj * HALF + n * 16); f32x4 o = bs + (acc[ai][bj][m][n] - sr.x) * sr.y;
                        if (bad) o = (f32x4){qnan, qnan, qnan, qnan}; *(f32x4*)(out + off + bj * HALF + n * 16) = o; }
                if (m & 1) asm volatile("" ::: "memory"); }
    }
};
struct EpiLnResLn {
    static constexpr bool PERM = false, AFTER_DRAIN = true;
    const float* base; float* out; bf16_t* xn; int ldc; const float* bias; PanelStats st1, st2; unsigned poison;
    __device__ __forceinline__ void fused(f32x4 (&acc)[2][2][4][2], const Unit& u, int wr, int wc, int fr, int fq, PG8_LAS unsigned char* lds, int wid, int lane) const {
        typedef float f32x2v __attribute__((ext_vector_type(2))); typedef unsigned u32x2v __attribute__((ext_vector_type(2)));
        const PG8_LAS f32x2v* S = (const PG8_LAS f32x2v*)(lds + 8192);
        const int col0 = u.pn * BM + wc * 32 + 4 * fq;
#pragma unroll
        for (int bj = 0; bj < 2; ++bj)
#pragma unroll
            for (int n = 0; n < 2; ++n) { const f32x4 bv = bias ? *(const f32x4*)(bias + col0 + bj * HALF + n * 16) : (f32x4){0.f, 0.f, 0.f, 0.f};
#pragma unroll
                for (int ai = 0; ai < 2; ++ai)
#pragma unroll
                    for (int m = 0; m < 4; ++m) acc[ai][bj][m][n] += bv; }
        bool bad = st1.run(acc, u, wr, wc, fr, fq, lds, wid, lane) || poison != 0u;
        const float qnan = __builtin_nanf("");
#pragma unroll
        for (int ai = 0; ai < 2; ++ai)
#pragma unroll
            for (int m = 0; m < 4; ++m) { const int r = ai * HALF + wr * 64 + m * 16 + fr; const f32x2v sr = S[r]; const size_t off = (size_t)(u.pm * BM + r) * ldc + col0;
#pragma unroll
                for (int bj = 0; bj < 2; ++bj)
#pragma unroll
                    for (int n = 0; n < 2; ++n) { const f32x4 bs = *(const f32x4*)(base + off + bj * HALF + n * 16); acc[ai][bj][m][n] = bs + (acc[ai][bj][m][n] - sr.x) * sr.y; }
                asm volatile("" : "+v"(acc[ai][0][m][0]), "+v"(acc[ai][0][m][1]), "+v"(acc[ai][1][m][0]), "+v"(acc[ai][1][m][1]));
                if (m & 1) asm volatile("" ::: "memory"); }
        const bool bad1 = bad;
        bad = st2.run(acc, u, wr, wc, fr, fq, lds, wid, lane) || bad;
#pragma unroll
        for (int ai = 0; ai < 2; ++ai)
#pragma unroll
            for (int m = 0; m < 4; ++m) { const int r = ai * HALF + wr * 64 + m * 16 + fr; const f32x2v sr = S[r]; const size_t off = (size_t)(u.pm * BM + r) * ldc + col0;
#pragma unroll
                for (int bj = 0; bj < 2; ++bj)
#pragma unroll
                    for (int n = 0; n < 2; ++n) { const f32x4 x1 = acc[ai][bj][m][n]; *(f32x4*)(out + off + bj * HALF + n * 16) = bad1 ? (f32x4){qnan, qnan, qnan, qnan} : x1;
                        const f32x4 o = (x1 - sr.x) * sr.y; u32x2v w; w.x = cvt_pk_bf16(o[0], o[1]); w.y = cvt_pk_bf16(o[2], o[3]);
                        if (bad) { w.x = 0x7fc07fc0u; w.y = 0x7fc07fc0u; } *(u32x2v*)(xn + off + bj * HALF + n * 16) = w; }
                asm volatile("" ::: "memory"); }
    }
};

template <class Epi, class Sched, bool ALIGN_EPI = false, bool SP2 = false, bool GATHER = false>
__device__ __forceinline__ void gemm_phase(PG8_LAS unsigned char* lds, const Gemm g, const Sched& S, const Epi& E, const int tid) {
    const int  wid = __builtin_amdgcn_readfirstlane(tid >> 6), lane = tid & 63, wr = wid >> 2, wc = wid & 3, fr = lane & 15, fq = lane >> 4;
    const int K = g.K, nt = K / BK;
    unsigned voffA[2], voffB[2]; int Rr[2], Cc[2];
#pragma unroll
    for (int i = 0; i < 2; ++i) { int R, C; stage_rc(tid * 16 + i * 8192, R, C); const int Rb = Epi::PERM ? ((R & ~31) + perm32(R & 31)) : R; Rr[i] = R; Cc[i] = C;
        voffA[i] = (unsigned)(R * g.lda + C) * 2u; voffB[i] = (unsigned)(Rb * g.ldb + C) * 2u; }
    unsigned gvC[2][2] = {{0u, 0u}, {0u, 0u}}, gvN[2][2] = {{0u, 0u}, {0u, 0u}};
#define PG8_GV(dst, un) do { _Pragma("unroll") for (int _h = 0; _h < 2; ++_h) _Pragma("unroll") for (int _i = 0; _i < 2; ++_i) { const int _r = (un).pm * BM + _h * HALF + Rr[_i]; \
        dst[_h][_i] = (unsigned)(((_r >> g.g_shift) * g.g_src + g.gidx[_r]) * g.lda + Cc[_i]) * 2u; } } while (0)
#define PG8_STAGE_A(bufoff, gbase, h, usenext) do { if constexpr (GATHER) { _Pragma("unroll") for (int _i = 0; _i < 2; ++_i) { const unsigned _vo = (usenext) ? gvN[h][_i] : gvC[h][_i]; \
        __builtin_amdgcn_global_load_lds((const unsigned*)((const char*)(gbase) + _vo), (PG8_LAS unsigned*)(lds + (bufoff) + ldsw + _i * 8192), 16, 0, 0); } } \
        else { PG8_STAGE(bufoff, (gbase) + (h) * hstepA, voffA); } } while (0)
    const size_t kstep = (size_t)(BK * 2);
    const size_t hstepA = (size_t)HALF * g.lda * 2, hstepB = (size_t)HALF * g.ldb * 2;
    const size_t tstepA = 2 * hstepA, tstepB = 2 * hstepB;
    const unsigned ldsw = (unsigned)wid * 1024u;
    const int aoff = lds_byte(wr * 64 + fr, fq * 8), boff = lds_byte(wc * 32 + fr, fq * 8);
#define PG8_SA(b, h) (((b) * 2 + (h)) * HTB)
#define PG8_SB(b, h) ((4 + (b) * 2 + (h)) * HTB)
#define PG8_STAGE(bufoff, gbase, voff) do { _Pragma("unroll") for (int _i = 0; _i < 2; ++_i) \
        __builtin_amdgcn_global_load_lds((const unsigned*)((const char*)(gbase) + (voff)[_i]), (PG8_LAS unsigned*)(lds + (bufoff) + ldsw + _i * 8192), 16, 0, 0); } while (0)
#define PG8_LDA(dst, b, h) do { _Pragma("unroll") for (int m = 0; m < 4; ++m) _Pragma("unroll") for (int k = 0; k < 2; ++k) dst[m][k] = *(const PG8_LAS bf16x8*)(lds + PG8_SA(b, h) + aoff + m * 2048 + k * 1024); } while (0)
#define PG8_LDB(dst, b, h) do { _Pragma("unroll") for (int n = 0; n < 2; ++n) _Pragma("unroll") for (int k = 0; k < 2; ++k) dst[n][k] = *(const PG8_LAS bf16x8*)(lds + PG8_SB(b, h) + boff + n * 2048 + k * 1024); } while (0)
#define PG8_MMA(ai, bj, At, Bt) do { __builtin_amdgcn_s_setprio(1); _Pragma("unroll") for (int m = 0; m < 4; ++m) _Pragma("unroll") for (int n = 0; n < 2; ++n) _Pragma("unroll") for (int k = 0; k < 2; ++k) \
        acc[ai][bj][m][n] = __builtin_amdgcn_mfma_f32_16x16x32_bf16(Bt[n][k], At[m][k], acc[ai][bj][m][n], 0, 0, 0); __builtin_amdgcn_s_setprio(0); } while (0)
#define PG8_WAIT_V(n) asm volatile("s_waitcnt vmcnt(" #n ")" ::: "memory")
#define PG8_WAIT_L(n) asm volatile("s_waitcnt lgkmcnt(" #n ")" ::: "memory")
#define PG8_BAR __builtin_amdgcn_s_barrier()
#define PG8_SCHED __builtin_amdgcn_sched_barrier(0)
    Unit cur, nxt; int ui = 0;
    if (!S.next(0, cur)) return;
    f32x4 acc[2][2][4][2];
#pragma unroll
    for (int a = 0; a < 2; ++a)
#pragma unroll
        for (int b = 0; b < 2; ++b)
#pragma unroll
            for (int m = 0; m < 4; ++m)
#pragma unroll
                for (int n = 0; n < 2; ++n) acc[a][b][m][n] = (f32x4){0.f, 0.f, 0.f, 0.f};
    bf16x8 At[4][2], B0[2][2], B1[2][2];
    const char* cA = (const char*)g.A + (GATHER ? (size_t)0 : (size_t)cur.pm * tstepA); if constexpr (GATHER) { PG8_GV(gvC, cur); }
    const char* cB = (const char*)g.Bt + (size_t)((cur.pm / g.pm_per_grp) % g.grp_mod) * g.b_grp_bytes + (size_t)cur.pn * tstepB;
    S.a_ready(cur);
    if constexpr (SP2) {
        PG8_STAGE(PG8_SB(0, 0), cB, voffB); PG8_STAGE(PG8_SB(0, 1), cB + hstepB, voffB); PG8_STAGE_A(PG8_SA(0, 0), cA, 0, false); PG8_STAGE_A(PG8_SA(0, 1), cA, 1, false);
        if (wr == 1) PG8_BAR;
        PG8_WAIT_V(2); PG8_BAR;
        PG8_STAGE(PG8_SB(1, 0), cB + kstep, voffB); PG8_STAGE_A(PG8_SA(1, 0), cA + kstep, 0, false); PG8_STAGE(PG8_SB(1, 1), cB + hstepB + kstep, voffB);
        PG8_WAIT_V(6); PG8_BAR;
    } else {
        PG8_STAGE(PG8_SB(0, 0), cB, voffB); PG8_STAGE_A(PG8_SA(0, 0), cA, 0, false); PG8_STAGE(PG8_SB(0, 1), cB + hstepB, voffB); PG8_STAGE_A(PG8_SA(0, 1), cA, 1, false);
        if (wr == 1) PG8_BAR;
        PG8_WAIT_V(4); PG8_BAR;
        PG8_STAGE(PG8_SB(1, 0), cB + kstep, voffB); PG8_STAGE_A(PG8_SA(1, 0), cA + kstep, 0, false); PG8_STAGE(PG8_SB(1, 1), cB + hstepB + kstep, voffB);
        PG8_WAIT_V(6); PG8_BAR;
    }
    for (;;) {
        const bool has_next = S.next(ui + 1, nxt);
        const char* nA = (has_next && !GATHER) ? (const char*)g.A + (size_t)nxt.pm * tstepA : cA;
        if constexpr (GATHER) { if (has_next) { PG8_GV(gvN, nxt); } else { _Pragma("unroll") for (int _h = 0; _h < 2; ++_h) _Pragma("unroll") for (int _i = 0; _i < 2; ++_i) gvN[_h][_i] = gvC[_h][_i]; } }
        const char* nB = has_next ? (const char*)g.Bt + (size_t)((nxt.pm / g.pm_per_grp) % g.grp_mod) * g.b_grp_bytes + (size_t)nxt.pn * tstepB : cB;
        for (int t = 0; t < nt; t += 2) {
            const bool last = (t == nt - 2);
            const char* a1 = cA + (size_t)(t + 1) * kstep;
            const char* a2 = last ? nA : cA + (size_t)(t + 2) * kstep; const char* b2 = last ? nB : cB + (size_t)(t + 2) * kstep;
            const char* a3 = a2 + kstep; const char* b3 = b2 + kstep;
            if (last && has_next) S.a_ready(nxt);
            if constexpr (SP2) {
            PG8_LDB(B0, 0, 0); PG8_LDB(B1, 0, 1); PG8_SCHED; PG8_LDA(At, 0, 0); PG8_STAGE_A(PG8_SA(1, 1), a1, 1, false);
            PG8_WAIT_V(8); PG8_WAIT_L(0); PG8_BAR; PG8_MMA(0, 0, At, B0); PG8_MMA(0, 1, At, B1); PG8_BAR; PG8_SCHED;
            PG8_LDA(At, 0, 1); PG8_STAGE(PG8_SB(0, 0), b2, voffB); PG8_STAGE(PG8_SB(0, 1), b2 + hstepB, voffB); PG8_STAGE_A(PG8_SA(0, 0), a2, 0, last);
            PG8_WAIT_V(8); PG8_WAIT_L(0); PG8_BAR; PG8_MMA(1, 0, At, B0); PG8_MMA(1, 1, At, B1); PG8_BAR; PG8_SCHED;
            PG8_LDB(B0, 1, 0); PG8_LDB(B1, 1, 1); PG8_SCHED; PG8_LDA(At, 1, 0); PG8_STAGE_A(PG8_SA(0, 1), a2, 1, last);
            PG8_WAIT_V(8); PG8_WAIT_L(0); PG8_BAR; PG8_MMA(0, 0, At, B0); PG8_MMA(0, 1, At, B1); PG8_BAR; PG8_SCHED;
            PG8_LDA(At, 1, 1); PG8_STAGE(PG8_SB(1, 0), b3, voffB); PG8_STAGE(PG8_SB(1, 1), b3 + hstepB, voffB); PG8_STAGE_A(PG8_SA(1, 0), a3, 0, last);
            PG8_WAIT_V(8); PG8_WAIT_L(0); PG8_BAR; PG8_MMA(1, 0, At, B0); PG8_MMA(1, 1, At, B1); PG8_BAR; PG8_SCHED;
            } else {
            PG8_LDB(B0, 0, 0); PG8_SCHED; PG8_LDA(At, 0, 0); PG8_STAGE_A(PG8_SA(1, 1), a1, 1, false);
            PG8_WAIT_L(8); PG8_BAR; PG8_WAIT_L(0); PG8_MMA(0, 0, At, B0); PG8_BAR; PG8_SCHED;
            PG8_LDB(B1, 0, 1); PG8_STAGE(PG8_SB(0, 0), b2, voffB);
            PG8_BAR; PG8_WAIT_L(0); PG8_MMA(0, 1, At, B1); PG8_BAR;
            PG8_LDA(At, 0, 1); PG8_STAGE_A(PG8_SA(0, 0), a2, 0, last);
            PG8_BAR; PG8_WAIT_L(0); PG8_MMA(1, 0, At, B0); PG8_BAR; PG8_SCHED;
            PG8_STAGE(PG8_SB(0, 1), b2 + hstepB, voffB);
            PG8_WAIT_V(6); PG8_BAR; PG8_MMA(1, 1, At, B1); PG8_BAR;
            PG8_LDB(B0, 1, 0); PG8_SCHED; PG8_LDA(At, 1, 0); PG8_STAGE_A(PG8_SA(0, 1), a2, 1, last);
            PG8_WAIT_L(8); PG8_BAR; PG8_WAIT_L(0); PG8_MMA(0, 0, At, B0); PG8_BAR; PG8_SCHED;
            PG8_LDB(B1, 1, 1); PG8_STAGE(PG8_SB(1, 0), b3, voffB);
            PG8_BAR; PG8_WAIT_L(0); PG8_MMA(0, 1, At, B1); PG8_BAR;
            PG8_LDA(At, 1, 1); PG8_STAGE_A(PG8_SA(1, 0), a3, 0, last);
            PG8_BAR; PG8_WAIT_L(0); PG8_MMA(1, 0, At, B0); PG8_BAR; PG8_SCHED;
            PG8_STAGE(PG8_SB(1, 1), b3 + hstepB, voffB);
            PG8_WAIT_V(6); PG8_BAR; PG8_MMA(1, 1, At, B1); PG8_BAR;
            }
        }
        if constexpr (ALIGN_EPI) { if (wr == 0) PG8_BAR; }
        if constexpr (!Epi::AFTER_DRAIN) { E(acc, cur, wr, wc, fr, fq); S.done(cur); }
        if (!has_next) break;
#pragma unroll
        for (int a = 0; a < 2; ++a)
#pragma unroll
            for (int b = 0; b < 2; ++b)
#pragma unroll
                for (int m = 0; m < 4; ++m)
#pragma unroll
                    for (int n = 0; n < 2; ++n) acc[a][b][m][n] = (f32x4){0.f, 0.f, 0.f, 0.f};
        cur = nxt; cA = nA; cB = nB; ++ui;
        if constexpr (GATHER) { _Pragma("unroll") for (int _h = 0; _h < 2; ++_h) _Pragma("unroll") for (int _i = 0; _i < 2; ++_i) gvC[_h][_i] = gvN[_h][_i]; }
        if constexpr (ALIGN_EPI) { if (wr == 1) PG8_BAR; }
    }
    PG8_WAIT_V(0);
    if constexpr (!ALIGN_EPI) { if (wr == 0) PG8_BAR; }
    PG8_BAR;
    if constexpr (Epi::AFTER_DRAIN) { E.fused(acc, cur, wr, wc, fr, fq, lds, wid, lane); S.done(cur); }
#undef PG8_SA
#undef PG8_SB
#undef PG8_STAGE
#undef PG8_STAGE_A
#undef PG8_GV
#undef PG8_LDA
#undef PG8_LDB
#undef PG8_MMA
#undef PG8_WAIT_V
#undef PG8_WAIT_L
#undef PG8_BAR
#undef PG8_SCHED
}
}

namespace epi {
using pg8::f32x4; using pg8::u32x4; using pg8::Unit; using pg8::bf16_t; using pg8::cvt_pk_bf16; using pg8::HALF; using pg8::BM;
typedef unsigned u32x2 __attribute__((ext_vector_type(2)));

struct EpiIn {
    static constexpr bool PERM = false, AFTER_DRAIN = false;
    bf16_t* cq; bf16_t* ckv; float* krr; bf16_t* hyT; float* ssq_q; float* ssq_kv; PG8_LAS unsigned char* stg;
    __device__ __forceinline__ void operator()(const f32x4 (&acc)[2][2][4][2], const Unit& u, int wr, int wc, int fr, int fq) const {
        PG8_LAS unsigned char* ws_ = stg + (wr * 4 + wc) * 2304; const int lane = fr + 16 * fq;
#pragma unroll
        for (int ai = 0; ai < 2; ++ai)
#pragma unroll
            for (int bj = 0; bj < 2; ++bj)
#pragma unroll
                for (int n = 0; n < 2; ++n) {
                    const int cg = u.pn * BM + bj * HALF + wc * 32 + n * 16;
                    if (cg >= 416 && cg < IN_COLS) {
#pragma unroll
                        for (int m = 0; m < 4; ++m) { const f32x4 v = acc[ai][bj][m][n]; const unsigned w0 = cvt_pk_bf16(v[0], v[1]), w1 = cvt_pk_bf16(v[2], v[3]);
                            PG8_LAS unsigned char* p = ws_ + (4 * fq) * 144 + (16 * m + fr) * 2;
                            *(PG8_LAS unsigned short*)(p) = (unsigned short)(w0 & 0xffffu); *(PG8_LAS unsigned short*)(p + 144) = (unsigned short)(w0 >> 16);
                            *(PG8_LAS unsigned short*)(p + 288) = (unsigned short)(w1 & 0xffffu); *(PG8_LAS unsigned short*)(p + 432) = (unsigned short)(w1 >> 16); }
                        asm volatile("s_waitcnt lgkmcnt(0)" ::: "memory");
                        const int rowbase = u.pm * BM + ai * HALF + wr * 64;
#pragma unroll
                        for (int h = 0; h < 2; ++h) { const int pc = lane + 64 * h, col = pc >> 3, oct = pc & 7;
                            const u32x4 w = *(const PG8_LAS u32x4*)(ws_ + col * 144 + oct * 16);
                            *(u32x4*)(hyT + (size_t)(cg - 416 + col) * T + rowbase + oct * 8) = w; }
                        asm volatile("s_waitcnt lgkmcnt(0)" ::: "memory");
                    }
                }
#pragma unroll
        for (int ai = 0; ai < 2; ++ai)
#pragma unroll
            for (int m = 0; m < 4; ++m) {
                const int rowp = u.pm * BM + ai * HALF + wr * 64 + m * 16 + fr;
                const int row = (rowp & 1) * SEQ + (rowp >> 1);
                float sq = 0.f, skv = 0.f;
#pragma unroll
                for (int bj = 0; bj < 2; ++bj)
#pragma unroll
                    for (int n = 0; n < 2; ++n) {
                        const int c0 = u.pn * BM + bj * HALF + wc * 32 + n * 16 + 4 * fq;
                        const f32x4 v = acc[ai][bj][m][n];
                        if (c0 < 256) {
                            u32x2 w; w.x = cvt_pk_bf16(v[0], v[1]); w.y = cvt_pk_bf16(v[2], v[3]);
                            *(u32x2*)(cq + (size_t)row * 256 + c0) = w;
                            sq += (v[0] * v[0] + v[1] * v[1]) + (v[2] * v[2] + v[3] * v[3]);
                        } else if (c0 < 384) {
                            u32x2 w; w.x = cvt_pk_bf16(v[0], v[1]); w.y = cvt_pk_bf16(v[2], v[3]);
                            *(u32x2*)(ckv + (size_t)row * 128 + (c0 - 256)) = w;
                            skv += (v[0] * v[0] + v[1] * v[1]) + (v[2] * v[2] + v[3] * v[3]);
                        } else if (c0 < 416) {
                            *(f32x4*)(krr + (size_t)row * 32 + (c0 - 384)) = v;
                        }
                    }
                if (u.pn == 0) { sq += __shfl_xor(sq, 16); sq += __shfl_xor(sq, 32); if (fq == 0) ssq_q[row * 4 + wc] = sq; }
                if (u.pn == 1) { skv += __shfl_xor(skv, 16); skv += __shfl_xor(skv, 32); if (fq == 0) ssq_kv[row * 4 + wc] = skv; }
            }
    }
};

struct EpiRowScale {
    static constexpr bool PERM = true, AFTER_DRAIN = false;
    bf16_t* O; int ldc; const float* ssq; float inv_n; float post;
    __device__ __forceinline__ void operator()(const f32x4 (&acc)[2][2][4][2], const Unit& u, int wr, int wc, int fr, int fq) const {
        const int col0 = u.pn * BM + wc * 32 + 8 * fq;
#pragma unroll
        for (int ai = 0; ai < 2; ++ai)
#pragma unroll
            for (int m = 0; m < 4; ++m) {
                const int row = u.pm * BM + ai * HALF + wr * 64 + m * 16 + fr;
                float s = 1.f; if (ssq) { const f32x4 pp = *(const f32x4*)(ssq + (size_t)row * 4); s = __builtin_amdgcn_rsqf(((pp[0] + pp[1]) + (pp[2] + pp[3])) * inv_n + EPS) * post; }
#pragma unroll
                for (int bj = 0; bj < 2; ++bj) {
                    const f32x4 v0 = acc[ai][bj][m][0] * s, v1 = acc[ai][bj][m][1] * s;
                    u32x4 w; w.x = cvt_pk_bf16(v0[0], v0[1]); w.y = cvt_pk_bf16(v0[2], v0[3]); w.z = cvt_pk_bf16(v1[0], v1[1]); w.w = cvt_pk_bf16(v1[2], v1[3]);
                    *(u32x4*)(O + (size_t)row * ldc + col0 + bj * HALF) = w;
                }
            }
    }
};

struct EpiFilt {
    static constexpr bool PERM = false, AFTER_DRAIN = false;
    unsigned* kT2; const float* b3; const float* decay;
    __device__ __forceinline__ void operator()(const f32x4 (&acc)[2][2][4][2], const Unit& u, int wr, int wc, int fr, int fq) const {
        typedef float f32x2 __attribute__((ext_vector_type(2)));
#pragma unroll
        for (int bj = 0; bj < 2; ++bj)
#pragma unroll
            for (int n = 0; n < 2; ++n) {
                const int c0 = u.pn * BM + bj * HALF + wc * 32 + n * 16 + 4 * fq;
                const int dir = c0 >> 10, cp = (c0 & 1023) >> 1;
                const f32x2 b_o0 = *(const f32x2*)(b3 + dir * 1024 + cp), b_o1 = *(const f32x2*)(b3 + dir * 1024 + 512 + cp);
                const f32x2 d_o0 = *(const f32x2*)(decay + dir * 1024 + cp), d_o1 = *(const f32x2*)(decay + dir * 1024 + 512 + cp);
                const float bb[4] = {b_o0.x, b_o1.x, b_o0.y, b_o1.y}; const float dd[4] = {fabsf(d_o0.x), fabsf(d_o1.x), fabsf(d_o0.y), fabsf(d_o1.y)};
#pragma unroll
                for (int ai = 0; ai < 2; ++ai)
#pragma unroll
                    for (int m = 0; m < 4; ++m) {
                        const int row = u.pm * BM + ai * HALF + wr * 64 + m * 16 + fr;
                        const float tl = (float)row * (1.0f / (float)(SEQ - 1));
                        const f32x4 v = acc[ai][bj][m][n];
                        float val[4];
#pragma unroll
                        for (int j = 0; j < 4; ++j) val[j] = (v[j] + bb[j]) * __expf(-tl * dd[j]);
                        kT2[(size_t)(dir * 512 + cp) * SEQ + row] = cvt_pk_bf16(val[0], val[1]);
                        kT2[(size_t)(dir * 512 + cp + 1) * SEQ + row] = cvt_pk_bf16(val[2], val[3]);
                    }
            }
    }
};

struct EpiGU {
    static constexpr bool PERM = true, AFTER_DRAIN = false;
    bf16_t* H;
    __device__ __forceinline__ void operator()(const f32x4 (&acc)[2][2][4][2], const Unit& u, int wr, int wc, int fr, int fq) const {
        const int col0 = u.pn * BM + wc * 32 + 8 * fq;
#pragma unroll
        for (int ai = 0; ai < 2; ++ai)
#pragma unroll
            for (int m = 0; m < 4; ++m) {
                const int row = u.pm * BM + ai * HALF + wr * 64 + m * 16 + fr;
#pragma unroll
                for (int bj = 0; bj < 2; ++bj) {
                    const f32x4 v0 = acc[ai][bj][m][0], v1 = acc[ai][bj][m][1];
                    float h[4];
                    { const float g = v0[0], up = v0[1]; h[0] = g * __builtin_amdgcn_rcpf(1.f + __expf(-g)) * up; }
                    { const float g = v0[2], up = v0[3]; h[1] = g * __builtin_amdgcn_rcpf(1.f + __expf(-g)) * up; }
                    { const float g = v1[0], up = v1[1]; h[2] = g * __builtin_amdgcn_rcpf(1.f + __expf(-g)) * up; }
                    { const float g = v1[2], up = v1[3]; h[3] = g * __builtin_amdgcn_rcpf(1.f + __expf(-g)) * up; }
                    u32x2 w; w.x = cvt_pk_bf16(h[0], h[1]); w.y = cvt_pk_bf16(h[2], h[3]);
                    *(u32x2*)(H + (size_t)row * EFF + ((col0 + bj * HALF) >> 1)) = w;
                }
            }
    }
};

struct EpiDown {
    static constexpr bool PERM = true, AFTER_DRAIN = false;
    bf16_t* O; const float* gate;
    __device__ __forceinline__ void operator()(const f32x4 (&acc)[2][2][4][2], const Unit& u, int wr, int wc, int fr, int fq) const {
        const int col0 = u.pn * BM + wc * 32 + 8 * fq;
#pragma unroll
        for (int ai = 0; ai < 2; ++ai)
#pragma unroll
            for (int m = 0; m < 4; ++m) {
                const int row = u.pm * BM + ai * HALF + wr * 64 + m * 16 + fr;
                const float s = gate[row];
#pragma unroll
                for (int bj = 0; bj < 2; ++bj) {
                    const f32x4 v0 = acc[ai][bj][m][0] * s, v1 = acc[ai][bj][m][1] * s;
                    u32x4 w; w.x = cvt_pk_bf16(v0[0], v0[1]); w.y = cvt_pk_bf16(v0[2], v0[3]); w.z = cvt_pk_bf16(v1[0], v1[1]); w.w = cvt_pk_bf16(v1[2], v1[3]);
                    *(u32x4*)(O + (size_t)row * DM + col0 + bj * HALF) = w;
                }
            }
    }
};
}

namespace attn {
using bf16x8 = __attribute__((ext_vector_type(8))) short;
using s16x4  = __attribute__((ext_vector_type(4))) short;
using f32x16 = __attribute__((ext_vector_type(16))) float;
using f32x8  = __attribute__((ext_vector_type(8))) float;
using u32x4  = __attribute__((ext_vector_type(4))) unsigned;
typedef unsigned short bf16_t;
constexpr int NW = 8, QBLK = 32, KVBLK = 64;
constexpr float SCALE = 0.10206207261596575f;
constexpr float THR = 8.f;
constexpr int LDQ = NH * QKD;
constexpr int LDKV = NH * 128;
constexpr int LDO = NH * VD;
constexpr int SHM_V = KVBLK * 128 * 2, SHM_K = KVBLK * 128 * 2;
constexpr int SHM_ATTN = 2 * SHM_V + 2 * SHM_K + NW * 64 * 4;
#define KSWZ(row, colB) ((row) * 256 + ((colB) ^ (((row) & 7) << 4)))
#define SBAR() __builtin_amdgcn_sched_barrier(0)
__device__ __forceinline__ int crow(int r, int hi) { return (r & 3) + 8 * (r >> 2) + 4 * hi; }
__device__ __forceinline__ unsigned cvtpk(float lo, float hi) { unsigned r; asm volatile("v_cvt_pk_bf16_f32 %0, %1, %2" : "=v"(r) : "v"(lo), "v"(hi)); return r; }
__device__ __forceinline__ float bf2f(short s) { return __uint_as_float(((unsigned)(unsigned short)s) << 16); }

__device__ __forceinline__ void partialSM(f32x16& p0, f32x16& p1, float& m_reg, float& mn, float& alpha) {
  constexpr float C = SCALE * 1.4426950408889634f;
  float pmax = p0[0]; for (int r = 1; r < 16; ++r) pmax = fmaxf(pmax, p0[r]); for (int r = 0; r < 16; ++r) pmax = fmaxf(pmax, p1[r]);
  { auto rr = __builtin_amdgcn_permlane32_swap(__float_as_uint(pmax), __float_as_uint(pmax), false, false);
    pmax = fmaxf(__uint_as_float(rr[0]), __uint_as_float(rr[1])); }
  if (__builtin_expect(__all(pmax - m_reg <= THR / SCALE), 1)) { mn = m_reg; alpha = 1.f; }
  else { mn = fmaxf(m_reg, pmax); alpha = __builtin_amdgcn_exp2f((m_reg - mn) * C); m_reg = mn; }
  float mnC = -mn * C;
  for (int r = 0; r < 16; ++r) p0[r] = fmaf(p0[r], C, mnC); for (int r = 0; r < 16; ++r) p1[r] = fmaf(p1[r], C, mnC);
  for (int r = 0; r < 16; ++r) p0[r] = __builtin_amdgcn_exp2f(p0[r]);
}
__device__ __forceinline__ void finishSM(f32x16& p0, f32x16& p1, float alpha, float& l_reg, bf16x8& pa0, bf16x8& pa1, bf16x8& pa2, bf16x8& pa3) {
  for (int r = 0; r < 16; ++r) p1[r] = __builtin_amdgcn_exp2f(p1[r]);
  float ps = 0; for (int r = 0; r < 16; ++r) ps += p0[r]; for (int r = 0; r < 16; ++r) ps += p1[r];
  { auto rr = __builtin_amdgcn_permlane32_swap(__float_as_uint(ps), __float_as_uint(ps), false, false);
    ps = __uint_as_float(rr[0]) + __uint_as_float(rr[1]); }
  l_reg = l_reg * alpha + ps;
#define PK4(P, BASE, OUT) do { unsigned a0 = cvtpk(P[BASE + 0], P[BASE + 1]), a1 = cvtpk(P[BASE + 2], P[BASE + 3]);   \
    unsigned b0 = cvtpk(P[BASE + 4], P[BASE + 5]), b1 = cvtpk(P[BASE + 6], P[BASE + 7]);                              \
    auto r0 = __builtin_amdgcn_permlane32_swap(a0, b0, false, false); auto r1 = __builtin_amdgcn_permlane32_swap(a1, b1, false, false); \
    u32x4 w = {r0[0], r1[0], r0[1], r1[1]}; OUT = *reinterpret_cast<bf16x8*>(&w); } while (0)
  PK4(p0, 0, pa0); PK4(p0, 8, pa1); PK4(p1, 0, pa2); PK4(p1, 8, pa3);
#undef PK4
}
__device__ __forceinline__ void qkt(f32x16& p0, f32x16& p1, const bf16_t* Ks, const bf16x8* qr, int r32, int hi) {
  p0 = f32x16{}; p1 = f32x16{};
#pragma unroll
  for (int d0 = 0; d0 < 6; ++d0) { int cb = (d0 * 16 + hi * 8) * 2;
    bf16x8 b0 = *reinterpret_cast<const bf16x8*>((const char*)Ks + KSWZ(r32, cb));
    bf16x8 b1 = *reinterpret_cast<const bf16x8*>((const char*)Ks + KSWZ(32 + r32, cb));
    p0 = __builtin_amdgcn_mfma_f32_32x32x16_bf16(b0, qr[d0], p0, 0, 0, 0);
    p1 = __builtin_amdgcn_mfma_f32_32x32x16_bf16(b1, qr[d0], p1, 0, 0, 0); }
}
__device__ __forceinline__ int v_st(int k, int c) { const int kk = (k & ~0xC) | ((k & 4) << 1) | ((k & 8) >> 1); return ((kk >> 3) * 4 + (c >> 5)) * 512 + ((kk & 7) * 32 + (c & 31)) * 2; }
__device__ __forceinline__ int v_rd_base(int lane) { return ((lane & 3) << 3) | (((lane >> 2) & 3) << 6) | (((lane >> 4) & 1) << 5) | (((lane >> 5) & 1) << 8); }
constexpr int v_rd_off(int d0, int ks, int half) { return d0 * 512 + ks * 4096 + half * 2048; }
template <int OFF> __device__ __forceinline__ s16x4 tr_read(int vb) {
  s16x4 r; asm volatile("ds_read_b64_tr_b16 %0, %1 offset:%2" : "=&v"(r) : "v"(vb), "i"(OFF) : "memory"); return r;
}
template <int D0> __device__ __forceinline__ void pv_one(f32x16& od, int vb, bf16x8 pa0, bf16x8 pa1, bf16x8 pa2, bf16x8 pa3) {
  const s16x4 l0 = tr_read<v_rd_off(D0, 0, 0)>(vb), h0 = tr_read<v_rd_off(D0, 0, 1)>(vb), l1 = tr_read<v_rd_off(D0, 1, 0)>(vb), h1 = tr_read<v_rd_off(D0, 1, 1)>(vb);
  const s16x4 l2 = tr_read<v_rd_off(D0, 2, 0)>(vb), h2 = tr_read<v_rd_off(D0, 2, 1)>(vb), l3 = tr_read<v_rd_off(D0, 3, 0)>(vb), h3 = tr_read<v_rd_off(D0, 3, 1)>(vb);
  asm volatile("s_waitcnt lgkmcnt(0)" ::: "memory"); SBAR();
#define PK(L, H) (bf16x8){L[0], L[1], L[2], L[3], H[0], H[1], H[2], H[3]}
  od = __builtin_amdgcn_mfma_f32_32x32x16_bf16(pa0, PK(l0, h0), od, 0, 0, 0);
  od = __builtin_amdgcn_mfma_f32_32x32x16_bf16(pa1, PK(l1, h1), od, 0, 0, 0);
  od = __builtin_amdgcn_mfma_f32_32x32x16_bf16(pa2, PK(l2, h2), od, 0, 0, 0);
  od = __builtin_amdgcn_mfma_f32_32x32x16_bf16(pa3, PK(l3, h3), od, 0, 0, 0);
#undef PK
}
__device__ __forceinline__ void pv_d0(f32x16* o, int vb, bf16x8 pa0, bf16x8 pa1, bf16x8 pa2, bf16x8 pa3) {
  pv_one<0>(o[0], vb, pa0, pa1, pa2, pa3); pv_one<1>(o[1], vb, pa0, pa1, pa2, pa3);
}

__device__ __forceinline__ void attn_unit(const bf16_t* __restrict__ Q, const bf16_t* __restrict__ KV, const bf16_t* __restrict__ KR, const float* __restrict__ CS,
                                          bf16_t* __restrict__ O, int h, long tq0, long tk0, int seq, char* lds, const int tid) {
  const int wid = tid >> 6, lane = tid & 63, r32 = lane & 31, hi = lane >> 5;
  bf16_t* V_lds = (bf16_t*)lds; bf16_t* K_lds = (bf16_t*)(lds + 2 * SHM_V);
  float* ws = (float*)(lds + 2 * SHM_V + 2 * SHM_K) + wid * 64; float* li_l = ws; float* al_l = ws + 32;
  float m_reg = -1e30f, l_reg = 0; f32x16 o[2] = {}; bf16x8 qr[6];
  { const long trow = tq0 + wid * QBLK + r32;
    const bf16_t* Qw = Q + trow * LDQ + h * QKD + hi * 8;
#pragma unroll
    for (int d0 = 0; d0 < 6; ++d0) qr[d0] = *reinterpret_cast<const bf16x8*>(Qw + d0 * 16);
    const float* cs = CS + trow * 32 + hi * 16;
    bf16x8 q4 = qr[4], q5 = qr[5];
    unsigned w4[4], w5[4];
#pragma unroll
    for (int jj = 0; jj < 4; ++jj) {
      const float4 c2 = *reinterpret_cast<const float4*>(cs + jj * 4);
      const float a0 = bf2f(q4[2 * jj]), b0 = bf2f(q5[2 * jj]), a1 = bf2f(q4[2 * jj + 1]), b1 = bf2f(q5[2 * jj + 1]);
      w4[jj] = cvtpk(a0 * c2.x - b0 * c2.y, a1 * c2.z - b1 * c2.w);
      w5[jj] = cvtpk(b0 * c2.x + a0 * c2.y, b1 * c2.z + a1 * c2.w);
    }
    u32x4 W4 = {w4[0], w4[1], w4[2], w4[3]}, W5 = {w5[0], w5[1], w5[2], w5[3]};
    qr[4] = *reinterpret_cast<bf16x8*>(&W4); qr[5] = *reinterpret_cast<bf16x8*>(&W5);
  }
  const int sr = tid >> 3, sc = (tid & 7) * 8, vst0 = v_st(sr, sc);
  const int rr = (tid & 255) >> 2, rc = (tid & 3) * 8;
  const bool rope_w = tid < 256;
  const bf16_t* Vg = KV + (tk0 + sr) * LDKV + h * 128 + 64 + sc;
  const bf16_t* Kg = KV + (tk0 + sr) * LDKV + h * 128 + sc;
  const bf16_t* Rg = KR + (tk0 + rr) * 32 + rc;
  const int vb0 = (int)(uintptr_t)V_lds + v_rd_base(lane);
  struct { bf16x8 vs, ks, rs; } sr_[2];
#define SLOAD(i, k0) do { sr_[i].vs = *reinterpret_cast<const bf16x8*>(Vg + (long)(k0) * LDKV); sr_[i].ks = *reinterpret_cast<const bf16x8*>(Kg + (long)(k0) * LDKV); \
    sr_[i].rs = *reinterpret_cast<const bf16x8*>(Rg + (long)(k0) * 32); } while (0)
#define SWRITE(b, i) do { *(bf16x8*)((char*)V_lds + (b) * SHM_V + vst0) = sr_[i].vs;          \
    *(bf16x8*)((char*)K_lds + (b) * SHM_K + KSWZ(sr, sc * 2)) = sr_[i].ks;                       \
    if (rope_w) *(bf16x8*)((char*)K_lds + (b) * SHM_K + KSWZ(rr, (64 + rc) * 2)) = sr_[i].rs; } while (0)
#define SWAIT() asm volatile("s_waitcnt vmcnt(3)" ::: "memory")
#define RESC(a) do { if (__any((a) < 1.f)) { if (hi == 0) al_l[r32] = (a); asm volatile("s_waitcnt lgkmcnt(0)" ::: "memory"); \
    for (int d = 0; d < 2; ++d) for (int r = 0; r < 16; ++r) o[d][r] *= al_l[crow(r, hi)]; } } while (0)
  f32x16 pA0, pA1, pB0, pB1; float mnA, mnB, alA, alB; bf16x8 pa0, pa1, pa2, pa3; const int NT = seq / KVBLK;
  constexpr int SE = 0, SO = 1;
  SLOAD(SE, 0); asm volatile("s_waitcnt vmcnt(0)" ::: "memory"); SWRITE(0, SE); __syncthreads();
  qkt(pA0, pA1, K_lds, qr, r32, hi); partialSM(pA0, pA1, m_reg, mnA, alA);
  SLOAD(SO, KVBLK); if (2 < NT) SLOAD(SE, 2 * KVBLK);
  SWAIT(); SWRITE(1, SO); __syncthreads();
  for (int j = 1; j + 1 < NT; j += 2) {
    SBAR(); qkt(pB0, pB1, (bf16_t*)((char*)K_lds + SHM_K), qr, r32, hi);
    finishSM(pA0, pA1, alA, l_reg, pa0, pa1, pa2, pa3); SBAR();
    SLOAD(SO, (j + 2) * KVBLK); SBAR();
    pv_d0(o, vb0, pa0, pa1, pa2, pa3); partialSM(pB0, pB1, m_reg, mnB, alB);
    __syncthreads(); SWAIT(); SWRITE(0, SE);
    RESC(alB); __syncthreads();
    SBAR(); qkt(pA0, pA1, K_lds, qr, r32, hi);
    finishSM(pB0, pB1, alB, l_reg, pa0, pa1, pa2, pa3); SBAR();
    if (j + 3 < NT) SLOAD(SE, (j + 3) * KVBLK); SBAR();
    pv_d0(o, vb0 + (int)SHM_V, pa0, pa1, pa2, pa3); partialSM(pA0, pA1, m_reg, mnA, alA);
    __syncthreads(); SWAIT(); SWRITE(1, SO);
    RESC(alA); __syncthreads();
  }
  SBAR(); qkt(pB0, pB1, (bf16_t*)((char*)K_lds + SHM_K), qr, r32, hi);
  finishSM(pA0, pA1, alA, l_reg, pa0, pa1, pa2, pa3); SBAR();
  pv_d0(o, vb0, pa0, pa1, pa2, pa3); partialSM(pB0, pB1, m_reg, mnB, alB);
  __syncthreads(); RESC(alB);
  finishSM(pB0, pB1, alB, l_reg, pa0, pa1, pa2, pa3); SBAR();
  pv_d0(o, vb0 + (int)SHM_V, pa0, pa1, pa2, pa3);
  if (hi == 0) li_l[r32] = l_reg; asm volatile("s_waitcnt lgkmcnt(0)" ::: "memory");
  float rli[16];
#pragma unroll
  for (int r = 0; r < 16; ++r) rli[r] = __builtin_amdgcn_rcpf(li_l[crow(r, hi)]);
  bf16_t* Ow = O + (tq0 + wid * QBLK) * LDO + h * VD;
#pragma unroll
  for (int r = 0; r < 16; ++r) { int orow = crow(r, hi);
#pragma unroll
    for (int d0 = 0; d0 < 2; ++d0) Ow[(long)orow * LDO + d0 * 32 + r32] = (bf16_t)(cvtpk(o[d0][r] * rli[r], 0.f) & 0xffffu); }
  __syncthreads();
#undef SLOAD
#undef SWRITE
#undef SWAIT
#undef RESC
}
#undef KSWZ
#undef SBAR
}

namespace attn2 {
using bf16=__hip_bfloat16;
using bf16x8=__attribute__((ext_vector_type(8)))short;
using s16x4=__attribute__((ext_vector_type(4)))short;
using f32x16=__attribute__((ext_vector_type(16)))float;
using u32x4=__attribute__((ext_vector_type(4)))unsigned;
constexpr int NHEAD=8,DQK=96,DV=64,PQ=NHEAD*DQK  ,PKV=NHEAD*128  ,PKR=32  ,PO=NHEAD*DV  ;
constexpr int NW=8,QBLK=32,QB=QBLK*NW,KVBLK=64,NQB=SEQ/QB;
constexpr int ATTN_UNIT_ROWS=QB;
__device__ __forceinline__ int crow(int r,int hi){return (r&3)+8*(r>>2)+4*hi;}
#define SBAR() __builtin_amdgcn_sched_barrier(0)
__device__ __forceinline__ void cmask(f32x16&p0,f32x16&p1,int jb,int qrel,int hi){
  const float NEG=-INFINITY; int kb=64*jb+4*hi;
  #pragma unroll
  for(int r=0;r<16;++r){int kv=kb+(r&3)+8*(r>>2); if(kv>qrel)p0[r]=NEG; if(kv+32>qrel)p1[r]=NEG;}
}

constexpr int NSLOT=3, SLOTK=8192, SLOTR=4096, SLOTV=8192;
constexpr int LDS_K=0, LDS_V=NSLOT*SLOTK, LDS_R=LDS_V+NSLOT*SLOTV, LDS_WS=LDS_R+NSLOT*SLOTR, LDS_OST=LDS_WS+NW*64*4, LDS_BYTES=LDS_OST+NW*4096;
constexpr float C2=0.10206207261596575f*1.4426950408889634f;
__device__ __forceinline__ void glds16(const void*gsrc,unsigned lds_dst){
  asm volatile("s_mov_b32 m0, %1\n\ts_nop 0\n\tglobal_load_lds_dwordx4 %0, off"::"v"(gsrc),"s"(lds_dst):"memory");}
__device__ __forceinline__ float max3f(float a,float b,float c){float r;asm("v_max3_f32 %0, %1, %2, %3":"=v"(r):"v"(a),"v"(b),"v"(c));return r;}
__device__ __forceinline__ float max2f(float a,float b){float r;asm("v_max_f32_e32 %0, %1, %2":"=v"(r):"v"(a),"v"(b));return r;}
__device__ __forceinline__ float fadd_s(float a,float b){float r;asm("v_add_f32_e32 %0, %1, %2":"=v"(r):"v"(a),"v"(b));return r;}
__device__ __forceinline__ float fsub_s(float a,float b){float r;asm("v_sub_f32_e32 %0, %1, %2":"=v"(r):"v"(a),"v"(b));return r;}
typedef float f32x2_t __attribute__((ext_vector_type(2))); typedef __bf16 bf16x2_t __attribute__((ext_vector_type(2)));
__device__ __forceinline__ unsigned cvtpk_s(float lo,float hi){f32x2_t v={lo,hi};bf16x2_t b=__builtin_convertvector(v,bf16x2_t);return __builtin_bit_cast(unsigned,b);}
#define WAIT_BAR(N) asm volatile("s_waitcnt vmcnt(" #N ") lgkmcnt(0)\n\ts_barrier":::"memory")

__device__ __forceinline__ void qkt(f32x16&p0,f32x16&p1,const char*Kslot,const char*Rslot,const bf16x8*qr,const f32x16&negm,int r32,int hi){
  const char*kb=Kslot+hi*1024+r32*16; const char*rb=Rslot+hi*1024+r32*16-4*2048;
  #pragma unroll
  for(int d0=0;d0<6;++d0){
    const bf16x8 b0=*reinterpret_cast<const bf16x8*>((d0<4?kb:rb)+d0*2048);
    const bf16x8 b1=*reinterpret_cast<const bf16x8*>((d0<4?kb:rb)+d0*2048+512);
    if(d0==0){p0=__builtin_amdgcn_mfma_f32_32x32x16_bf16(b0,qr[0],negm,0,0,0);p1=__builtin_amdgcn_mfma_f32_32x32x16_bf16(b1,qr[0],negm,0,0,0);}
    else{p0=__builtin_amdgcn_mfma_f32_32x32x16_bf16(b0,qr[d0],p0,0,0,0);p1=__builtin_amdgcn_mfma_f32_32x32x16_bf16(b1,qr[d0],p1,0,0,0);}}
}
typedef __attribute__((address_space(3))) const char* lds_cptr;
typedef short v4i16_t __attribute__((ext_vector_type(4)));
__device__ __forceinline__ void kload8(bf16x8*kf,lds_cptr kp){
  kf[0]=*(const __attribute__((address_space(3))) bf16x8*)(kp);      kf[1]=*(const __attribute__((address_space(3))) bf16x8*)(kp+512);
  kf[2]=*(const __attribute__((address_space(3))) bf16x8*)(kp+2048); kf[3]=*(const __attribute__((address_space(3))) bf16x8*)(kp+2560);
  kf[4]=*(const __attribute__((address_space(3))) bf16x8*)(kp+4096); kf[5]=*(const __attribute__((address_space(3))) bf16x8*)(kp+4608);
  kf[6]=*(const __attribute__((address_space(3))) bf16x8*)(kp+6144); kf[7]=*(const __attribute__((address_space(3))) bf16x8*)(kp+6656);
}
__device__ __forceinline__ void kload2(bf16x8*kf,lds_cptr kp,int j){ kf[2*j]=*(const __attribute__((address_space(3))) bf16x8*)(kp+j*2048); kf[2*j+1]=*(const __attribute__((address_space(3))) bf16x8*)(kp+j*2048+512); }
__device__ __forceinline__ s16x4 vtr(lds_cptr p){ return __builtin_bit_cast(s16x4,__builtin_amdgcn_ds_read_tr16_b64_v4i16((__attribute__((address_space(3))) v4i16_t*)p)); }
__device__ __forceinline__ float rowmax(const f32x16&p0,const f32x16&p1){
  float a=max3f(p0[0],p0[1],p1[0]),b=max3f(p0[2],p0[3],p1[1]);a=max3f(a,p1[2],p1[3]);
  #pragma unroll
  for(int r=4;r<16;r+=4){a=max3f(a,p0[r],p0[r+1]);b=max3f(b,p0[r+2],p0[r+3]);a=max3f(a,p1[r],p1[r+1]);b=max3f(b,p1[r+2],p1[r+3]);}
  const float m=max2f(a,b);
  auto rr=__builtin_amdgcn_permlane32_swap(__float_as_uint(m),__float_as_uint(m),false,false);
  return max2f(__uint_as_float(rr[0]),__uint_as_float(rr[1]));
}
__device__ __forceinline__ void pv(f32x16*o,int vb,bf16x8 pa0,bf16x8 pa1,bf16x8 pa2,bf16x8 pa3){
  #pragma unroll
  for(int d0=0;d0<2;++d0){s16x4 lo[4],hi[4];
    #pragma unroll
    for(int ks=0;ks<4;++ks){
      asm volatile("ds_read_b64_tr_b16 %0,%1 offset:%c2":"=&v"(lo[ks]):"v"(vb),"i"(d0*4096+ks*1024):"memory");
      asm volatile("ds_read_b64_tr_b16 %0,%1 offset:%c2":"=&v"(hi[ks]):"v"(vb),"i"(d0*4096+ks*1024+512):"memory");}
    asm volatile("s_waitcnt lgkmcnt(0)":::"memory");SBAR();
    #define PK(k) (bf16x8){lo[k][0],lo[k][1],lo[k][2],lo[k][3],hi[k][0],hi[k][1],hi[k][2],hi[k][3]}
    o[d0]=__builtin_amdgcn_mfma_f32_32x32x16_bf16(pa0,PK(0),o[d0],0,0,0);
    o[d0]=__builtin_amdgcn_mfma_f32_32x32x16_bf16(pa1,PK(1),o[d0],0,0,0);
    o[d0]=__builtin_amdgcn_mfma_f32_32x32x16_bf16(pa2,PK(2),o[d0],0,0,0);
    o[d0]=__builtin_amdgcn_mfma_f32_32x32x16_bf16(pa3,PK(3),o[d0],0,0,0);
    #undef PK
  }
}

#ifndef ATTN_STORE16
#define ATTN_STORE16(p,v) (*(u32x4*)(p)=(v))
#endif
template<int THRL> __device__ __forceinline__ void attn_unit(int b,int h,int qb,const bf16*Q,const bf16*__restrict__ KV,const bf16*__restrict__ KR,const float*__restrict__ CS,bf16*O,char*shm,const int tid){
  const int lane=tid&63,r32=lane&31,hi=lane>>5; const int wid=__builtin_amdgcn_readfirstlane(tid>>6);
  unsigned m0keep; asm volatile("s_mov_b32 %0, m0":"=s"(m0keep));
  const long rowbase=(long)b*SEQ; const int q0=qb*QB;
  const bf16*Qw=Q+(rowbase+q0+wid*QBLK)*PQ+h*DQK;
  const bf16*Kh=KV+rowbase*PKV+h*128,*Vh=KV+rowbase*PKV+h*128+64,*Rh=KR+rowbase*PKR;
  const unsigned lds0=(unsigned)(uintptr_t)shm;
  float*wsf=(float*)(shm+LDS_WS)+wid*64;
  const bf16*ksrc=Kh+(long)lane*PKV+wid*8;
  const bf16*rsrc=Rh+(long)lane*PKR+(wid&3)*8;
  const bf16*vsrc=Vh+(long)(16*(wid&3)+(lane>>2))*PKV+(wid>>2)*32+(lane&3)*8;
  const unsigned kdst=lds0+LDS_K+wid*1024, rdst=lds0+LDS_R+(wid&3)*1024, vdst=lds0+LDS_V+wid*1024;
  #define DMA_K(t,slot) glds16(ksrc+(long)(t)*KVBLK*PKV,(unsigned)__builtin_amdgcn_readfirstlane(kdst+(slot)*SLOTK))
  #define DMA_R(t,slot) glds16(rsrc+(long)(t)*KVBLK*PKR,(unsigned)__builtin_amdgcn_readfirstlane(rdst+(slot)*SLOTR))
  #define DMA_V(t,slot) glds16(vsrc+(long)(t)*KVBLK*PKV,(unsigned)__builtin_amdgcn_readfirstlane(vdst+(slot)*SLOTV))
  const int vb0=(int)(lds0+LDS_V)+((lane>>4)&1)*32+(lane&3)*8+(4*hi+((lane&15)>>2))*64;
  const char*Kbase=shm+LDS_K; bf16x8 kf[8];
  const lds_cptr shm3=(lds_cptr)shm; const lds_cptr kp0=shm3+LDS_K+hi*1024+r32*16; const lds_cptr rp0=shm3+LDS_R+hi*1024+r32*16; const lds_cptr vp0=shm3+LDS_V+((lane>>4)&1)*32+(lane&3)*8+(4*hi+((lane&15)>>2))*64;
  const int NT=SEQ/KVBLK;
  DMA_K(0,0);DMA_R(0,0);DMA_V(0,0);DMA_K(1,1);DMA_R(1,1);
  bf16x8 qr[6];
  #pragma unroll
  for(int d0=0;d0<6;++d0)qr[d0]=*reinterpret_cast<const bf16x8*>(&Qw[(long)r32*PQ+d0*16+hi*8]);
  {
    const float*cs=CS+(rowbase+q0+wid*QBLK+r32)*32+hi*16; const bf16x8 q4=qr[4],q5=qr[5]; unsigned w4[4],w5[4];
    #pragma unroll
    for(int jj=0;jj<4;++jj){ const float4 c2=*reinterpret_cast<const float4*>(cs+jj*4);
      const float a0=__uint_as_float(((unsigned)(unsigned short)q4[2*jj])<<16),b0=__uint_as_float(((unsigned)(unsigned short)q5[2*jj])<<16),a1=__uint_as_float(((unsigned)(unsigned short)q4[2*jj+1])<<16),b1=__uint_as_float(((unsigned)(unsigned short)q5[2*jj+1])<<16);
      w4[jj]=cvtpk_s(a0*c2.x-b0*c2.y,a1*c2.z-b1*c2.w); w5[jj]=cvtpk_s(b0*c2.x+a0*c2.y,b1*c2.z+a1*c2.w); }
    const u32x4 W4={w4[0],w4[1],w4[2],w4[3]},W5={w5[0],w5[1],w5[2],w5[3]}; qr[4]=__builtin_bit_cast(bf16x8,W4); qr[5]=__builtin_bit_cast(bf16x8,W5); }
  float mhat=0.f,l_reg=0.f;f32x16 o[2];o[0]=f32x16{};o[1]=f32x16{};f32x16 negm=f32x16{};asm volatile("":"+v"(negm));
  #define CMASK(P0,P1,t) do{}while(0)
  bool resc=false;
  #define START(P0,P1) do{ const float rm=rowmax(P0,P1); resc=false; \
    { const float dl=rm; mhat=fadd_s(mhat,dl); \
      _Pragma("unroll") for(int r=0;r<16;++r){P0[r]=fsub_s(P0[r],dl);P1[r]=fsub_s(P1[r],dl);} \
      _Pragma("unroll") for(int r=0;r<16;++r)negm[r]=-mhat; asm volatile("":"+v"(negm)); } \
    _Pragma("unroll") for(int r=0;r<16;++r)P0[r]=__builtin_amdgcn_exp2f(P0[r]); }while(0)
  #define RESC() do{ if(resc){ asm volatile("s_waitcnt lgkmcnt(0)":::"memory"); \
      _Pragma("unroll") for(int d_=0;d_<2;++d_) _Pragma("unroll") for(int r=0;r<16;++r)o[d_][r]*=wsf[crow(r,hi)]; } }while(0)
  f32x16 pA0,pA1,pB0,pB1;
  int sl_prev=0,sl_cur=0,sl_next=1;
  #define ROT() do{sl_prev=sl_cur;sl_cur=sl_next;sl_next=(sl_next==NSLOT-1)?0:sl_next+1;}while(0)
  DMA_K(2,2);
  WAIT_BAR(3);
  qkt(pA0,pA1,Kbase,shm+LDS_R,qr,negm,r32,hi);asm volatile("s_nop 15\n\ts_nop 7":"+v"(pA0),"+v"(pA1));CMASK(pA0,pA1,0);
  START(pA0,pA1);
  _Pragma("unroll") for(int r=0;r<16;++r)pA1[r]=__builtin_amdgcn_exp2f(pA1[r]);
  WAIT_BAR(0);
  DMA_K(3,0);DMA_R(2,2);DMA_V(1,1);
  ROT();
  kload8(kf,kp0+sl_cur*SLOTK);
  WAIT_BAR(3);
  s16x4 vlo[8],vhi[8]; u32x4 pw0,pw1,pw2,pw3;
  #define PKW(P,B) cvtpk_s(P[B],P[B+1])
  #define PAF(k) __builtin_bit_cast(bf16x8,pw##k)
  #define VFR(i) (bf16x8){vlo[i][0],vlo[i][1],vlo[i][2],vlo[i][3],vhi[i][0],vhi[i][1],vhi[i][2],vhi[i][3]}
  #define PIN(x) asm volatile("":"+v"(x))
  #define MX3(a,b,c) __builtin_fmaxf(__builtin_fmaxf((a),(b)),(c))
  #define MX2(a,b) __builtin_fmaxf((a),(b))
  #define LGKM0() __builtin_amdgcn_s_waitcnt(0xC07F)
  #define GAPA(MF,A0,A1,A2,A3,W0,W1,PW) do{ MF; sacc+=A0; sacc+=A1; sacc+=A2; sacc+=A3; PIN(sacc); W0; W1; PIN(PW); SBAR(); }while(0)
  #define EX(v) __builtin_amdgcn_exp2f(v)
  #define GAPB(MF,X,B) do{ MF; X[B]=EX(X[B]); X[B+1]=EX(X[B+1]); X[B+2]=EX(X[B+2]); X[B+3]=EX(X[B+3]); PIN(X); SBAR(); }while(0)
  #define VRD(i) do{ vlo[i]=vtr(vp_+(((i)>>2)*4096+((i)&3)*1024)); vhi[i]=vtr(vp_+(((i)>>2)*4096+((i)&3)*1024+512)); }while(0)
  #define KRD(G,j) do{ if(G){ kload2(kf,kp0+sl_next*SLOTK,j); SBAR(); } }while(0)
  #define STEP(C0,C1,P0,P1,t,GK,GR,GV,GL) do{ SBAR(); bf16x8 krf0,krf1,krf2,krf3; \
    const lds_cptr vp_=vp0+sl_prev*SLOTV; \
    float sacc=(P0[0]+P0[1]); LGKM0(); \
    C0=__builtin_amdgcn_mfma_f32_32x32x16_bf16(kf[0],qr[0],negm,0,0,0); sacc+=P0[2]; sacc+=P0[3]; sacc+=P0[4]; PIN(sacc); pw0[0]=PKW(P0,0); pw0[1]=PKW(P0,2); PIN(pw0); SBAR(); \
    C1=__builtin_amdgcn_mfma_f32_32x32x16_bf16(kf[1],qr[0],negm,0,0,0); sacc+=P0[5]; sacc+=P0[6]; sacc+=P0[7]; PIN(sacc); pw0[2]=PKW(P0,4); PIN(pw0); SBAR(); \
    C0=__builtin_amdgcn_mfma_f32_32x32x16_bf16(kf[2],qr[1],C0,0,0,0); sacc+=P0[8]; sacc+=P0[9]; sacc+=P0[10]; PIN(sacc); pw0[3]=PKW(P0,6); PIN(pw0); SBAR(); \
    C1=__builtin_amdgcn_mfma_f32_32x32x16_bf16(kf[3],qr[1],C1,0,0,0); sacc+=P0[11]; sacc+=P0[12]; sacc+=P0[13]; PIN(sacc); pw1[0]=PKW(P0,8); pw1[1]=PKW(P0,10); PIN(pw1); SBAR(); \
    { const lds_cptr rp_=rp0+sl_cur*SLOTR; krf0=*(const __attribute__((address_space(3))) bf16x8*)(rp_); krf1=*(const __attribute__((address_space(3))) bf16x8*)(rp_+512); krf2=*(const __attribute__((address_space(3))) bf16x8*)(rp_+2048); krf3=*(const __attribute__((address_space(3))) bf16x8*)(rp_+2560); } SBAR(); \
    C0=__builtin_amdgcn_mfma_f32_32x32x16_bf16(kf[4],qr[2],C0,0,0,0); sacc+=P0[14]; sacc+=P0[15]; PIN(sacc); pw1[2]=PKW(P0,12); PIN(pw1); SBAR(); \
    C1=__builtin_amdgcn_mfma_f32_32x32x16_bf16(kf[5],qr[2],C1,0,0,0); sacc+=P1[0]; sacc+=P1[1]; PIN(sacc); pw1[3]=PKW(P0,14); PIN(pw1); SBAR(); \
    C0=__builtin_amdgcn_mfma_f32_32x32x16_bf16(kf[6],qr[3],C0,0,0,0); sacc+=P1[2]; sacc+=P1[3]; PIN(sacc); pw2[0]=PKW(P1,0); pw2[1]=PKW(P1,2); PIN(pw2); SBAR(); \
    C1=__builtin_amdgcn_mfma_f32_32x32x16_bf16(kf[7],qr[3],C1,0,0,0); sacc+=P1[4]; sacc+=P1[5]; PIN(sacc); pw2[2]=PKW(P1,4); PIN(pw2); SBAR(); \
    LGKM0(); C0=__builtin_amdgcn_mfma_f32_32x32x16_bf16(krf0,qr[4],C0,0,0,0); sacc+=P1[6]; sacc+=P1[7]; sacc+=P1[8]; PIN(sacc); pw2[3]=PKW(P1,6); PIN(pw2); SBAR(); \
    C1=__builtin_amdgcn_mfma_f32_32x32x16_bf16(krf1,qr[4],C1,0,0,0); sacc+=P1[9]; sacc+=P1[10]; sacc+=P1[11]; PIN(sacc); pw3[0]=PKW(P1,8); pw3[1]=PKW(P1,10); PIN(pw3); SBAR(); \
    C0=__builtin_amdgcn_mfma_f32_32x32x16_bf16(krf2,qr[5],C0,0,0,0); sacc+=P1[12]; sacc+=P1[13]; PIN(sacc); pw3[2]=PKW(P1,12); PIN(pw3); SBAR(); \
    C1=__builtin_amdgcn_mfma_f32_32x32x16_bf16(krf3,qr[5],C1,0,0,0); sacc+=P1[14]; sacc+=P1[15]; PIN(sacc); pw3[3]=PKW(P1,14); PIN(pw3); SBAR(); \
    l_reg+=sacc; \
    if(GK){DMA_K((t)+3,sl_cur);} if(GR){DMA_R((t)+2,sl_prev);} if(GV){DMA_V((t)+1,sl_next);} \
    CMASK(C0,C1,t); \
    { float a=MX3(C0[0],C0[1],C1[0]),b=MX3(C0[2],C0[3],C1[1]); a=MX3(a,C1[2],C1[3]); \
      _Pragma("unroll") for(int r=4;r<16;r+=4){a=MX3(a,C0[r],C0[r+1]);b=MX3(b,C0[r+2],C0[r+3]);a=MX3(a,C1[r],C1[r+1]);b=MX3(b,C1[r+2],C1[r+3]);} \
      float rm=MX2(a,b); { auto rr=__builtin_amdgcn_permlane32_swap(__float_as_uint(rm),__float_as_uint(rm),false,false); rm=MX2(__uint_as_float(rr[0]),__uint_as_float(rr[1])); } \
      resc=false; \
      if(__builtin_expect(__any(rm>(float)THRL),0)){ const float dl=__builtin_fmaxf(rm,0.f); mhat+=dl; \
        _Pragma("unroll") for(int r=0;r<16;++r){C0[r]-=dl;C1[r]-=dl;} \
        _Pragma("unroll") for(int r=0;r<16;++r)negm[r]=-mhat; asm volatile("":"+v"(negm)); \
        const float f=__builtin_amdgcn_exp2f(-dl); l_reg*=f; if(hi==0)wsf[r32]=f; resc=true; } } \
    SBAR(); VRD(0); VRD(4); SBAR(); \
    GAPB(o[0]=__builtin_amdgcn_mfma_f32_32x32x16_bf16(PAF(0),VFR(0),o[0],0,0,0), C0,0); VRD(1); SBAR(); \
    GAPB(o[1]=__builtin_amdgcn_mfma_f32_32x32x16_bf16(PAF(0),VFR(4),o[1],0,0,0), C0,4); VRD(5); SBAR(); \
    KRD(GL,0); GAPB(o[0]=__builtin_amdgcn_mfma_f32_32x32x16_bf16(PAF(1),VFR(1),o[0],0,0,0), C0,8); VRD(2); SBAR(); \
    KRD(GL,1); GAPB(o[1]=__builtin_amdgcn_mfma_f32_32x32x16_bf16(PAF(1),VFR(5),o[1],0,0,0), C0,12); VRD(6); SBAR(); \
    KRD(GL,2); GAPB(o[0]=__builtin_amdgcn_mfma_f32_32x32x16_bf16(PAF(2),VFR(2),o[0],0,0,0), C1,0); VRD(3); SBAR(); \
    KRD(GL,3); GAPB(o[1]=__builtin_amdgcn_mfma_f32_32x32x16_bf16(PAF(2),VFR(6),o[1],0,0,0), C1,4); VRD(7); SBAR(); \
    GAPB(o[0]=__builtin_amdgcn_mfma_f32_32x32x16_bf16(PAF(3),VFR(3),o[0],0,0,0), C1,8); \
    GAPB(o[1]=__builtin_amdgcn_mfma_f32_32x32x16_bf16(PAF(3),VFR(7),o[1],0,0,0), C1,12); \
    }while(0)
  int t=1;
  #undef CMASK
  #define CMASK(P0,P1,t) do{}while(0)
  for(;t+5<NT;t+=2){
    STEP(pB0,pB1,pA0,pA1,t,true,true,true,true);     WAIT_BAR(3); RESC(); ROT();
    STEP(pA0,pA1,pB0,pB1,t+1,true,true,true,true);   WAIT_BAR(3); RESC(); ROT();
  }
  #define ENDW(tt) do{ if((tt)+3<NT){WAIT_BAR(3);} else if((tt)+2<NT){WAIT_BAR(2);} else {WAIT_BAR(0);} }while(0)
  for(;t+1<NT;t+=2){
    STEP(pB0,pB1,pA0,pA1,t,(t+3<NT),(t+2<NT),(t+1<NT),(t+1<NT));       ENDW(t);   RESC(); ROT();
    STEP(pA0,pA1,pB0,pB1,t+1,(t+4<NT),(t+3<NT),(t+2<NT),(t+2<NT));     ENDW(t+1); RESC(); ROT();
  }
  STEP(pB0,pB1,pA0,pA1,NT-1,false,false,false,false); RESC();
  { float sacc=pB0[0]+pB0[1]; _Pragma("unroll") for(int r=2;r<16;++r)sacc+=pB0[r]; _Pragma("unroll") for(int r=0;r<16;++r)sacc+=pB1[r]; l_reg+=sacc;
    pw0=(u32x4){PKW(pB0,0),PKW(pB0,2),PKW(pB0,4),PKW(pB0,6)};pw1=(u32x4){PKW(pB0,8),PKW(pB0,10),PKW(pB0,12),PKW(pB0,14)};pw2=(u32x4){PKW(pB1,0),PKW(pB1,2),PKW(pB1,4),PKW(pB1,6)};pw3=(u32x4){PKW(pB1,8),PKW(pB1,10),PKW(pB1,12),PKW(pB1,14)};
    SBAR(); pv(o,vb0+sl_cur*SLOTV,PAF(0),PAF(1),PAF(2),PAF(3)); }
  #undef PKW
  #undef PAF
  #undef VFR
  #undef PIN
  #undef MX3
  #undef GAPA
  #undef GAPB
  #undef EX
  #undef VRD
  #undef KRD
  #undef STEP
  #undef ENDW
  {auto rr=__builtin_amdgcn_permlane32_swap(__float_as_uint(l_reg),__float_as_uint(l_reg),false,false);l_reg=__uint_as_float(rr[0])+__uint_as_float(rr[1]);}
  if(hi==0)wsf[32+r32]=l_reg;asm volatile("s_waitcnt lgkmcnt(0)":::"memory");
  float rli[16];
  #pragma unroll
  for(int r=0;r<16;++r)rli[r]=__builtin_amdgcn_rcpf(wsf[32+crow(r,hi)]);
  bf16*Ow=O+(rowbase+q0+wid*QBLK)*PO+h*DV;
  { bf16*stg=(bf16*)(shm+LDS_OST)+wid*2048;
    #pragma unroll
    for(int r=0;r<16;++r){const int orow=crow(r,hi);
      #pragma unroll
      for(int d0=0;d0<2;++d0)stg[orow*64+d0*32+r32]=__float2bfloat16(o[d0][r]*rli[r]);}
    asm volatile("s_waitcnt lgkmcnt(0)":::"memory");
    #pragma unroll
    for(int i=0;i<4;++i){const int row=i*8+(lane>>3),ch=lane&7; const u32x4 v=*(const u32x4*)(stg+row*64+ch*8); ATTN_STORE16(Ow+(long)row*PO+ch*8,v);} }
  asm volatile("s_waitcnt lgkmcnt(0)\n\ts_barrier":::"memory");
  asm volatile("s_mov_b32 m0, %0"::"s"(m0keep));
  #undef DMA_K
  #undef DMA_V
  #undef CMASK
  #undef START
  #undef RESC
  #undef ROT
}
constexpr int ATTN_LDS_BYTES=LDS_BYTES;
#undef SBAR
#undef WAIT_BAR
}

namespace hy {
typedef float2 cf;
typedef unsigned short bf16_t;
constexpr int N = NFFT, L = SEQ;
constexpr int ZELEMS = 17408;
__device__ __forceinline__ float fadd_(float a, float b) { float r; asm("v_add_f32_e32 %0, %1, %2" : "=v"(r) : "v"(a), "v"(b)); return r; }
__device__ __forceinline__ float fsub_(float a, float b) { float r; asm("v_sub_f32_e32 %0, %1, %2" : "=v"(r) : "v"(a), "v"(b)); return r; }
__device__ __forceinline__ float fmul_(float a, float b) { float r; asm("v_mul_f32_e32 %0, %1, %2" : "=v"(r) : "v"(a), "v"(b)); return r; }
__device__ __forceinline__ float ffma_(float a, float b, float c) { float r; asm("v_fma_f32 %0, %1, %2, %3" : "=v"(r) : "v"(a), "v"(b), "v"(c)); return r; }
__device__ __forceinline__ float fnma_(float a, float b, float c) { float r; asm("v_fma_f32 %0, -%1, %2, %3" : "=v"(r) : "v"(a), "v"(b), "v"(c)); return r; }
__device__ __forceinline__ cf cmul(cf a, cf b) { return make_float2(fnma_(a.y, b.y, fmul_(a.x, b.x)), ffma_(a.x, b.y, fmul_(a.y, b.x))); }
__device__ __forceinline__ cf cadd(cf a, cf b) { return make_float2(fadd_(a.x, b.x), fadd_(a.y, b.y)); }
__device__ __forceinline__ cf csub(cf a, cf b) { return make_float2(fsub_(a.x, b.x), fsub_(a.y, b.y)); }
__device__ __forceinline__ float bf_lo(unsigned w) { return __uint_as_float(w << 16); }
__device__ __forceinline__ float bf_hi(unsigned w) { return __uint_as_float(w & 0xffff0000u); }
__device__ constexpr int BR16[16] = {0, 8, 4, 12, 2, 10, 6, 14, 1, 9, 5, 13, 3, 11, 7, 15};
__device__ constexpr int BR4[4] = {0, 2, 1, 3};
#define bitrev(p, R) (((R) == 16) ? BR16[(p) & 15] : BR4[(p) & 3])
__device__ constexpr float C32[16] = {1.0f, 0.98078528040323043f, 0.92387953251128674f, 0.83146961230254524f, 0.70710678118654752f, 0.55557023301960218f, 0.38268343236508977f, 0.19509032201612825f,
                                      0.0f, -0.19509032201612825f, -0.38268343236508977f, -0.55557023301960218f, -0.70710678118654752f, -0.83146961230254524f, -0.92387953251128674f, -0.98078528040323043f};
__device__ constexpr float S32[16] = {0.0f, 0.19509032201612825f, 0.38268343236508977f, 0.55557023301960218f, 0.70710678118654752f, 0.83146961230254524f, 0.92387953251128674f, 0.98078528040323043f,
                                      1.0f, 0.98078528040323043f, 0.92387953251128674f, 0.83146961230254524f, 0.70710678118654752f, 0.55557023301960218f, 0.38268343236508977f, 0.19509032201612825f};
template <int SGN> __device__ __forceinline__ cf twc(cf d, int tk) {
    if (tk == 0) return d;
    if (tk == 8) return (SGN < 0) ? make_float2(d.y, -d.x) : make_float2(-d.y, d.x);
    const float c = C32[tk], s = (SGN < 0) ? -S32[tk] : S32[tk]; return make_float2(fnma_(d.y, s, fmul_(d.x, c)), ffma_(d.x, s, fmul_(d.y, c)));
}
template <int R, int LEN, int SGN> struct DftStage {
    static __device__ __forceinline__ void run(cf (&v)[R]) {
        constexpr int half = LEN / 2;
#pragma unroll
        for (int blk = 0; blk < R; blk += LEN) {
#pragma unroll
            for (int k = 0; k < half; ++k) {
                const cf a = v[blk + k], b = v[blk + k + half];
                v[blk + k] = cadd(a, b);
                v[blk + k + half] = twc<SGN>(csub(a, b), k * (32 / LEN));
            }
        }
        DftStage<R, LEN / 2, SGN>::run(v);
    }
};
template <int R, int SGN> struct DftStage<R, 1, SGN> { static __device__ __forceinline__ void run(cf (&)[R]) {} };
template <int R, int SGN> __device__ __forceinline__ void dft_reg(cf (&v)[R]) { DftStage<R, R, SGN>::run(v); }
__device__ __forceinline__ void dft16_fwd_halfzero(cf (&v)[16]) {
#pragma unroll
    for (int k = 0; k < 8; ++k) v[k + 8] = twc<-1>(v[k], 2 * k);
    DftStage<16, 8, -1>::run(v);
}
__device__ __forceinline__ void tw_apply_br(cf (&v)[16], cf w1) {
    const cf w2 = cmul(w1, w1), w3 = cmul(w2, w1), w4 = cmul(w2, w2);
    cf c0 = w4, c1 = w1, c2 = w2, c3 = w3;
#pragma unroll
    for (int k = 0; k < 4; ++k) {
        if (k > 0) { v[bitrev(4 * k, 16)] = cmul(v[bitrev(4 * k, 16)], c0); c0 = cmul(c0, w4); }
        v[bitrev(4 * k + 1, 16)] = cmul(v[bitrev(4 * k + 1, 16)], c1); c1 = cmul(c1, w4);
        v[bitrev(4 * k + 2, 16)] = cmul(v[bitrev(4 * k + 2, 16)], c2); c2 = cmul(c2, w4);
        v[bitrev(4 * k + 3, 16)] = cmul(v[bitrev(4 * k + 3, 16)], c3); c3 = cmul(c3, w4);
    }
}
__device__ __forceinline__ void tw_apply_nat(cf (&v)[16], cf w1) {
    const cf w2 = cmul(w1, w1), w3 = cmul(w2, w1), w4 = cmul(w2, w2);
    cf c0 = w4, c1 = w1, c2 = w2, c3 = w3;
#pragma unroll
    for (int k = 0; k < 4; ++k) {
        if (k > 0) { v[4 * k] = cmul(v[4 * k], c0); c0 = cmul(c0, w4); }
        v[4 * k + 1] = cmul(v[4 * k + 1], c1); c1 = cmul(c1, w4);
        v[4 * k + 2] = cmul(v[4 * k + 2], c2); c2 = cmul(c2, w4);
        v[4 * k + 3] = cmul(v[4 * k + 3], c3); c3 = cmul(c3, w4);
    }
}
__device__ __forceinline__ constexpr int eoff1(int q) { return q * 1088; }
__device__ __forceinline__ void bf_geom1(int b, int& base, int& twi) { base = b + (b >> 4); twi = b; }
template <bool HALFZERO> __device__ __forceinline__ void fwd_store1(cf* Z, int base, cf w1, cf (&v)[16]) {
    if (HALFZERO) dft16_fwd_halfzero(v); else dft_reg<16, -1>(v);
    tw_apply_br(v, w1);
#pragma unroll
    for (int p = 0; p < 16; ++p) Z[base + eoff1(p)] = v[bitrev(p, 16)];
}
__device__ __forceinline__ void inv_load1(const cf* Z, int base, cf w1c, cf (&v)[16]) {
#pragma unroll
    for (int p = 0; p < 16; ++p) v[p] = Z[base + eoff1(p)];
    tw_apply_nat(v, w1c);
    dft_reg<16, 1>(v);
}
template <bool FWD> __device__ __forceinline__ void lds_passes(cf* Z, const cf* TW, int tid) {
#pragma unroll 1
    for (int ps = 0; ps < 2; ++ps) {
        int p2 = FWD ? (ps == 0) : (ps == 1); asm volatile("" : "+s"(p2));
        const int shift = p2 ? 6 : 2, bmul = p2 ? 1088 : 68, tws = p2 ? 4 : 8, es = p2 ? 68 : 4, ex = p2 ? 0 : 1;
#pragma unroll
        for (int i = 0; i < 2; ++i) {
            const int b = tid + 512 * i, blk = b >> shift, j = b & ((1 << shift) - 1);
            const int base = bmul * blk + j + (j >> 4);
            cf w = TW[j << tws];
            cf v[16];
            if (FWD) {
#pragma unroll
                for (int q = 0; q < 16; ++q) v[q] = Z[base + q * es + (q >> 2) * ex];
                dft_reg<16, -1>(v);
                tw_apply_br(v, w);
#pragma unroll
                for (int p = 0; p < 16; ++p) Z[base + p * es + (p >> 2) * ex] = v[bitrev(p, 16)];
            } else {
                w.y = -w.y;
#pragma unroll
                for (int p = 0; p < 16; ++p) v[p] = Z[base + p * es + (p >> 2) * ex];
                tw_apply_nat(v, w);
                dft_reg<16, 1>(v);
#pragma unroll
                for (int q = 0; q < 16; ++q) Z[base + q * es + (q >> 2) * ex] = v[bitrev(q, 16)];
            }
        }
        __syncthreads();
    }
}
__device__ __forceinline__ void mid_pass(cf* Z, const cf* Hs, int conv, int tid) {
#pragma unroll 1
    for (int i = 0; i < 2; ++i) {
        const int b = tid + 512 * i, base = 17 * b;
        float4 h[8];
        if (conv) {
#pragma unroll
            for (int g = 0; g < 8; ++g) h[g] = *reinterpret_cast<const float4*>(Hs + 16 * b + 2 * g);
        } else {
#pragma unroll
            for (int g = 0; g < 8; ++g) h[g] = make_float4(0.f, 0.f, 0.f, 0.f);
        }
        cf v[16];
#pragma unroll
        for (int q = 0; q < 16; ++q) v[q] = Z[base + q];
#pragma unroll
        for (int g = 0; g < 4; ++g) { cf u[4] = {v[4 * g], v[4 * g + 1], v[4 * g + 2], v[4 * g + 3]};
            dft_reg<4, -1>(u);
            if (conv) {
                const float4 h0 = h[2 * g], h1 = h[2 * g + 1];
                cf t[4];
                t[0] = cmul(u[bitrev(0, 4)], make_float2(h0.x, h0.y)); t[1] = cmul(u[bitrev(1, 4)], make_float2(h0.z, h0.w));
                t[2] = cmul(u[bitrev(2, 4)], make_float2(h1.x, h1.y)); t[3] = cmul(u[bitrev(3, 4)], make_float2(h1.z, h1.w));
                dft_reg<4, 1>(t);
#pragma unroll
                for (int q = 0; q < 4; ++q) Z[base + 4 * g + q] = t[bitrev(q, 4)];
            } else {
#pragma unroll
                for (int p2 = 0; p2 < 4; ++p2) Z[base + 4 * g + p2] = u[bitrev(p2, 4)];
            }
        }
    }
}

__device__ __forceinline__ cf conv3x2(const unsigned* row, int s, float w0, float w1, float w2, float cb) {
    const unsigned a = (s > 0) ? row[s - 1] : 0u, b = row[s], c = (s < SEQ - 1) ? row[s + 1] : 0u;
    return make_float2(cb + w0 * bf_lo(a) + w1 * bf_lo(b) + w2 * bf_lo(c), cb + w0 * bf_hi(a) + w1 * bf_hi(b) + w2 * bf_hi(c));
}

__device__ __forceinline__ void hyena_channel(int c, cf* Z, const cf* TW, const bf16_t* HYT2, const bf16_t* KT,
                                              const float* conv_w, const float* conv_b, const float* hbias,
                                              cf* Hs, cf* Z1S, bf16_t* HYOT, const int tid) {
    const float w00 = conv_w[0 * 1536 + c], w01 = conv_w[1 * 1536 + c], w02 = conv_w[2 * 1536 + c], cb0 = conv_b[c];
    const float w10 = conv_w[0 * 1536 + 512 + c], w11 = conv_w[1 * 1536 + 512 + c], w12 = conv_w[2 * 1536 + 512 + c], cb1 = conv_b[512 + c];
    const float w20 = conv_w[0 * 1536 + 1024 + c], w21 = conv_w[1 * 1536 + 1024 + c], w22 = conv_w[2 * 1536 + 1024 + c], cb2 = conv_b[1024 + c];
    const float bias0 = hbias[c], bias1 = hbias[512 + c];
    const unsigned* r0 = (const unsigned*)HYT2 + (size_t)c * SEQ; const unsigned* r1 = (const unsigned*)HYT2 + (size_t)(512 + c) * SEQ; const unsigned* r2 = (const unsigned*)HYT2 + (size_t)(1024 + c) * SEQ;
#pragma unroll 1
    for (int round = 0; round < 3; ++round) {
        int it = round; asm volatile("" : "+s"(it));
        if (it == 0) {
            const bf16_t* f0 = KT + (size_t)(0 * 1024 + 0 * 512 + c) * SEQ; const bf16_t* f1 = KT + (size_t)(0 * 1024 + 1 * 512 + c) * SEQ;
            const bf16_t* g0 = KT + (size_t)(1 * 1024 + 0 * 512 + c) * SEQ; const bf16_t* g1 = KT + (size_t)(1 * 1024 + 1 * 512 + c) * SEQ;
#pragma unroll 1
            for (int i = 0; i < 2; ++i) { const int j = tid + 512 * i; cf v[16];
#pragma unroll
                for (int q = 0; q < 8; ++q) { const int n = j + 1024 * q; v[q] = make_float2(__uint_as_float((unsigned)f0[n] << 16), __uint_as_float((unsigned)f1[n] << 16)); }
#pragma unroll
                for (int q = 8; q < 16; ++q) { const int m = L - (j + 1024 * (q - 8));
                    v[q] = (m == L) ? make_float2(0.f, 0.f) : make_float2(__uint_as_float((unsigned)g0[m & (L - 1)] << 16), __uint_as_float((unsigned)g1[m & (L - 1)] << 16)); }
                int base, twi; bf_geom1(j, base, twi);
                fwd_store1<false>(Z, base, TW[twi], v); }
        } else if (it == 1) {
#pragma unroll 1
            for (int i = 0; i < 2; ++i) { const int j = tid + 512 * i; cf v[16];
#pragma unroll
                for (int q = 0; q < 8; ++q) v[q] = conv3x2(r0, j + 1024 * q, w00, w01, w02, cb0);
                int base, twi; bf_geom1(j, base, twi);
                fwd_store1<true>(Z, base, TW[twi], v); }
        }
        __syncthreads();
        lds_passes<true>(Z, TW, tid);
        mid_pass(Z, Hs + (it == 2 ? N : 0), it > 0, tid);
        __syncthreads();
        if (it == 0) {
            const float sc = 0.5f / (float)N;
#pragma unroll 4
            for (int i = 0; i < 32; ++i) { const int pos = tid + 512 * i;
                const int k = (pos >> 10) + (((pos >> 6) & 15) << 4) + (((pos >> 2) & 15) << 8) + ((pos & 3) << 12);
                const int k2 = (N - k) & (N - 1);
                const int pos2 = ((k2 & 15) << 10) + (((k2 >> 4) & 15) << 6) + (((k2 >> 8) & 15) << 2) + (k2 >> 12);
                const cf F = Z[pos + (pos >> 4)], G = Z[pos2 + (pos2 >> 4)];
                Hs[pos] = make_float2((F.x + G.x) * sc, (F.y - G.y) * sc);
                Hs[N + pos] = make_float2((F.y + G.y) * sc, (G.x - F.x) * sc); }
            __syncthreads();
        } else {
            lds_passes<false>(Z, TW, tid);
            if (it == 1) {
#pragma unroll 1
                for (int i = 0; i < 2; ++i) { const int j = tid + 512 * i; int base, twi; bf_geom1(j, base, twi); const cf w = TW[twi];
                    cf v[16]; inv_load1(Z, base, make_float2(w.x, -w.y), v);
                    cf z[16];
#pragma unroll
                    for (int q = 0; q < 8; ++q) { const int s = j + 1024 * q; const cf y = v[bitrev(q, 16)];
                        const cf z0 = conv3x2(r0, s, w00, w01, w02, cb0), x1 = conv3x2(r1, s, w10, w11, w12, cb1);
                        z[q] = make_float2(x1.x * (y.x + z0.x * bias0), x1.y * (y.y + z0.y * bias0));
                        Z1S[s] = z[q]; }
                    fwd_store1<true>(Z, base, w, z); }
            } else {
#pragma unroll 1
                for (int i = 0; i < 2; ++i) { const int j = tid + 512 * i; int base, twi; bf_geom1(j, base, twi); const cf w = TW[twi];
                    cf v[16]; inv_load1(Z, base, make_float2(w.x, -w.y), v);
#pragma unroll
                    for (int q = 0; q < 8; ++q) { const int s = j + 1024 * q; const cf y = v[bitrev(q, 16)]; const cf z1 = Z1S[s];
                        const cf x2 = conv3x2(r2, s, w20, w21, w22, cb2);
                        HYOT[(size_t)c * T + s] = (bf16_t)(pg8::cvt_pk_bf16(x2.x * (y.x + z1.x * bias1), 0.f) & 0xffffu);
                        HYOT[(size_t)c * T + SEQ + s] = (bf16_t)(pg8::cvt_pk_bf16(x2.y * (y.y + z1.y * bias1), 0.f) & 0xffffu); } }
            }
        }
    }
    __syncthreads();
}
}

namespace hy16 {
typedef _Float16 h2 __attribute__((ext_vector_type(2)));
typedef float2 cf;
typedef unsigned short bf16_t;
constexpr int N = NFFT, L = SEQ;
constexpr int ZELEMS = 17408;
constexpr int TWROW = 18;
constexpr int HLW = 2 * 4096 + 2 * 512;
constexpr int LDS_Z = 0, LDS_H = ZELEMS * 4, LDS_T2 = LDS_H + 2 * HLW * 4, LDS_T3 = LDS_T2 + 64 * TWROW * 4, LDS_HX = LDS_T3 + 4 * TWROW * 4, LDS_END = LDS_HX + 16;
constexpr float S_IN = 1.0f / 16.0f, S_H = 1.0f / 8.0f, S_OUT = 1.0f / 128.0f;
constexpr float S_IN2 = 1.0f / 128.0f, S_OUT2 = 1.0f / 16.0f;
using hy::bf_lo; using hy::bf_hi;
__device__ __forceinline__ h2 mk(float re, float im) { h2 r; r.x = (_Float16)re; r.y = (_Float16)im; return r; }
template <bool CONJ> __device__ __forceinline__ h2 cmul(h2 a, h2 b) {
    h2 t, r;
    if (!CONJ) {
        asm("v_pk_mul_f16 %0, %1, %2 op_sel:[0,0] op_sel_hi:[0,1]" : "=v"(t) : "v"(a), "v"(b));
        asm("v_pk_fma_f16 %0, %1, %2, %3 op_sel:[1,1,0] op_sel_hi:[1,0,1] neg_lo:[1,0,0]" : "=v"(r) : "v"(a), "v"(b), "v"(t));
    } else {
        asm("v_pk_mul_f16 %0, %1, %2 op_sel:[0,0] op_sel_hi:[0,1] neg_hi:[1,0]" : "=v"(t) : "v"(a), "v"(b));
        asm("v_pk_fma_f16 %0, %1, %2, %3 op_sel:[1,1,0] op_sel_hi:[1,0,1]" : "=v"(r) : "v"(a), "v"(b), "v"(t));
    }
    return r;
}
template <int SGN> __device__ __forceinline__ h2 muli(h2 a) {
    h2 r; const h2 one = {(_Float16)1.0f, (_Float16)1.0f};
    if (SGN < 0) asm("v_pk_mul_f16 %0, %1, %2 op_sel:[1,0] op_sel_hi:[0,1] neg_hi:[1,0]" : "=v"(r) : "v"(a), "v"(one));
    else         asm("v_pk_mul_f16 %0, %1, %2 op_sel:[1,0] op_sel_hi:[0,1] neg_lo:[1,0]" : "=v"(r) : "v"(a), "v"(one));
    return r;
}
template <int SGN> __device__ __forceinline__ h2 sub_muli(h2 a, h2 b) {
    h2 r;
    if (SGN < 0) asm("v_pk_add_f16 %0, %1, %2 op_sel:[1,1] op_sel_hi:[0,0] neg_lo:[0,1] neg_hi:[1,0]" : "=v"(r) : "v"(a), "v"(b));
    else         asm("v_pk_add_f16 %0, %1, %2 op_sel:[1,1] op_sel_hi:[0,0] neg_lo:[1,0] neg_hi:[0,1]" : "=v"(r) : "v"(a), "v"(b));
    return r;
}
__device__ constexpr int BR16[16] = {0, 8, 4, 12, 2, 10, 6, 14, 1, 9, 5, 13, 3, 11, 7, 15};
__device__ constexpr int BR4[4] = {0, 2, 1, 3};
#define br16(p) BR16[(p) & 15]
#define br4(p) BR4[(p) & 3]
template <int SGN> __device__ __forceinline__ h2 twc(h2 d, int tk) {
    if (tk == 0) return d;
    if (tk == 8) return muli<SGN>(d);
    const h2 w = {(_Float16)hy::C32[tk], (_Float16)((SGN < 0) ? -hy::S32[tk] : hy::S32[tk])};
    return cmul<false>(d, w);
}
template <int R, int LEN, int SGN> struct DftStage {
    static __device__ __forceinline__ void run(h2 (&v)[R]) {
        constexpr int half = LEN / 2;
#pragma unroll
        for (int blk = 0; blk < R; blk += LEN) {
#pragma unroll
            for (int k = 0; k < half; ++k) {
                const h2 a = v[blk + k], b = v[blk + k + half];
                v[blk + k] = a + b;
                v[blk + k + half] = (k * (32 / LEN) == 8) ? sub_muli<SGN>(a, b) : twc<SGN>(a - b, k * (32 / LEN));
            }
        }
        DftStage<R, LEN / 2, SGN>::run(v);
    }
};
template <int R, int SGN> struct DftStage<R, 1, SGN> { static __device__ __forceinline__ void run(h2 (&)[R]) {} };
template <int R, int SGN> __device__ __forceinline__ void dft_reg(h2 (&v)[R]) { DftStage<R, R, SGN>::run(v); }
__device__ __forceinline__ void dft16_fwd_halfzero(h2 (&v)[16]) {
#pragma unroll
    for (int k = 0; k < 8; ++k) v[k + 8] = twc<-1>(v[k], 2 * k);
    DftStage<16, 8, -1>::run(v);
}
__device__ __forceinline__ h2 mk2(_Float16 x, _Float16 y) { h2 r = {x, y}; return r; }
__device__ __forceinline__ void tw_load(const h2* row, h2 (&w)[16]) {
#pragma unroll
    for (int i = 0; i < 8; ++i) { const uint2 u = *reinterpret_cast<const uint2*>(row + 2 * i); w[2 * i] = __builtin_bit_cast(h2, u.x); w[2 * i + 1] = __builtin_bit_cast(h2, u.y); }
}
__device__ __forceinline__ void ld2(const h2* Z, int idx, h2& a, h2& b) { const uint2 u = *reinterpret_cast<const uint2*>(Z + idx); a = __builtin_bit_cast(h2, u.x); b = __builtin_bit_cast(h2, u.y); }
__device__ __forceinline__ void st2(h2* Z, int idx, h2 a, h2 b) { uint2 u; u.x = __builtin_bit_cast(unsigned, a); u.y = __builtin_bit_cast(unsigned, b); *reinterpret_cast<uint2*>(Z + idx) = u; }
__device__ __forceinline__ constexpr int eoff1(int q) { return q * 1088; }
__device__ __forceinline__ int base1(int j) { return j + 2 * (j >> 5); }
template <bool HALFZERO> __device__ __forceinline__ void fwd_store1(h2* Z, const h2 (&wa)[16], const h2 (&wb)[16], int j, h2 (&va)[16], h2 (&vb)[16]) {
    if (HALFZERO) { dft16_fwd_halfzero(va); dft16_fwd_halfzero(vb); } else { dft_reg<16, -1>(va); dft_reg<16, -1>(vb); }
    const int base = base1(j);
    st2(Z, base, va[0], vb[0]);
#pragma unroll
    for (int p = 1; p < 16; ++p) st2(Z, base + eoff1(p), cmul<false>(va[br16(p)], wa[p - 1]), cmul<false>(vb[br16(p)], wb[p - 1]));
}
__device__ __forceinline__ void inv_load1(const h2* Z, const h2 (&wa)[16], const h2 (&wb)[16], int j, h2 (&va)[16], h2 (&vb)[16]) {
    const int base = base1(j);
    ld2(Z, base, va[0], vb[0]);
#pragma unroll
    for (int p = 1; p < 16; ++p) { h2 a, b; ld2(Z, base + eoff1(p), a, b); va[p] = cmul<true>(a, wa[p - 1]); vb[p] = cmul<true>(b, wb[p - 1]); }
    dft_reg<16, 1>(va); dft_reg<16, 1>(vb);
}
__device__ __forceinline__ void wave_lds_sync() { asm volatile("s_waitcnt lgkmcnt(0)" ::: "memory"); __builtin_amdgcn_wave_barrier(); }
template <bool FWD> __device__ __forceinline__ void lds_passes(h2* Z, const h2* T2, const h2* T3, int tid) {
#pragma unroll 1
    for (int ps = 0; ps < 2; ++ps) {
        int p2 = FWD ? (ps == 0) : (ps == 1); asm volatile("" : "+s"(p2));
        const int shift = p2 ? 6 : 2, bmul = p2 ? 1088 : 68, es = p2 ? 68 : 4, ex = p2 ? 0 : 2;
        const h2* TT = p2 ? T2 : T3;
        const int b = 2 * tid, blk = b >> shift, j = b & ((1 << shift) - 1);
        const int base = bmul * blk + j + 2 * (j >> 5);
        h2 wa[16], wb[16]; tw_load(TT + j * TWROW, wa); tw_load(TT + (j + 1) * TWROW, wb);
        h2 va[16], vb[16];
        if (FWD) {
#pragma unroll
            for (int q = 0; q < 16; ++q) ld2(Z, base + q * es + (q >> 3) * ex, va[q], vb[q]);
            dft_reg<16, -1>(va); dft_reg<16, -1>(vb);
            st2(Z, base, va[0], vb[0]);
#pragma unroll
            for (int p = 1; p < 16; ++p) st2(Z, base + p * es + (p >> 3) * ex, cmul<false>(va[br16(p)], wa[p - 1]), cmul<false>(vb[br16(p)], wb[p - 1]));
        } else {
            ld2(Z, base, va[0], vb[0]);
#pragma unroll
            for (int p = 1; p < 16; ++p) { h2 a, c; ld2(Z, base + p * es + (p >> 3) * ex, a, c); va[p] = cmul<true>(a, wa[p - 1]); vb[p] = cmul<true>(c, wb[p - 1]); }
            dft_reg<16, 1>(va); dft_reg<16, 1>(vb);
#pragma unroll
            for (int q = 0; q < 16; ++q) st2(Z, base + q * es + (q >> 3) * ex, va[br16(q)], vb[br16(q)]);
        }
        wave_lds_sync();
    }
}
__device__ __forceinline__ void mid_pass(h2* Z, const h2* HL, const h2* HX, int conv, int tid) {
    const int lo8 = (tid >> 5) + 16 * ((tid >> 1) & 15), r8 = (256 - lo8) & 255;
    const int M2 = ((r8 & 15) << 8) + ((r8 >> 4) << 4) + (lo8 ? 15 : 16) - 8 * (tid & 1);
#pragma unroll 1
    for (int i = 0; i < 2; ++i) {
        const int base = 34 * tid + 16 * i;
        h2 hd[8], hm[8];
        if (conv) {
#pragma unroll
            for (int g = 0; g < 4; ++g) { const int c = 4 * i + g, m2 = M2 - c;
                ld2(HL, 18 * tid + 2 * c, hd[2 * g], hd[2 * g + 1]);
                ld2(HL, 2 * m2 + 2 * (m2 >> 3), hm[2 * g], hm[2 * g + 1]); }
            if (tid + i == 0) { const h2 x = HX[0]; hm[1] = mk2(x.x, -x.y); hm[0] = hd[1]; }
        } else {
#pragma unroll
            for (int g = 0; g < 8; ++g) { hd[g] = mk(0.f, 0.f); hm[g] = mk(0.f, 0.f); }
        }
        h2 v[16];
#pragma unroll
        for (int q = 0; q < 16; q += 2) ld2(Z, base + q, v[q], v[q + 1]);
#pragma unroll
        for (int g = 0; g < 4; ++g) { h2 u[4] = {v[4 * g], v[4 * g + 1], v[4 * g + 2], v[4 * g + 3]};
            dft_reg<4, -1>(u);
            if (conv) {
                h2 t[4];
                t[0] = cmul<false>(u[br4(0)], hd[2 * g]); t[1] = cmul<false>(u[br4(1)], hd[2 * g + 1]);
                t[2] = cmul<true>(u[br4(2)], hm[2 * g + 1]); t[3] = cmul<true>(u[br4(3)], hm[2 * g]);
                dft_reg<4, 1>(t);
                st2(Z, base + 4 * g, t[br4(0)], t[br4(1)]); st2(Z, base + 4 * g + 2, t[br4(2)], t[br4(3)]);
            } else {
                st2(Z, base + 4 * g, u[br4(0)], u[br4(1)]); st2(Z, base + 4 * g + 2, u[br4(2)], u[br4(3)]);
            }
        }
    }
}
__device__ __forceinline__ void build_tables(h2* T2, h2* T3, const cf* TWg, int tid) {
    for (int i = tid; i < 64 * 16; i += 512) { const int j = i >> 4, p = (i & 15) + 1; const cf w = TWg[(16 * j * p) & (N - 1)]; T2[j * TWROW + p - 1] = mk(w.x, w.y); }
    if (tid < 64) { const int j = tid >> 4, p = (tid & 15) + 1; const cf w = TWg[(256 * j * p) & (N - 1)]; T3[j * TWROW + p - 1] = mk(w.x, w.y); }
}
__device__ __forceinline__ void load_tw1(const cf* TWg, int tid, h2 (&wa)[16], h2 (&wb)[16]) {
#pragma unroll
    for (int k = 0; k < 15; ++k) { const cf a = TWg[(2 * tid * (k + 1)) & (N - 1)], b = TWg[((2 * tid + 1) * (k + 1)) & (N - 1)]; wa[k] = mk(a.x, a.y); wb[k] = mk(b.x, b.y); }
    wa[15] = mk(0.f, 0.f); wb[15] = mk(0.f, 0.f);
}

__device__ __forceinline__ void taps_load(const unsigned* row, int s, unsigned (&t)[4]) {
    t[0] = (s > 0) ? row[s - 1] : 0u; const uint2 bc = *reinterpret_cast<const uint2*>(row + s); t[1] = bc.x; t[2] = bc.y; t[3] = (s + 2 < SEQ) ? row[s + 2] : 0u;
}
__device__ __forceinline__ void taps_conv(const unsigned (&t)[4], float w0, float w1, float w2, float cb, cf& z0, cf& z1) {
    z0 = make_float2(cb + w0 * bf_lo(t[0]) + w1 * bf_lo(t[1]) + w2 * bf_lo(t[2]), cb + w0 * bf_hi(t[0]) + w1 * bf_hi(t[1]) + w2 * bf_hi(t[2]));
    z1 = make_float2(cb + w0 * bf_lo(t[1]) + w1 * bf_lo(t[2]) + w2 * bf_lo(t[3]), cb + w0 * bf_hi(t[1]) + w1 * bf_hi(t[2]) + w2 * bf_hi(t[3]));
}
__device__ __forceinline__ void conv3x2_pair(const unsigned* row, int s, float w0, float w1, float w2, float cb, cf& z0, cf& z1) {
    const unsigned a = (s > 0) ? row[s - 1] : 0u; const uint2 bc = *reinterpret_cast<const uint2*>(row + s); const unsigned d = (s + 2 < SEQ) ? row[s + 2] : 0u;
    z0 = make_float2(cb + w0 * bf_lo(a) + w1 * bf_lo(bc.x) + w2 * bf_lo(bc.y), cb + w0 * bf_hi(a) + w1 * bf_hi(bc.x) + w2 * bf_hi(bc.y));
    z1 = make_float2(cb + w0 * bf_lo(bc.x) + w1 * bf_lo(bc.y) + w2 * bf_lo(d), cb + w0 * bf_hi(bc.x) + w1 * bf_hi(bc.y) + w2 * bf_hi(d));
}
__device__ __forceinline__ void hyena_channel(int c, unsigned char* lds, const bf16_t* HYT2, const bf16_t* KT,
                                              const float* conv_w, const float* conv_b, const float* hbias,
                                              const h2 (&w1a)[16], const h2 (&w1b)[16], bf16_t* HYOT, const int tid) {
    h2* Z = (h2*)(lds + LDS_Z); h2* HL = (h2*)(lds + LDS_H); h2* HX = (h2*)(lds + LDS_HX); const h2* T2 = (const h2*)(lds + LDS_T2); const h2* T3 = (const h2*)(lds + LDS_T3);
    const float w00 = conv_w[0 * 1536 + c], w01 = conv_w[1 * 1536 + c], w02 = conv_w[2 * 1536 + c], cb0 = conv_b[c];
    const float w10 = conv_w[0 * 1536 + 512 + c], w11 = conv_w[1 * 1536 + 512 + c], w12 = conv_w[2 * 1536 + 512 + c], cb1 = conv_b[512 + c];
    const float w20 = conv_w[0 * 1536 + 1024 + c], w21 = conv_w[1 * 1536 + 1024 + c], w22 = conv_w[2 * 1536 + 1024 + c], cb2 = conv_b[1024 + c];
    const float bias0 = hbias[c], bias1 = hbias[512 + c];
    const unsigned* r0 = (const unsigned*)HYT2 + (size_t)c * SEQ; const unsigned* r1 = (const unsigned*)HYT2 + (size_t)(512 + c) * SEQ; const unsigned* r2 = (const unsigned*)HYT2 + (size_t)(1024 + c) * SEQ;
    h2 z1a[8], z1b[8];
#pragma unroll
    for (int q = 0; q < 8; ++q) { z1a[q] = mk(0.f, 0.f); z1b[q] = mk(0.f, 0.f); }
#ifndef REP_R0
#define REP_R0 0
#endif
#ifndef REP_SPLIT
#define REP_SPLIT 1
#endif
#pragma unroll 1
    for (int round = -REP_R0; round < 3; ++round) {
        int it = round < 0 ? 0 : round; asm volatile("" : "+s"(it));
        int j = 2 * tid; asm volatile("" : "+v"(j));
        if (it == 0) {
            const unsigned* fp = (const unsigned*)KT + (size_t)c * SEQ; const unsigned* gp = (const unsigned*)KT + (size_t)(512 + c) * SEQ;
            h2 va[16], vb[16];
#pragma unroll
            for (int q = 0; q < 8; ++q) { const uint2 w = *reinterpret_cast<const uint2*>(fp + j + 1024 * q); va[q] = mk(bf_lo(w.x), bf_hi(w.x)); vb[q] = mk(bf_lo(w.y), bf_hi(w.y)); }
#pragma unroll
            for (int q = 8; q < 16; ++q) { const int m = L - (j + 1024 * (q - 8));
                const unsigned wa_ = gp[m & (L - 1)], wb_ = gp[m - 1];
                va[q] = (m == L) ? mk(0.f, 0.f) : mk(bf_lo(wa_), bf_hi(wa_)); vb[q] = mk(bf_lo(wb_), bf_hi(wb_)); }
            fwd_store1<false>(Z, w1a, w1b, j, va, vb);
        }
        __syncthreads();
        lds_passes<true>(Z, T2, T3, tid);
        mid_pass(Z, HL + (it == 2 ? HLW : 0), HX + (it == 2 ? 1 : 0), it > 0, tid);
        if (it == 0) {
            unsigned pz[8][4];
#pragma unroll
            for (int q = 0; q < 8; ++q) taps_load(r0, j + 1024 * q, pz[q]);
            __syncthreads();
            const h2 scv = mk(0.5f * S_H, 0.5f * S_H);
            for (int rs = 0; rs < REP_SPLIT; ++rs) {
#pragma unroll 2
            for (int i = 0; i < 8; ++i) { const int m = tid + 512 * i;
                if (m != 0) {
                    const int klow = (m >> 8) + (((m >> 4) & 15) << 4) + ((m & 15) << 8);
                    const int k2 = 4096 - klow;
                    const int m2 = ((k2 & 15) << 8) + (((k2 >> 4) & 15) << 4) + (k2 >> 8);
                    h2 F0, F1, Ga, Gb; ld2(Z, 4 * m + 2 * (m >> 3), F0, F1); ld2(Z, 4 * m2 + 2 + 2 * (m2 >> 3), Ga, Gb);
                    const h2 cb = mk2(Gb.x, -Gb.y), ca = mk2(Ga.x, -Ga.y);
                    const h2 h00 = (F0 + cb) * scv, h01 = (F1 + ca) * scv;
                    const h2 d0 = F0 - cb, d1 = F1 - ca;
                    const h2 h10 = mk2(d0.y, -d0.x) * scv, h11 = mk2(d1.y, -d1.x) * scv;
                    st2(HL, 2 * m + 2 * (m >> 3), h00, h01); st2(HL, HLW + 2 * m + 2 * (m >> 3), h10, h11);
                }
            }
            if (tid == 0) {
                const h2 F0 = Z[0], F1 = Z[1], F2 = Z[2], F3 = Z[3];
                const h2 c0 = mk2(F0.x, -F0.y), c3 = mk2(F3.x, -F3.y), c2 = mk2(F2.x, -F2.y);
                const h2 e0 = F0 - c0, e1 = F1 - c3, e2 = F2 - c2;
                st2(HL, 0, (F0 + c0) * scv, (F1 + c3) * scv); st2(HL, HLW, mk2(e0.y, -e0.x) * scv, mk2(e1.y, -e1.x) * scv);
                HX[0] = (F2 + c2) * scv; HX[1] = mk2(e2.y, -e2.x) * scv;
            }
            }
            __syncthreads();
            {
                h2 va[16], vb[16];
#pragma unroll
                for (int q = 0; q < 8; ++q) { cf za, zb; taps_conv(pz[q], w00, w01, w02, cb0, za, zb); va[q] = mk(za.x * S_IN, za.y * S_IN); vb[q] = mk(zb.x * S_IN, zb.y * S_IN);
                    z1a[q] = mk(za.x, za.y); z1b[q] = mk(zb.x, zb.y); }
                fwd_store1<true>(Z, w1a, w1b, j, va, vb);
            }
        } else {
            unsigned pa[8][4];
            const unsigned* ra = (it == 1) ? r1 : r2;
#pragma unroll
            for (int q = 0; q < 8; ++q) taps_load(ra, j + 1024 * q, pa[q]);
            wave_lds_sync();
            lds_passes<false>(Z, T2, T3, tid);
            __syncthreads();
            h2 va[16], vb[16]; inv_load1(Z, w1a, w1b, j, va, vb);
            if (it == 1) {
                h2 za[16], zb[16];
#pragma unroll
                for (int q = 0; q < 8; ++q) { const int s = j + 1024 * q; const h2 ya = va[br16(q)], yb = vb[br16(q)];
                    cf x1a, x1b; taps_conv(pa[q], w10, w11, w12, cb1, x1a, x1b);
                    const cf z0a = make_float2((float)z1a[q].x, (float)z1a[q].y), z0b = make_float2((float)z1b[q].x, (float)z1b[q].y);
                    const cf oa = make_float2(x1a.x * ((float)ya.x * S_OUT + z0a.x * bias0), x1a.y * ((float)ya.y * S_OUT + z0a.y * bias0));
                    const cf ob = make_float2(x1b.x * ((float)yb.x * S_OUT + z0b.x * bias0), x1b.y * ((float)yb.y * S_OUT + z0b.y * bias0));
                    z1a[q] = mk(oa.x, oa.y); z1b[q] = mk(ob.x, ob.y);
                    za[q] = mk(oa.x * S_IN2, oa.y * S_IN2); zb[q] = mk(ob.x * S_IN2, ob.y * S_IN2); }
                fwd_store1<true>(Z, w1a, w1b, j, za, zb);
            } else {
#pragma unroll
                for (int q = 0; q < 8; ++q) { const int s = j + 1024 * q; const h2 ya = va[br16(q)], yb = vb[br16(q)];
                    const float z1x = (float)z1a[q].x, z1y = (float)z1a[q].y, z1z = (float)z1b[q].x, z1w = (float)z1b[q].y;
                    cf x2a, x2b; taps_conv(pa[q], w20, w21, w22, cb2, x2a, x2b);
                    const float oa0 = x2a.x * ((float)ya.x * S_OUT2 + z1x * bias1), oa1 = x2a.y * ((float)ya.y * S_OUT2 + z1y * bias1);
                    const float ob0 = x2b.x * ((float)yb.x * S_OUT2 + z1z * bias1), ob1 = x2b.y * ((float)yb.y * S_OUT2 + z1w * bias1);
                    *reinterpret_cast<unsigned*>(HYOT + (unsigned)(((s >> 6) * 512 + c) * 64 + (s & 63))) = pg8::cvt_pk_bf16(oa0, ob0);
                    *reinterpret_cast<unsigned*>(HYOT + (unsigned)((((SEQ + s) >> 6) * 512 + c) * 64 + (s & 63))) = pg8::cvt_pk_bf16(oa1, ob1); }
            }
        }
    }
    __syncthreads();
}
#undef br16
#undef br4
}

#define GAS __attribute__((address_space(1)))
#define LAS __attribute__((address_space(3)))
typedef unsigned short bf16;
typedef unsigned v4u __attribute__((ext_vector_type(4)));
typedef unsigned v2u __attribute__((ext_vector_type(2)));
typedef float f32x4 __attribute__((ext_vector_type(4)));
constexpr int NWAVES = 8, NTHR = 512;
constexpr size_t MiB = 1u << 20;
constexpr size_t WS_MOD = 0  , WS_MODP = 256 * 1024  ;
constexpr size_t WS_SSQQ = 2 * MiB + 256 * 1024, WS_SSQKV = 2 * MiB + 512 * 1024;
constexpr size_t WS_BAR = 128 * 1024;
constexpr size_t WS_TW = 2 * MiB;
constexpr size_t WS_CS = 3 * MiB;
constexpr size_t WS_WTIN = 5 * MiB;
constexpr size_t WS_WTO = 9 * MiB;
constexpr size_t WS_WTQB = 11 * MiB;
constexpr size_t WS_WTKVB = 11 * MiB + 512 * 1024;
constexpr size_t WS_WT3 = 12 * MiB;
constexpr size_t WS_H2 = 13 * MiB;
constexpr size_t WS_AFF = 15 * MiB;
constexpr size_t WS_IDX = 16 * MiB;
constexpr size_t WS_GATE = 16 * MiB + 128 * 1024;
constexpr size_t WS_STATS = 16 * MiB + 256 * 1024;
constexpr size_t WS_INV = 17 * MiB;
constexpr size_t WS_U1 = 18 * MiB;
constexpr size_t WS_HYOT = 18 * MiB;
constexpr size_t WS_AATT = 34 * MiB;
constexpr size_t WS_MIXED = 18 * MiB;
constexpr size_t WS_HYT = 50 * MiB;
constexpr size_t WS_APRIME = 50 * MiB;
constexpr size_t WS_XE = 50 * MiB;
constexpr size_t WS_YE = 210 * MiB;
constexpr size_t WS_KT = 98 * MiB;
constexpr size_t WS_CQ = 130 * MiB;
constexpr size_t WS_CKV = 138 * MiB;
constexpr size_t WS_KRR = 142 * MiB;
constexpr size_t WS_KR = 144 * MiB;
constexpr size_t WS_FFTS = 146 * MiB;
constexpr size_t FFTS_PER_WG = 320 * 1024;
constexpr size_t WS_WTGU = 114 * MiB;
constexpr size_t WS_WTD = 178 * MiB;
constexpr size_t WS_U2 = 210 * MiB;
constexpr size_t WS_HB = 50 * MiB;
constexpr size_t WS_Q = 226 * MiB;
constexpr size_t WS_KV = 250 * MiB;
constexpr size_t WS_X1 = WS_MIXED;
constexpr size_t WS_END = 282 * MiB;
constexpr int LDS_BYTES = 148 * 1024;

struct Params {
    const float* x; const float* c; const int* positions; const float* w_ada; const float* b_ada; const float* w_in; const float* q_norm_g; const float* w_qb;
    const float* kv_norm_g; const float* w_kvb; const float* conv_w; const float* conv_b; const float* filt_w1; const float* filt_b1; const float* filt_freq;
    const float* filt_w2; const float* filt_b2; const float* filt_w3; const float* filt_b3; const float* hyena_decay; const float* hyena_bias;
    const float* attn_out_g; const float* hyena_out_g; const float* w_o; const float* ln1_g; const float* ln1_b; const float* w_router;
    const float* w_gate; const float* w_up; const float* w_down; const float* ln2_g; const float* ln2_b;
    float* out; unsigned char* ws;
};

__device__ __forceinline__ unsigned f2bf(float f) { unsigned u = __builtin_bit_cast(unsigned, f); return (u + 0x7fffu + ((u >> 16) & 1u)) >> 16; }
__device__ __forceinline__ unsigned pk2(float lo, float hi) { return pg8::cvt_pk_bf16(lo, hi); }
__device__ __forceinline__ float bf_lo(unsigned w) { return __uint_as_float(w << 16); }
__device__ __forceinline__ float bf_hi(unsigned w) { return __uint_as_float(w & 0xffff0000u); }
__device__ __forceinline__ float wave_sum(float v) {
#pragma unroll
    for (int o = 1; o < 64; o <<= 1) v += __shfl_xor(v, o);
    return v;
}
struct Ctx { int tid, lane, wave, vcu, G, gw, NGW; unsigned char* lds; };

__device__ __forceinline__ void transpose_item(const float* __restrict__ W, int ldw, int N, bf16* WT, int ldk, int nmul, int nadd, const float* __restrict__ kscale, float* scr, int item, int lane) {
    const int nblk = N / 32, kb = item / nblk, nb = item % nblk, k0 = 64 * kb, n0 = 32 * nb;
#pragma unroll 8
    for (int i = 0; i < 32; ++i) { const int kk = 2 * i + (lane >> 5); float v = W[(size_t)(k0 + kk) * ldw + n0 + (lane & 31)]; if (kscale) v *= kscale[k0 + kk]; scr[kk * 33 + (lane & 31)] = v; }
    asm volatile("s_waitcnt lgkmcnt(0)" ::: "memory");
    const int c = lane & 7;
#pragma unroll
    for (int j = 0; j < 4; ++j) { const int n = (lane >> 3) + 8 * j; const float* s = scr + (8 * c) * 33 + n;
        v4u o; o.x = pk2(s[0 * 33], s[1 * 33]); o.y = pk2(s[2 * 33], s[3 * 33]); o.z = pk2(s[4 * 33], s[5 * 33]); o.w = pk2(s[6 * 33], s[7 * 33]);
        *(v4u*)(WT + (size_t)((n0 + n) * nmul + nadd) * ldk + k0 + 8 * c) = o; }
    asm volatile("s_waitcnt lgkmcnt(0)" ::: "memory");
}

__device__ __forceinline__ void phase0(const Params& P, const Ctx& X) {
    unsigned char* ws = P.ws;
    const int gt = X.vcu * NTHR + X.tid, NGT = X.G * NTHR;
    for (int k = gt; k < NFFT; k += NGT) { float s, c; sincospif(2.0f * (float)k / (float)NFFT, &s, &c); ((float2*)(ws + WS_TW))[k] = make_float2(c, -s); }
    { double* invf = (double*)(X.lds + 131072);
      if (X.tid < 16) invf[X.tid] = pow(10000.0, -(double)X.tid / 16.0);
      __syncthreads();
      for (int i = gt; i < T * 16; i += NGT) { const int t = i >> 4, f = i & 15; const double ang = (double)P.positions[t] * invf[f];
          const double k = rint(ang * 0.15915494309189535); const float r = (float)(ang - k * 6.283185307179586476925);
          float sn, cs; sincosf(r, &sn, &cs); ((float2*)(ws + WS_CS))[i] = make_float2(cs, sn); } }
    for (int i = gt; i < 96 * 1024 / 8; i += NGT) ((v4u*)(ws + WS_WTIN + (size_t)IN_COLS * 1024 * 2))[i] = (v4u){0u, 0u, 0u, 0u};
    for (int i = gt; i < 2048 * 8; i += NGT) { const int r = i >> 3, cc = i & 7; ((v4u*)(ws + WS_WT3 + (size_t)r * 256 + 128))[cc] = (v4u){0u, 0u, 0u, 0u}; }
    for (int i = gt; i < 8192 * 8; i += NGT) { const int r = i >> 3, cc = i & 7; ((v4u*)(ws + WS_H2 + (size_t)r * 256 + 128))[cc] = (v4u){0u, 0u, 0u, 0u}; }
    float* scr = (float*)(X.lds + X.wave * 16384);
    {
        constexpr int I_IN = (1024 / 64) * (IN_COLS / 32), I_O = 16 * 32, I_QB = (256 / 64) * (768 / 32), I_KVB = (128 / 64) * (1024 / 32), I_3 = 1 * (2048 / 32);
        constexpr int NIT = I_IN + I_O + I_QB + I_KVB + I_3;
        for (int it = X.gw; it < NIT; it += X.NGW) {
            int r = it;
            if (r < I_IN) { transpose_item(P.w_in, IN_COLS, IN_COLS, (bf16*)(ws + WS_WTIN), 1024, 1, 0, nullptr, scr, r, X.lane); continue; } r -= I_IN;
            if (r < I_O) { transpose_item(P.w_o, 1024, 1024, (bf16*)(ws + WS_WTO), 1024, 1, 0, nullptr, scr, r, X.lane); continue; } r -= I_O;
            if (r < I_QB) { transpose_item(P.w_qb, 768, 768, (bf16*)(ws + WS_WTQB), 256, 1, 0, P.q_norm_g, scr, r, X.lane); continue; } r -= I_QB;
            if (r < I_KVB) { transpose_item(P.w_kvb, 1024, 1024, (bf16*)(ws + WS_WTKVB), 128, 1, 0, P.kv_norm_g, scr, r, X.lane); continue; } r -= I_KVB;
            { const int n0 = 32 * r, dir = n0 >> 10, o = (n0 >> 9) & 1;
              transpose_item(P.filt_w3, 2048, 2048, (bf16*)(ws + WS_WT3), 128, 2, o - (dir + o) * 1024, nullptr, scr, r, X.lane); }
        }
    }
    for (int l = X.gw; l < SEQ; l += X.NGW) {
        const int j = X.lane;
        float feat;
        { const float pos = (float)l; const int i = j;
          if (i == 0) feat = pos / (float)(SEQ - 1);
          else if (i <= 32) { const int kk = (i - 1) & 15; const float fk = 1e-4f + (float)kk * ((15.0f - 1e-4f) / 15.0f);
              const float ph = (6.283185307179586f / (float)SEQ) * pos * fk; feat = (i <= 16) ? cosf(ph) : -sinf(ph); }
          else feat = 0.f; }
        float a = P.filt_b1[j];
#pragma unroll
        for (int i = 0; i < FEMB; ++i) a += __uint_as_float(__builtin_amdgcn_readlane(__float_as_uint(feat), i)) * P.filt_w1[i * 64 + j];
        const float fr = P.filt_freq[j];
        const float h1 = sinf(fr * a);
        float b2 = P.filt_b2[j];
#pragma unroll
        for (int i = 0; i < 64; ++i) b2 += __uint_as_float(__builtin_amdgcn_readlane(__float_as_uint(h1), i)) * P.filt_w2[i * 64 + j];
        const float h2 = sinf(fr * b2);
        ((bf16*)(ws + WS_H2))[(size_t)l * 128 + j] = (bf16)f2bf(h2);
    }
    for (int it = X.gw; it < 32 * 24; it += X.NGW) {
        const int kc = it / 24, nc = it % 24, n = nc * 256 + X.lane * 4;
        f32x4 a0 = {0.f, 0.f, 0.f, 0.f}, a1 = {0.f, 0.f, 0.f, 0.f};
#pragma unroll 8
        for (int kk = 0; kk < 32; ++kk) { const int k = kc * 32 + kk; const f32x4 w = *(const f32x4*)(P.w_ada + (size_t)k * 6144 + n);
            const float c0 = P.c[k], c1 = P.c[1024 + k]; const float s0 = c0 / (1.f + __expf(-c0)), s1 = c1 / (1.f + __expf(-c1));
            a0 += w * s0; a1 += w * s1; }
        float* mp = (float*)(ws + WS_MODP);
        *(f32x4*)(mp + ((size_t)kc * 2 + 0) * 6144 + n) = a0; *(f32x4*)(mp + ((size_t)kc * 2 + 1) * 6144 + n) = a1;
    }
}

__device__ __forceinline__ void phase1(const Params& P, const Ctx& X) {
    unsigned char* ws = P.ws;
    float* modl = (float*)X.lds;
    const float* mp = (const float*)(ws + WS_MODP);
    f32x4 xv[8][4];
#pragma unroll
    for (int r = 0; r < 8; ++r) { const int m = X.gw + r * X.NGW;
        if (m < T) { const f32x4* xr = (const f32x4*)(P.x + (size_t)m * DM) + X.lane;
#pragma unroll
            for (int j = 0; j < 4; ++j) xv[r][j] = xr[64 * j]; } }
    for (int i = X.tid; i < 4096; i += NTHR) { const int b = i >> 11, n = i & 2047;
        float part[32];
#pragma unroll
        for (int kc = 0; kc < 32; ++kc) part[kc] = mp[((size_t)kc * 2 + b) * 6144 + n];
        float s = P.b_ada[n];
#pragma unroll
        for (int kc = 0; kc < 32; ++kc) s += part[kc];
        modl[i] = s; }
    for (int i0 = X.vcu * 48; i0 < 2 * 6144; i0 += X.G * 48) { const int i = i0 + X.tid;
      if (X.tid < 48 && i < 2 * 6144) { const int b = i / 6144, n = i % 6144;
        float part[32];
#pragma unroll
        for (int kc = 0; kc < 32; ++kc) part[kc] = mp[((size_t)kc * 2 + b) * 6144 + n];
        float s2 = P.b_ada[n];
#pragma unroll
        for (int kc = 0; kc < 32; ++kc) s2 += part[kc];
        ((float*)(ws + WS_MOD))[i] = s2; } }
    __syncthreads();
#pragma unroll
    for (int r = 0; r < 8; ++r) { const int m = X.gw + r * X.NGW;
        if (m < T) { const int b = m / SEQ; const float* sh = modl + b * 2048; const float* sc = sh + 1024;
            unsigned long long* o8 = (unsigned long long*)(ws + WS_U1 + (size_t)(2 * (m % SEQ) + b) * DM * 2) + X.lane;
#pragma unroll
            for (int j = 0; j < 4; ++j) { const f32x4 v = xv[r][j]; const int c0 = 4 * X.lane + 256 * j;
                const float u0 = v.x * (1.f + sc[c0]) + sh[c0], u1 = v.y * (1.f + sc[c0 + 1]) + sh[c0 + 1], u2 = v.z * (1.f + sc[c0 + 2]) + sh[c0 + 2], u3 = v.w * (1.f + sc[c0 + 3]) + sh[c0 + 3];
                o8[64 * j] = (unsigned long long)pk2(u0, u1) | ((unsigned long long)pk2(u2, u3) << 32); } } }
#pragma unroll 4
    for (int m = X.gw + 8 * X.NGW; m < T; m += X.NGW) {
        const int b = m / SEQ; const float* sh = modl + b * 2048; const float* sc = sh + 1024;
        const f32x4* xr = (const f32x4*)(P.x + (size_t)m * DM) + X.lane;
        unsigned long long* o8 = (unsigned long long*)(ws + WS_U1 + (size_t)(2 * (m % SEQ) + b) * DM * 2) + X.lane;
#pragma unroll
        for (int j = 0; j < 4; ++j) { const f32x4 v = xr[64 * j]; const int c0 = 4 * X.lane + 256 * j;
            const float u0 = v.x * (1.f + sc[c0]) + sh[c0], u1 = v.y * (1.f + sc[c0 + 1]) + sh[c0 + 1], u2 = v.z * (1.f + sc[c0 + 2]) + sh[c0 + 2], u3 = v.w * (1.f + sc[c0 + 3]) + sh[c0 + 3];
            o8[64 * j] = (unsigned long long)pk2(u0, u1) | ((unsigned long long)pk2(u2, u3) << 32); }
    }
    __syncthreads();
}

__device__ __forceinline__ void krope_pass(const Params& P, const Ctx& X) {
    unsigned char* ws = P.ws;
    const int gt = X.vcu * NTHR + X.tid, NGT = X.G * NTHR;
    const float* krr = (const float*)(ws + WS_KRR); const float2* cs = (const float2*)(ws + WS_CS); bf16* kr = (bf16*)(ws + WS_KR);
    for (int i = gt; i < T * 16; i += NGT) { const int t = i >> 4, f = i & 15;
        const float x1 = krr[t * 32 + f], x2 = krr[t * 32 + 16 + f]; const float2 c = cs[i];
        kr[t * 32 + f] = (bf16)f2bf(x1 * c.x - x2 * c.y); kr[t * 32 + 16 + f] = (bf16)f2bf(x2 * c.x + x1 * c.y); }
}

__device__ __forceinline__ void phase5(const Params& P, const Ctx& X) {
    unsigned char* ws = P.ws;
    const bf16* hyot = (const bf16*)(ws + WS_HYOT); const bf16* aatt = (const bf16*)(ws + WS_AATT); bf16* ap = (bf16*)(ws + WS_APRIME);
    float* red = (float*)X.lds;
    for (int tile = X.vcu; tile < T / 64; tile += X.G) {
        const int t0 = tile * 64;
        { const int tl = X.tid & 63, cgp = X.tid >> 6; float v[64]; float ss = 0.f;
          unsigned char* raw = X.lds + 71680;
          { const int oct = X.tid & 7, c0 = X.tid >> 3; v4u tmp[8];
#pragma unroll
            for (int i = 0; i < 8; ++i) tmp[i] = *(const v4u*)(hyot + ((size_t)tile * 512 + c0 + 64 * i) * 64 + oct * 8);
#pragma unroll
            for (int i = 0; i < 8; ++i) *(v4u*)(raw + (c0 + 64 * i) * 144 + oct * 16) = tmp[i]; }
          __syncthreads();
#pragma unroll
          for (int i = 0; i < 64; ++i) { v[i] = __uint_as_float(((unsigned)*(const unsigned short*)(raw + (cgp * 64 + i) * 144 + tl * 2)) << 16); ss += v[i] * v[i]; }
          red[cgp * 64 + tl] = ss;
          __syncthreads();
          float tot = 0.f;
#pragma unroll
          for (int g = 0; g < 8; ++g) tot += red[g * 64 + tl];
          const float rs = __builtin_amdgcn_rsqf(tot * (1.0f / 512.0f) + EPS);
          const float* gg = P.hyena_out_g + cgp * 64;
          unsigned char* stg = X.lds + 4096;
          v4u* dst = (v4u*)(stg + (size_t)tl * 1040 + cgp * 128);
#pragma unroll
          for (int i = 0; i < 8; ++i) { v4u o; o.x = pk2(v[8 * i] * rs * gg[8 * i], v[8 * i + 1] * rs * gg[8 * i + 1]); o.y = pk2(v[8 * i + 2] * rs * gg[8 * i + 2], v[8 * i + 3] * rs * gg[8 * i + 3]);
              o.z = pk2(v[8 * i + 4] * rs * gg[8 * i + 4], v[8 * i + 5] * rs * gg[8 * i + 5]); o.w = pk2(v[8 * i + 6] * rs * gg[8 * i + 6], v[8 * i + 7] * rs * gg[8 * i + 7]); dst[i] = o; }
          __syncthreads();
#pragma unroll
          for (int k = 0; k < 8; ++k) { const int r = X.wave + 8 * k; const v4u o = *(const v4u*)(stg + (size_t)r * 1040 + X.lane * 16);
              *(v4u*)(ap + (size_t)(t0 + r) * DM + 512 + X.lane * 8) = o; }
          __syncthreads(); }
        { v4u w[8]; float ss[8];
#pragma unroll
          for (int k = 0; k < 8; ++k) w[k] = *(const v4u*)(aatt + (size_t)(t0 + X.wave + 8 * k) * 512 + X.lane * 8);
#pragma unroll
          for (int k = 0; k < 8; ++k) { const float f0 = bf_lo(w[k].x), f1 = bf_hi(w[k].x), f2 = bf_lo(w[k].y), f3 = bf_hi(w[k].y), f4 = bf_lo(w[k].z), f5 = bf_hi(w[k].z), f6 = bf_lo(w[k].w), f7 = bf_hi(w[k].w);
              ss[k] = ((f0 * f0 + f1 * f1) + (f2 * f2 + f3 * f3)) + ((f4 * f4 + f5 * f5) + (f6 * f6 + f7 * f7)); }
#pragma unroll
          for (int o = 1; o < 64; o <<= 1) {
#pragma unroll
              for (int k = 0; k < 8; ++k) ss[k] += __shfl_xor(ss[k], o); }
          const float* gg = P.attn_out_g + X.lane * 8;
          const f32x4 g0 = *(const f32x4*)gg, g1 = *(const f32x4*)(gg + 4);
#pragma unroll
          for (int k = 0; k < 8; ++k) { const float rs = __builtin_amdgcn_rsqf(ss[k] * (1.0f / 512.0f) + EPS);
              v4u o; o.x = pk2(bf_lo(w[k].x) * rs * g0.x, bf_hi(w[k].x) * rs * g0.y); o.y = pk2(bf_lo(w[k].y) * rs * g0.z, bf_hi(w[k].y) * rs * g0.w);
              o.z = pk2(bf_lo(w[k].z) * rs * g1.x, bf_hi(w[k].z) * rs * g1.y); o.w = pk2(bf_lo(w[k].w) * rs * g1.z, bf_hi(w[k].w) * rs * g1.w);
              *(v4u*)(ap + (size_t)(t0 + X.wave + 8 * k) * DM + X.lane * 8) = o; } }
    }
}

struct Y1Raw { f32x4 x[4]; v2u m[4]; };
__device__ __forceinline__ void load_raw(const Params& P, const unsigned char* ws, int m, int lane, Y1Raw& r) {
    const f32x4* xr = (const f32x4*)(P.x + (size_t)m * DM) + lane;
    const v2u* mr = (const v2u*)(ws + WS_MIXED + (size_t)m * DM * 2) + lane;
#pragma unroll
    for (int j = 0; j < 4; ++j) { r.x[j] = xr[64 * j]; r.m[j] = mr[64 * j]; }
}
__device__ __forceinline__ void make_y1(const Y1Raw& r, int lane, const float* mod_b, f32x4 (&y)[4]) {
    const float* g1 = mod_b + 2 * 1024;
#pragma unroll
    for (int j = 0; j < 4; ++j) { const f32x4 xv = r.x[j]; const v2u mw = r.m[j]; const f32x4 gv = *(const f32x4*)(g1 + 4 * lane + 256 * j);
        y[j].x = DN_ALPHA * xv.x + gv.x * bf_lo(mw.x); y[j].y = DN_ALPHA * xv.y + gv.y * bf_hi(mw.x); y[j].z = DN_ALPHA * xv.z + gv.z * bf_lo(mw.y); y[j].w = DN_ALPHA * xv.w + gv.w * bf_hi(mw.y); }
}
__device__ __forceinline__ void load_y1(const Params& P, const unsigned char* ws, int m, int lane, const float* mod_b, f32x4 (&y)[4]) {
    Y1Raw r; load_raw(P, ws, m, lane, r); make_y1(r, lane, mod_b, y);
}
__device__ __forceinline__ void row_stats(const f32x4 (&y)[4], float& mean, float& rstd) {
    float s = 0.f, q = 0.f;
#pragma unroll
    for (int j = 0; j < 4; ++j) { s += (y[j].x + y[j].y) + (y[j].z + y[j].w); q += (y[j].x * y[j].x + y[j].y * y[j].y) + (y[j].z * y[j].z + y[j].w * y[j].w); }
#pragma unroll
    for (int o = 1; o < 64; o <<= 1) { s += __shfl_xor(s, o); q += __shfl_xor(q, o); }
    mean = s * (1.0f / DM); const float var = fmaxf(q * (1.0f / DM) - mean * mean, 0.f); rstd = 1.0f / sqrtf(var + EPS);
}
__device__ __forceinline__ void phase7(const Params& P, const Ctx& X) {
    unsigned char* ws = P.ws;
    float* wr = (float*)X.lds;
    for (int i = X.tid; i < 1024 * 16; i += NTHR) wr[(i & 15) * 1024 + (i >> 4)] = P.w_router[i];
    __syncthreads();
    const float* mod = (const float*)(ws + WS_MOD);
    int m = X.gw;
    Y1Raw raw; if (m < T) load_raw(P, ws, m, X.lane, raw);
    for (; m < T; m += X.NGW) {
        const int b = m / SEQ; const float* mb = mod + b * 6144;
        f32x4 y[4]; make_y1(raw, X.lane, mb, y);
        if (m + X.NGW < T) load_raw(P, ws, m + X.NGW, X.lane, raw);
        float mean, rstd; row_stats(y, mean, rstd);
        if (X.lane == 0) ((float2*)(ws + WS_STATS))[m] = make_float2(mean, rstd);
        float lg[16];
#pragma unroll
        for (int e = 0; e < 16; ++e) lg[e] = 0.f;
        unsigned long long* o8 = (unsigned long long*)(ws + WS_U2 + (size_t)m * DM * 2) + X.lane;
        unsigned long long* x8 = (unsigned long long*)(ws + WS_X1 + (size_t)m * DM * 2) + X.lane;
#pragma unroll
        for (int j = 0; j < 4; ++j) { const int c0 = 4 * X.lane + 256 * j;
            const f32x4 g = *(const f32x4*)(P.ln1_g + c0), bb = *(const f32x4*)(P.ln1_b + c0), sh = *(const f32x4*)(mb + 3 * 1024 + c0), sc = *(const f32x4*)(mb + 4 * 1024 + c0);
            f32x4 u; u = ((y[j] - mean) * rstd * g + bb);
            x8[64 * j] = (unsigned long long)pk2(u.x, u.y) | ((unsigned long long)pk2(u.z, u.w) << 32);
            u = u * (sc + 1.0f) + sh;
            o8[64 * j] = (unsigned long long)pk2(u.x, u.y) | ((unsigned long long)pk2(u.z, u.w) << 32);
#pragma unroll
            for (int e = 0; e < 16; ++e) { const f32x4 w = *(const f32x4*)(wr + e * 1024 + c0); lg[e] += (u.x * w.x + u.y * w.y) + (u.z * w.z + u.w * w.w); } }
#pragma unroll
        for (int n = 8, B = 32; n >= 1; n >>= 1, B >>= 1) { const bool up = (X.lane & B) != 0;
#pragma unroll
            for (int i = 0; i < n; ++i) { const float lo = lg[i], hi = lg[i + n]; const float send = up ? lo : hi, keep = up ? hi : lo; lg[i] = keep + __shfl_xor(send, B); } }
        float lv = lg[0]; lv += __shfl_xor(lv, 2); lv += __shfl_xor(lv, 1);
        float mx = lv;
#pragma unroll
        for (int o = 4; o < 64; o <<= 1) mx = fmaxf(mx, __shfl_xor(mx, o));
        const float ex = expf(lv - mx); float den = ex;
#pragma unroll
        for (int o = 4; o < 64; o <<= 1) den += __shfl_xor(den, o);
        const int e = ((X.lane >> 5) & 1) * 8 + ((X.lane >> 4) & 1) * 4 + ((X.lane >> 3) & 1) * 2 + ((X.lane >> 2) & 1);
        if ((X.lane & 3) == 0) ((float*)(ws + WS_AFF))[(size_t)m * 16 + e] = ex / den;
    }
    __syncthreads();
}

__device__ __forceinline__ int block_excl_scan(int v, int& total, volatile int* sh, const Ctx& X) {
    int inc = v;
#pragma unroll
    for (int o = 1; o < 64; o <<= 1) { const int t = __shfl_up(inc, o); if (X.lane >= o) inc += t; }
    __syncthreads();
    if (X.lane == 63) sh[X.wave] = inc;
    __syncthreads();
    int base = 0, tot = 0;
#pragma unroll
    for (int w = 0; w < NWAVES; ++w) { const int c = sh[w]; if (w < X.wave) base += c; tot += c; }
    total = tot;
    return base + inc - v;
}
__device__ __forceinline__ void topk_be(const Params& P, const Ctx& X, int be) {
    unsigned char* ws = P.ws;
    const int b = be >> 4, e = be & 15;
    volatile int* sh = (volatile int*)X.lds;
    const float* aff = (const float*)(ws + WS_AFF) + ((size_t)b * SEQ + 16 * X.tid) * 16 + e;
    unsigned u[16];
#pragma unroll
    for (int i = 0; i < 16; ++i) u[i] = __float_as_uint(aff[i * 16]);
    unsigned Tv = 0u;
    for (int bit = 30; bit >= 0; --bit) {
        const unsigned cand = Tv | (1u << bit);
        int c = 0;
#pragma unroll
        for (int i = 0; i < 16; ++i) c += (u[i] >= cand) ? 1 : 0;
        c = (int)wave_sum((float)c);
        volatile int* slot = sh + 16 + 16 * (bit & 1);
        if (X.lane == 0) slot[X.wave] = c;
        __syncthreads();
        int tot = 0;
#pragma unroll
        for (int w = 0; w < NWAVES; ++w) tot += slot[w];
        if (tot >= CAP) Tv = cand;
    }
    int ngt = 0, neq = 0;
#pragma unroll
    for (int i = 0; i < 16; ++i) { ngt += (u[i] > Tv) ? 1 : 0; neq += (u[i] == Tv) ? 1 : 0; }
    int tot_gt, tot_eq;
    const int eq_before = block_excl_scan(neq, tot_eq, sh, X);
    (void)block_excl_scan(ngt, tot_gt, sh, X);
    const int need_eq = CAP - tot_gt;
    int nsel = 0; unsigned selmask = 0u; int er = eq_before;
#pragma unroll
    for (int i = 0; i < 16; ++i) { bool sel = u[i] > Tv; if (u[i] == Tv) { sel = er < need_eq; ++er; } if (sel) { selmask |= 1u << i; ++nsel; } }
    int tot_sel;
    int slot0 = block_excl_scan(nsel, tot_sel, sh, X);
    int* idx = (int*)(ws + WS_IDX) + be * CAP; float* gate = (float*)(ws + WS_GATE) + be * CAP; int* inv = (int*)(ws + WS_INV) + ((size_t)b * SEQ + 16 * X.tid) * 16 + e;
#pragma unroll
    for (int i = 0; i < 16; ++i) { const bool sel = (selmask >> i) & 1u;
        if (sel) { idx[slot0] = 16 * X.tid + i; gate[slot0] = __uint_as_float(u[i]); }
        inv[i * 16] = sel ? slot0 : -1;
        slot0 += sel ? 1 : 0; }
    __syncthreads();
}

__device__ __forceinline__ void transpose_item64(const float* __restrict__ W, int ldw, bf16* WT, int ldk, int nmul, int nadd, float* scr, int k0, int n0, int lane) {
    f32x4 v[16];
    const int kr = lane >> 4, nc = 4 * (lane & 15);
#pragma unroll
    for (int i = 0; i < 16; ++i) v[i] = *(const f32x4*)(W + (size_t)(k0 + 4 * i + kr) * ldw + n0 + nc);
#pragma unroll
    for (int i = 0; i < 16; ++i) { const int k = 4 * i + kr;
        scr[(nc + 0) * 65 + k] = v[i].x; scr[(nc + 1) * 65 + k] = v[i].y; scr[(nc + 2) * 65 + k] = v[i].z; scr[(nc + 3) * 65 + k] = v[i].w; }
    asm volatile("s_waitcnt lgkmcnt(0)" ::: "memory");
    const int c = lane & 7;
#pragma unroll
    for (int j = 0; j < 8; ++j) { const int n = 8 * j + (lane >> 3); const float* sp = scr + n * 65 + 8 * c;
        v4u o; o.x = pk2(sp[0], sp[1]); o.y = pk2(sp[2], sp[3]); o.z = pk2(sp[4], sp[5]); o.w = pk2(sp[6], sp[7]);
        *(v4u*)(WT + (size_t)((n0 + n) * nmul + nadd) * ldk + k0 + 8 * c) = o; }
    asm volatile("s_waitcnt lgkmcnt(0)" ::: "memory");
}
__device__ __forceinline__ void expert_weight_copies(const Params& P, const Ctx& X, int wg_rel, int nwg) {
    unsigned char* ws = P.ws;
    float* scr = (float*)(X.lds + X.wave * 16640);
    constexpr int I_E = 16 * 16;
    const int gw = wg_rel * NWAVES + X.wave, ngw = nwg * NWAVES;
    for (int it = gw; it < 48 * I_E; it += ngw) {
        const int mat = it / I_E, r = it % I_E, e = mat / 3, which = mat % 3;
        const int pnl = r >> 3, w8 = r & 7, k0 = 256 * (pnl >> 3) + 64 * (w8 >> 1), n0 = 128 * (pnl & 7) + 64 * (w8 & 1);
        if (which == 0) transpose_item64(P.w_gate + (size_t)e * 1048576, 1024, (bf16*)(ws + WS_WTGU) + (size_t)e * 2048 * 1024, 1024, 2, 0, scr, k0, n0, X.lane);
        else if (which == 1) transpose_item64(P.w_up + (size_t)e * 1048576, 1024, (bf16*)(ws + WS_WTGU) + (size_t)e * 2048 * 1024, 1024, 2, 1, scr, k0, n0, X.lane);
        else transpose_item64(P.w_down + (size_t)e * 1048576, 1024, (bf16*)(ws + WS_WTD) + (size_t)e * 1024 * 1024, 1024, 1, 0, scr, k0, n0, X.lane);
    }
}

__device__ __forceinline__ void phase9(const Params& P, const Ctx& X) {
    unsigned char* ws = P.ws;
    const int* idx = (const int*)(ws + WS_IDX);
#pragma unroll 4
    for (int r = X.gw; r < 32 * CAP; r += X.NGW) { const int b = r >> 14; const int s = idx[r];
        const v4u* src = (const v4u*)(ws + WS_U2 + ((size_t)b * SEQ + s) * DM * 2) + X.lane; v4u* dst = (v4u*)(ws + WS_XE + (size_t)r * DM * 2) + X.lane;
        dst[0] = src[0]; dst[64] = src[64]; }
}

struct P12Row { v2u yr[4][4]; v2u x1[4]; int cnt; unsigned rest; };
__device__ __forceinline__ void p12_issue(const unsigned char* ws, const Ctx& X, int m, int invm, P12Row& R) {
    const int b = m / SEQ;
    unsigned msk = (unsigned)(__ballot(invm >= 0) & 0xffffull);
    R.cnt = __popc(msk);
    int sl[4];
#pragma unroll
    for (int i = 0; i < 4; ++i) { sl[i] = -1; if (msk) { const int e = __ffs(msk) - 1; msk &= msk - 1; sl[i] = (b * 16 + e) * CAP + __shfl(invm, e); } }
    R.rest = msk;
#pragma unroll
    for (int i = 0; i < 4; ++i) if (R.cnt > i) { const v2u* p = (const v2u*)(ws + WS_YE + (size_t)sl[i] * DM * 2) + X.lane;
#pragma unroll
        for (int j = 0; j < 4; ++j) R.yr[i][j] = p[64 * j]; }
    const v2u* xp = (const v2u*)(ws + WS_X1 + (size_t)m * DM * 2) + X.lane;
#pragma unroll
    for (int j = 0; j < 4; ++j) R.x1[j] = xp[64 * j];
}
__device__ __forceinline__ void phase12(const Params& P, const Ctx& X) {
    unsigned char* ws = P.ws;
    const float* mod = (const float*)(ws + WS_MOD); const int* inv = (const int*)(ws + WS_INV);
    int m = X.gw;
    int inv0 = (m < T && X.lane < 16) ? inv[(size_t)m * 16 + X.lane] : -1;
    int inv1 = (m + X.NGW < T && X.lane < 16) ? inv[(size_t)(m + X.NGW) * 16 + X.lane] : -1;
    P12Row cur, nxt;
    if (m < T) p12_issue(ws, X, m, inv0, cur);
    for (; m < T; m += X.NGW) {
        const int b = m / SEQ; const float* mb = mod + b * 6144;
        const int nm = m + X.NGW;
        const int inv2 = (nm + X.NGW < T && X.lane < 16) ? inv[(size_t)(nm + X.NGW) * 16 + X.lane] : -1;
        if (nm < T) p12_issue(ws, X, nm, inv1, nxt);
        f32x4 y[4];
#pragma unroll
        for (int j = 0; j < 4; ++j) { y[j].x = bf_lo(cur.x1[j].x); y[j].y = bf_hi(cur.x1[j].x); y[j].z = bf_lo(cur.x1[j].y); y[j].w = bf_hi(cur.x1[j].y); }
        f32x4 f[4];
#pragma unroll
        for (int j = 0; j < 4; ++j) f[j] = (f32x4){0.f, 0.f, 0.f, 0.f};
#pragma unroll
        for (int i = 0; i < 4; ++i) if (cur.cnt > i) {
#pragma unroll
            for (int j = 0; j < 4; ++j) { const v2u w = cur.yr[i][j]; f[j].x += bf_lo(w.x); f[j].y += bf_hi(w.x); f[j].z += bf_lo(w.y); f[j].w += bf_hi(w.y); } }
        unsigned msk = cur.rest;
        while (msk) { const int e = __ffs(msk) - 1; msk &= msk - 1; const int r = (b * 16 + e) * CAP + __shfl(inv0, e);
            const v2u* p = (const v2u*)(ws + WS_YE + (size_t)r * DM * 2) + X.lane;
#pragma unroll
            for (int j = 0; j < 4; ++j) { const v2u w = p[64 * j]; f[j].x += bf_lo(w.x); f[j].y += bf_hi(w.x); f[j].z += bf_lo(w.y); f[j].w += bf_hi(w.y); } }
#pragma unroll
        for (int j = 0; j < 4; ++j) { const int c0 = 4 * X.lane + 256 * j;
            const f32x4 g2 = *(const f32x4*)(mb + 5 * 1024 + c0);
            y[j] = y[j] * DN_ALPHA + g2 * f[j]; }
        float mean, rstd; row_stats(y, mean, rstd);
#pragma unroll
        for (int j = 0; j < 4; ++j) y[j] = y[j] - mean;
        f32x4* orow = (f32x4*)(P.out + (size_t)m * DM) + X.lane;
#pragma unroll
        for (int j = 0; j < 4; ++j) { const int c0 = 4 * X.lane + 256 * j; const f32x4 g = *(const f32x4*)(P.ln2_g + c0), bb = *(const f32x4*)(P.ln2_b + c0);
            orow[64 * j] = y[j] * rstd * g + bb; }
        cur = nxt; inv0 = inv1; inv1 = inv2;
    }
}

#ifndef DBG_LAST_PHASE
#define DBG_LAST_PHASE 99
#endif
#define XB_TMO      128
#define XB_XCNT(j)  (256  + 64 * (j))
#define XB_XSUB(j)  (1280 + 64 * (j))
#define XB_XGEN(j)  (2304 + 64 * (j))
#define XB_TOP      3328
#define XB_TOPGEN   3392
#define XCD_BAR_WORDS 3456
#define XB_SPIN_CAP (1u << 18)

__device__ __forceinline__ unsigned xb_ld(unsigned* p)              { return __hip_atomic_load(p, __ATOMIC_RELAXED, __HIP_MEMORY_SCOPE_AGENT); }
__device__ __forceinline__ unsigned xb_add(unsigned* p, unsigned v) { return __hip_atomic_fetch_add(p, v, __ATOMIC_RELAXED, __HIP_MEMORY_SCOPE_AGENT); }
__device__ __forceinline__ unsigned xb_xcc_id() { return (unsigned)__builtin_amdgcn_s_getreg((3 << 11) | 20) & 0xFu; }
#define XB_SPIN(cond, bar) do { unsigned _sp = 0; while (cond) { __builtin_amdgcn_s_sleep(1); \
    if ((++_sp & 255u) == 0u) { if (xb_ld(&(bar)[XB_TMO])) break; if (_sp > XB_SPIN_CAP) { atomicAdd(&(bar)[XB_TMO], 1u); break; } } } } while (0)

struct XcdBarrier {
    unsigned* bar; unsigned x;
    volatile LAS unsigned* st;
};

__device__ __forceinline__ XcdBarrier xcd_barrier_post(unsigned* bar, volatile LAS unsigned* st) {
    XcdBarrier b; b.bar = bar; b.x = xb_xcc_id(); b.st = st;
    if (threadIdx.x == 0) (void)xb_add(&bar[XB_XCNT(b.x)], 1u);
    return b;
}
__device__ __forceinline__ void xcd_barrier_complete(unsigned* bar, unsigned x, unsigned& nloc, unsigned& nx) {
    const unsigned G = gridDim.x * gridDim.y * gridDim.z;
    unsigned sum, cnt, mine, sp = 0u;
    for (;;) {
        sum = 0u; cnt = 0u; mine = 0u;
#pragma unroll
        for (unsigned j = 0; j < 16; ++j) { const unsigned c = xb_ld(&bar[XB_XCNT(j)]); sum += c; cnt += (c > 0u) ? 1u : 0u; mine = (j == x) ? c : mine; }
        if (sum == G) break;
        __builtin_amdgcn_s_sleep(1);
        if ((++sp & 255u) == 0u) { if (xb_ld(&bar[XB_TMO])) break; if (sp > XB_SPIN_CAP) { atomicAdd(&bar[XB_TMO], 1u); break; } }
    }
    nloc = mine > 0u ? mine : 1u; nx = cnt > 0u ? cnt : 1u;
}

__device__ __forceinline__ void xcd_barrier(const XcdBarrier& b) {
    asm volatile("s_waitcnt vmcnt(0)" ::: "memory");
    __syncthreads();
    if (threadIdx.x == 0) {
        unsigned* bar = b.bar;
        __builtin_amdgcn_s_waitcnt(0);
        unsigned nloc = b.st[0], nx = b.st[1];
        if (nloc == 0u) { xcd_barrier_complete(bar, b.x, nloc, nx); b.st[0] = nloc; b.st[1] = nx; }
        const unsigned old = xb_add(&bar[XB_XSUB(b.x)], 1u);
        const unsigned gen = old / nloc;
        if (old + 1u == (gen + 1u) * nloc) {
            __builtin_amdgcn_fence(__ATOMIC_RELEASE, "agent");
            asm volatile("s_waitcnt vmcnt(0)" ::: "memory");
            const unsigned og = xb_add(&bar[XB_TOP], 1u);
            const unsigned tg = og / nx;
            if (og + 1u == (tg + 1u) * nx) xb_add(&bar[XB_TOPGEN], 1u);
            else XB_SPIN(xb_ld(&bar[XB_TOPGEN]) == tg, bar);
            __builtin_amdgcn_fence(__ATOMIC_ACQUIRE, "agent");
            xb_add(&bar[XB_XGEN(b.x)], 1u);
            asm volatile("s_waitcnt vmcnt(0)" ::: "memory");
        } else {
            XB_SPIN(xb_ld(&bar[XB_XGEN(b.x)]) == gen, bar);
            __builtin_amdgcn_fence(__ATOMIC_ACQUIRE, "agent");
            asm volatile("s_waitcnt vmcnt(0)" ::: "memory");
        }
    }
    __syncthreads();
}

#ifndef ATTN_V2
#define ATTN_V2 1
#endif
#ifndef P6_ALIGN
#define P6_ALIGN true
#endif
#ifndef EXP_WGM
#define EXP_WGM 4
#endif
#ifndef HY16
#define HY16 1
#endif
#ifndef REP_P0
#define REP_P0 1
#endif
#ifndef REP_P1
#define REP_P1 1
#endif
#ifndef REP_P2
#define REP_P2 1
#endif
#ifndef REP_P3
#define REP_P3 1
#endif
#ifndef REP_P4
#define REP_P4 1
#endif
#ifndef REP_P5
#define REP_P5 1
#endif
#ifndef REP_P6
#define REP_P6 1
#endif
#ifndef REP_P7
#define REP_P7 1
#endif
#ifndef REP_P8
#define REP_P8 1
#endif
#ifndef REP_P9
#define REP_P9 1
#endif
#ifndef REP_P10
#define REP_P10 1
#endif
#ifndef REP_P11
#define REP_P11 1
#endif
#ifndef REP_P12
#define REP_P12 1
#endif
#ifndef REP_HY
#define REP_HY 1
#endif
typedef const __attribute__((address_space(4))) Params* KParams;
__device__ __forceinline__ KParams launder_kp(KParams p) { asm volatile("" : "+s"(p)); return p; }
__device__ __forceinline__ Params load_params(KParams p) { Params r{};
#if defined(__HIP_DEVICE_COMPILE__)
    r = *launder_kp(p);
#endif
    return r; }
#define LOADP() const Params P = load_params(kp); unsigned char* ws = P.ws; MKCTX()
__global__ void __launch_bounds__(NTHR, 2) fwd_megakernel(Params Pv) {
    extern __shared__ __attribute__((aligned(16))) unsigned char lds[];
    cg::grid_group grid = cg::this_grid();
    const int wave0 = __builtin_amdgcn_readfirstlane(threadIdx.x >> 6);
#define MKCTX() Ctx X; { int w_ = wave0; asm volatile("" : "+s"(w_)); X.wave = w_; unsigned m_ = ~0u; asm volatile("" : "+s"(m_)); X.lane = __builtin_amdgcn_mbcnt_hi(m_, __builtin_amdgcn_mbcnt_lo(m_, 0u)); X.tid = w_ * 64 + X.lane; \
    X.G = gridDim.x; const int bx_ = blockIdx.x; X.vcu = (X.G % 8 == 0) ? (bx_ % 8) * (X.G / 8) + bx_ / 8 : bx_; X.gw = X.vcu * NWAVES + X.wave; X.NGW = X.G * NWAVES; X.lds = lds; }
    KParams kp = (KParams)__builtin_amdgcn_kernarg_segment_ptr();
    volatile LAS unsigned* bar_st = (volatile LAS unsigned*)((LAS unsigned char*)lds + (LDS_BYTES - 64));
    if (threadIdx.x < 2) bar_st[threadIdx.x] = 0u;
    __syncthreads();
    XcdBarrier xbar; xbar.bar = nullptr; xbar.x = 0; xbar.st = bar_st;
    PG8_LAS unsigned char* ring = (PG8_LAS unsigned char*)lds;

    for (int rep = 0; rep < REP_P0; ++rep) {
    { LOADP(); if (blockIdx.x == 0) for (int i = X.tid; i < XCD_BAR_WORDS; i += NTHR) ((unsigned*)(ws + WS_BAR))[i] = 0u; phase0(P, X); }
    grid.sync(); if (rep + 1 == REP_P0) { LOADP(); (void)X; xbar = xcd_barrier_post((unsigned*)(ws + WS_BAR), bar_st); }
    }
    for (int rep = 0; rep < REP_P1; ++rep) {
    { LOADP(); (void)ws; phase1(P, X); }
    xcd_barrier(xbar);
    }
    for (int rep = 0; rep < REP_P2; ++rep) {
    { LOADP();
        { pg8::Gemm g{(const pg8::bf16_t*)(ws + WS_U1), (const pg8::bf16_t*)(ws + WS_WTIN), T, IN_PAD, 1024, 1024, 1024, 1 << 30, 1, 0, nullptr, 0, 0};
          pg8::StaticOrder S; S.init(T, IN_PAD, X.G, (int)blockIdx.x);
          epi::EpiIn E{(pg8::bf16_t*)(ws + WS_CQ), (pg8::bf16_t*)(ws + WS_CKV), (float*)(ws + WS_KRR), (pg8::bf16_t*)(ws + WS_HYT), (float*)(ws + (rep ? WS_FFTS : WS_SSQQ)), (float*)(ws + (rep ? WS_FFTS + 65536 : WS_SSQKV)), ring + pg8::STAGE_BYTES};
          pg8::gemm_phase<epi::EpiIn, pg8::StaticOrder, true, true>(ring, g, S, E, X.tid); }
        __syncthreads();
        { pg8::Gemm g{(const pg8::bf16_t*)(ws + WS_H2), (const pg8::bf16_t*)(ws + WS_WT3), SEQ, 2048, 128, 128, 128, 1 << 30, 1, 0, nullptr, 0, 0};
          pg8::StaticOrder S; S.init(SEQ, 2048, X.G, (int)blockIdx.x);
          epi::EpiFilt E{(unsigned*)(ws + WS_KT), P.filt_b3, P.hyena_decay};
          pg8::gemm_phase<epi::EpiFilt, pg8::StaticOrder, true, true>(ring, g, S, E, X.tid); }
    }
    xcd_barrier(xbar);
    }
    for (int rep = 0; rep < REP_P3; ++rep) {
    { LOADP();
        { pg8::Gemm g{(const pg8::bf16_t*)(ws + WS_CQ), (const pg8::bf16_t*)(ws + WS_WTQB), T, 768, 256, 256, 256, 1 << 30, 1, 0, nullptr, 0, 0};
          pg8::StaticOrder S; S.init(T, 768, X.G, (int)blockIdx.x);
          epi::EpiRowScale E{(pg8::bf16_t*)(ws + WS_Q), 768, (const float*)(ws + WS_SSQQ), 1.0f / 256.0f, ATTN_V2 ? attn2::C2 : 1.0f};
          pg8::gemm_phase<epi::EpiRowScale, pg8::StaticOrder, true, true>(ring, g, S, E, X.tid); }
        __syncthreads();
        { pg8::Gemm g{(const pg8::bf16_t*)(ws + WS_CKV), (const pg8::bf16_t*)(ws + WS_WTKVB), T, 1024, 128, 128, 128, 1 << 30, 1, 0, nullptr, 0, 0};
          pg8::StaticOrder S; S.init(T, 1024, X.G, (int)blockIdx.x);
          epi::EpiRowScale E{(pg8::bf16_t*)(ws + WS_KV), 1024, (const float*)(ws + WS_SSQKV), 1.0f / 128.0f, 1.0f};
          pg8::gemm_phase<epi::EpiRowScale, pg8::StaticOrder, true, true>(ring, g, S, E, X.tid); }
        __syncthreads();
        krope_pass(P, X);
        __syncthreads();
#if HY16
        hy16::build_tables((hy16::h2*)(lds + hy16::LDS_T2), (hy16::h2*)(lds + hy16::LDS_T3), (const hy16::cf*)(ws + WS_TW), X.tid);
        hy16::h2 w1a[16], w1b[16]; hy16::load_tw1((const hy16::cf*)(ws + WS_TW), X.tid, w1a, w1b);
        __syncthreads();
        if ((X.tid >> 6) < 4) __builtin_amdgcn_s_setprio(2);
        for (int rh = 0; rh < REP_HY; ++rh)
        for (int c = X.vcu; c < HW; c += X.G) {
            hy16::hyena_channel(c, lds, (const hy16::bf16_t*)(ws + WS_HYT), (const hy16::bf16_t*)(ws + WS_KT), P.conv_w, P.conv_b, P.hyena_bias,
                                w1a, w1b, (hy16::bf16_t*)(ws + WS_HYOT), X.tid);
        }
        __builtin_amdgcn_s_setprio(0);
    }
#else
        { hy::cf* twl = (hy::cf*)(lds + hy::ZELEMS * 8);
          for (int i = X.tid; i < 1024; i += NTHR) twl[i] = ((const hy::cf*)(ws + WS_TW))[i]; }
        __syncthreads();
        for (int rh = 0; rh < REP_HY; ++rh)
        for (int c = X.vcu; c < HW; c += X.G) {
            unsigned char* fs = ws + WS_FFTS + (size_t)blockIdx.x * FFTS_PER_WG;
            hy::hyena_channel(c, (hy::cf*)lds, (const hy::cf*)(lds + hy::ZELEMS * 8), (const hy::bf16_t*)(ws + WS_HYT), (const hy::bf16_t*)(ws + WS_KT), P.conv_w, P.conv_b, P.hyena_bias,
                              (hy::cf*)fs, (hy::cf*)(fs + 256 * 1024), (hy::bf16_t*)(ws + WS_HYOT), X.tid);
        }
    }
#endif
    xcd_barrier(xbar);
    }
    for (int rep = 0; rep < REP_P4; ++rep) {
    { LOADP();
        for (int u = X.vcu; u < BATCH * NH * (SEQ / 256); u += X.G) {
            const int bh = u >> 5, qb = u & 31, b = bh >> 3, h = bh & 7;
#if ATTN_V2
#ifdef ATTN_PRIO
            if (X.wave < 4) __builtin_amdgcn_s_setprio(ATTN_PRIO);
#endif
            attn2::attn_unit<8>(b, h, qb, (const attn2::bf16*)(ws + WS_Q), (const attn2::bf16*)(ws + WS_KV), (const attn2::bf16*)(ws + WS_KR), (const float*)(ws + WS_CS),
                                (attn2::bf16*)(ws + WS_AATT), (char*)lds, X.tid);
#ifdef ATTN_PRIO
            __builtin_amdgcn_s_setprio(0);
#endif
#else
            attn::attn_unit((const attn::bf16_t*)(ws + WS_Q), (const attn::bf16_t*)(ws + WS_KV), (const attn::bf16_t*)(ws + WS_KR), (const float*)(ws + WS_CS),
                            (attn::bf16_t*)(ws + WS_AATT), h, (long)b * SEQ + qb * 256, (long)b * SEQ, SEQ, (char*)lds, X.tid);
#endif
        }
    }
    xcd_barrier(xbar);
    }
    for (int rep = 0; rep < REP_P5; ++rep) {
    { LOADP(); (void)ws; phase5(P, X); }
    xcd_barrier(xbar);
    }
    for (int rep = 0; rep < REP_P6; ++rep) {
    { LOADP();
        pg8::Gemm g{(const pg8::bf16_t*)(ws + WS_APRIME), (const pg8::bf16_t*)(ws + WS_WTO), T, 1024, 1024, 1024, 1024, 1 << 30, 1, 0, nullptr, 0, 0};
        pg8::StaticOrder S; S.init(T, 1024, X.G, (int)blockIdx.x);
        epi::EpiRowScale E{(pg8::bf16_t*)(ws + WS_MIXED), 1024, nullptr, 0.f, 1.0f};
        pg8::gemm_phase<epi::EpiRowScale, pg8::StaticOrder, P6_ALIGN, true>(ring, g, S, E, X.tid);
    }
    xcd_barrier(xbar);
    }
    for (int rep = 0; rep < REP_P7; ++rep) {
    { LOADP(); (void)ws; phase7(P, X); }
    xcd_barrier(xbar);
    }
    for (int rep = 0; rep < REP_P8; ++rep) {
    { LOADP();
#ifndef REP_TOPK
#define REP_TOPK 1
#endif
#ifndef REP_CONV
#define REP_CONV 1
#endif
        if (X.G >= 64) { if (blockIdx.x < 32) { for (int q = 0; q < REP_TOPK; ++q) topk_be(P, X, blockIdx.x); } else { for (int q = 0; q < REP_CONV; ++q) expert_weight_copies(P, X, blockIdx.x - 32, X.G - 32); } }
        else { for (int be = blockIdx.x; be < 32; be += X.G) topk_be(P, X, be); expert_weight_copies(P, X, blockIdx.x, X.G); }
    }
    xcd_barrier(xbar);
    }
    for (int rep = 0; rep < REP_P10; ++rep) {
    { LOADP();
        pg8::Gemm g{(const pg8::bf16_t*)(ws + WS_U2), (const pg8::bf16_t*)(ws + WS_WTGU), 32 * CAP, 2048, 1024, 1024, 1024, 4, 16, (size_t)2048 * 1024 * 2, (const int*)(ws + WS_IDX), 14, SEQ};
        pg8::StaticOrder S; S.init(32 * CAP, 2048, X.G, (int)blockIdx.x, EXP_WGM);
        epi::EpiGU E{(pg8::bf16_t*)(ws + WS_HB)};
        pg8::gemm_phase<epi::EpiGU, pg8::StaticOrder, true, true, true>(ring, g, S, E, X.tid);
    }
    xcd_barrier(xbar);
    }
    for (int rep = 0; rep < REP_P11; ++rep) {
    { LOADP();
        pg8::Gemm g{(const pg8::bf16_t*)(ws + WS_HB), (const pg8::bf16_t*)(ws + WS_WTD), 32 * CAP, 1024, 1024, 1024, 1024, 4, 16, (size_t)1024 * 1024 * 2, nullptr, 0, 0};
        pg8::StaticOrder S; S.init(32 * CAP, 1024, X.G, (int)blockIdx.x, EXP_WGM);
        epi::EpiDown E{(pg8::bf16_t*)(ws + WS_YE), (const float*)(ws + WS_GATE)};
        pg8::gemm_phase<epi::EpiDown, pg8::StaticOrder, true, true>(ring, g, S, E, X.tid);
    }
    xcd_barrier(xbar);
    }
#ifdef REP_SYNC
    for (int rs = 0; rs < REP_SYNC; ++rs) xcd_barrier(xbar);
#endif
    for (int rep = 0; rep < REP_P12; ++rep) {
    { LOADP(); (void)ws; phase12(P, X); }
        if (rep + 1 < REP_P12) xcd_barrier(xbar);
    }
}

extern "C" void kernel_launch(void* const* d_in, const int* in_sizes, int n_in, void* d_out, int out_size, void* d_ws, size_t ws_size, hipStream_t stream) {
    static int grid = 0;
    if (grid == 0) {
        if (n_in != 32 || in_sizes[0] != T * DM || out_size != T * DM || ws_size < WS_END) {
            fprintf(stderr, "kernel_launch: unexpected shapes: n_in %d in0 %d out %d ws %zu (need >= %zu)\n", n_in, n_in > 0 ? in_sizes[0] : -1, out_size, ws_size, (size_t)WS_END); grid = -1; return; }
        int dev = 0, cus = 0, per_cu = 0;
        hipGetDevice(&dev); hipDeviceGetAttribute(&cus, hipDeviceAttributeMultiprocessorCount, dev);
        if (hipFuncSetAttribute((const void*)fwd_megakernel, hipFuncAttributeMaxDynamicSharedMemorySize, LDS_BYTES) != hipSuccess) { fprintf(stderr, "kernel_launch: hipFuncSetAttribute failed\n"); grid = -1; return; }
        if (hipOccupancyMaxActiveBlocksPerMultiprocessor(&per_cu, (const void*)fwd_megakernel, NTHR, LDS_BYTES) != hipSuccess || per_cu < 1) { fprintf(stderr, "kernel_launch: occupancy query failed (%d)\n", per_cu); (void)hipGetLastError(); per_cu = 1; }
        grid = cus * 1;
        fprintf(stderr, "kernel_launch: cus %d per_cu %d grid %d ws %zu\n", cus, per_cu, grid, ws_size);
    }
    if (grid < 0) return;
    Params p{};
    const float** pf = (const float**)&p;
    p.x = (const float*)d_in[0]; p.c = (const float*)d_in[1]; p.positions = (const int*)d_in[2];
    p.w_ada = (const float*)d_in[3]; p.b_ada = (const float*)d_in[4]; p.w_in = (const float*)d_in[5]; p.q_norm_g = (const float*)d_in[6]; p.w_qb = (const float*)d_in[7];
    p.kv_norm_g = (const float*)d_in[8]; p.w_kvb = (const float*)d_in[9]; p.conv_w = (const float*)d_in[10]; p.conv_b = (const float*)d_in[11];
    p.filt_w1 = (const float*)d_in[12]; p.filt_b1 = (const float*)d_in[13]; p.filt_freq = (const float*)d_in[14]; p.filt_w2 = (const float*)d_in[15]; p.filt_b2 = (const float*)d_in[16];
    p.filt_w3 = (const float*)d_in[17]; p.filt_b3 = (const float*)d_in[18]; p.hyena_decay = (const float*)d_in[19]; p.hyena_bias = (const float*)d_in[20];
    p.attn_out_g = (const float*)d_in[21]; p.hyena_out_g = (const float*)d_in[22]; p.w_o = (const float*)d_in[23]; p.ln1_g = (const float*)d_in[24]; p.ln1_b = (const float*)d_in[25];
    p.w_router = (const float*)d_in[26]; p.w_gate = (const float*)d_in[27]; p.w_up = (const float*)d_in[28]; p.w_down = (const float*)d_in[29]; p.ln2_g = (const float*)d_in[30]; p.ln2_b = (const float*)d_in[31];
    p.out = (float*)d_out; p.ws = (unsigned char*)d_ws; (void)pf;
    void* args[] = {&p};
    hipError_t e = hipLaunchCooperativeKernel((const void*)fwd_megakernel, dim3(grid), dim3(NTHR), args, LDS_BYTES, stream);
    if (e != hipSuccess) fprintf(stderr, "kernel_launch: cooperative launch failed: %s (grid %d)\n", hipGetErrorString(e), grid);
}
```

```cpp
#include <hip/hip_runtime.h>
#include <hip/hip_cooperative_groups.h>
#include <hip/hip_bf16.h>
#include <cstdio>
#include <cstdint>
#include <cmath>
namespace cg = cooperative_groups;

constexpr int BATCH = 2, SEQ = 8192, DM = 1024, T = BATCH * SEQ;
constexpr int NH = 8, QKD = 96, VD = 64, NOPE = 64, ROPE = 32;
constexpr int QLR = 256, KVLR = 128;
constexpr int HW = 512;
constexpr int IN_COLS = 1952, IN_PAD = 2048;
constexpr int NEXP = 16, CAP = 1024, EFF = 1024;
constexpr int FEMB = 33, FORD = 64;
constexpr float EPS = 1e-5f;
constexpr float DN_ALPHA = 1.189207115002721f;
constexpr int NFFT = 2 * SEQ;

namespace pg8 {
#define PG8_LAS __attribute__((address_space(3)))
typedef unsigned short bf16_t;
typedef short bf16x8 __attribute__((ext_vector_type(8)));
typedef float f32x4 __attribute__((ext_vector_type(4)));
typedef unsigned u32x4 __attribute__((ext_vector_type(4)));
constexpr int BM = 256, BK = 64, HALF = 128, HTB = HALF * BK * 2  , STAGE_BYTES = 8 * HTB, NXCD = 8, WGM = 8;

__host__ __device__ __forceinline__ int lds_byte(int r, int c) { const int st = (r >> 4) * 2 + (c >> 5), rr = r & 15, cc = c & 31, ob = rr * 64 + cc * 2; return st * 1024 + (ob ^ (((ob >> 9) & 1) << 5)); }
__host__ __device__ __forceinline__ void stage_rc(int b, int& R, int& C) { const int st = b / 1024, sb = b % 1024, swz = sb ^ (((sb >> 9) & 1) << 5); R = (st >> 1) * 16 + swz / 64; C = (st & 1) * 32 + (swz % 64) / 2; }
__host__ __device__ __forceinline__ int perm32(int rho) { const int n = rho >> 4, i = rho & 15; return 8 * (i >> 2) + 4 * n + (i & 3); }

struct Unit { int pm, pn; };
struct Gemm { const bf16_t* A; const bf16_t* Bt; int M, N, K; int lda, ldb; int pm_per_grp, grp_mod; size_t b_grp_bytes; const int* gidx; int g_shift, g_src; };

struct StaticOrder {
    int nM, nN, nwg, G, c, wgm;
    __host__ __device__ void init(int M, int N, int G_, int c_, int wgm_ = WGM) { nM = M / BM; nN = N / BM; nwg = nM * nN; G = G_; c = c_; wgm = wgm_; }
    __host__ __device__ bool next(int i, Unit& u) const {
        const long L = (long)i * G + c; if (L >= nwg) return false;
        int wgid = (int)L; { const int q = nwg / NXCD, r = nwg % NXCD, xcd = wgid % NXCD, off = wgid / NXCD; wgid = (xcd < r ? xcd * (q + 1) : r * (q + 1) + (xcd - r) * q) + off; }
        const int nig = wgm * nN, gid = wgid / nig, fm = gid * wgm, gsz = (nM - fm) < wgm ? (nM - fm) : wgm;
        u.pm = fm + ((wgid % nig) % gsz); u.pn = (wgid % nig) / gsz; return true;
    }
    __device__ __forceinline__ void a_ready(const Unit&) const {}
    __device__ __forceinline__ void done(const Unit&) const {}
};

__device__ __forceinline__ unsigned cvt_pk_bf16(float lo, float hi) { unsigned r; asm volatile("v_cvt_pk_bf16_f32 %0, %1, %2" : "=v"(r) : "v"(lo), "v"(hi)); return r; }
typedef float f32x2 __attribute__((ext_vector_type(2)));
__device__ __forceinline__ f32x2 gelu_pk(f32x2 v) {
    const f32x2 av = __builtin_elementwise_abs(v), d = av * 0.2316418882f + 1.0f;
    f32x2 t; t.x = __builtin_amdgcn_rcpf(d.x); t.y = __builtin_amdgcn_rcpf(d.y);
    f32x2 q = t * 0.5307027145f + (-0.7265760135f); q = q * t + 0.7107068705f; q = q * t + (-0.142248368f); q = q * t + 0.127414796f; q = q * t;
    const f32x2 s = (v * v) * (-0.72134752044f);
    f32x2 e; e.x = __builtin_amdgcn_exp2f(s.x); e.y = __builtin_amdgcn_exp2f(s.y);
    const f32x2 m = v * (q * e), r = v - m;
    f32x2 o; o.x = v.x < 0.f ? m.x : r.x; o.y = v.y < 0.f ? m.y : r.y; return o;
}

template <int ACT  > struct EpiBf16 {
    static constexpr bool PERM = true, AFTER_DRAIN = false; static constexpr bool HAS_MID = false; static_assert(ACT == 0 || ACT == 1, "EpiBf16: ACT is 0 (none) or 1 (gelu_pk)");
    bf16_t* O; int ldc; const float* bias; int split_cols; size_t split_stride; float scale0;
    __device__ __forceinline__ void operator()(const f32x4 (&acc)[2][2][4][2], const Unit& u, int wr, int wc, int fr, int fq) const {
        const int row0 = u.pm * BM + wr * 64 + fr; int colt = u.pn * BM; bf16_t* base = O;
        float sc = 1.f; if (split_cols) { const int t = colt / split_cols; base += (size_t)t * split_stride; colt -= t * split_cols; if (t == 0) sc = scale0; }
        const int col0 = colt + wc * 32 + 8 * fq, bcol0 = u.pn * BM + wc * 32 + 8 * fq;
        f32x4 bv[2][2];
#pragma unroll
        for (int bj = 0; bj < 2; ++bj)
#pragma unroll
            for (int n = 0; n < 2; ++n) bv[bj][n] = bias ? *(const f32x4*)(bias + bcol0 + bj * HALF + 4 * n) : (f32x4){0.f, 0.f, 0.f, 0.f};
#pragma unroll
        for (int ai = 0; ai < 2; ++ai)
#pragma unroll
            for (int m = 0; m < 4; ++m) { bf16_t* rowp = base + (size_t)(row0 + ai * HALF + m * 16) * ldc + col0;
#pragma unroll
                for (int bj = 0; bj < 2; ++bj) { f32x4 v0 = acc[ai][bj][m][0] + bv[bj][0], v1 = acc[ai][bj][m][1] + bv[bj][1];
                    if (ACT == 1) { f32x2 a = gelu_pk((f32x2){v0[0], v0[1]}), b = gelu_pk((f32x2){v0[2], v0[3]}), c = gelu_pk((f32x2){v1[0], v1[1]}), d = gelu_pk((f32x2){v1[2], v1[3]});
                        v0 = (f32x4){a.x, a.y, b.x, b.y}; v1 = (f32x4){c.x, c.y, d.x, d.y}; }
                    v0 = v0 * sc; v1 = v1 * sc; u32x4 w; w.x = cvt_pk_bf16(v0[0], v0[1]); w.y = cvt_pk_bf16(v0[2], v0[3]); w.z = cvt_pk_bf16(v1[0], v1[1]); w.w = cvt_pk_bf16(v1[2], v1[3]);
                    *(u32x4*)(rowp + bj * HALF) = w; } }
    }
};

struct PanelStats {
    unsigned* xbuf;
    unsigned* cnt;
    unsigned* tmo;
    int ntn; float eps;
    unsigned code;
    __device__ __forceinline__ bool run(const f32x4 (&v)[2][2][4][2], const Unit& u, int wr, int wc, int fr, int fq, PG8_LAS unsigned char* lds, int wid, int lane) const {
        typedef float f32x2v __attribute__((ext_vector_type(2)));
        PG8_LAS f32x2v* P = (PG8_LAS f32x2v*)lds;
        PG8_LAS f32x2v* S = (PG8_LAS f32x2v*)(lds + 8192);
        PG8_LAS unsigned* flag = (PG8_LAS unsigned*)(lds + 8192 + 2048);
#pragma unroll
        for (int ai = 0; ai < 2; ++ai)
#pragma unroll
            for (int m = 0; m < 4; ++m) {
                float s = 0.f;
#pragma unroll
                for (int bj = 0; bj < 2; ++bj)
#pragma unroll
                    for (int n = 0; n < 2; ++n) { const f32x4 x = v[ai][bj][m][n]; s += (x[0] + x[1]) + (x[2] + x[3]); }
                s += __shfl_xor(s, 16); s += __shfl_xor(s, 32);
                const float mw = s * (1.0f / 64.0f); float q = 0.f;
#pragma unroll
                for (int bj = 0; bj < 2; ++bj)
#pragma unroll
                    for (int n = 0; n < 2; ++n) { const f32x4 d = v[ai][bj][m][n] - mw; q += (d[0] * d[0] + d[1] * d[1]) + (d[2] * d[2] + d[3] * d[3]); }
                q += __shfl_xor(q, 16); q += __shfl_xor(q, 32);
                if (fq == 0) P[(ai * HALF + wr * 64 + m * 16 + fr) * 4 + wc] = (f32x2v){mw, q};
            }
        asm volatile("s_waitcnt lgkmcnt(0)" ::: "memory"); __builtin_amdgcn_s_barrier(); asm volatile("" ::: "memory");
#if defined(BROKEN_EXCHANGE_NO_WAIT)
#warning BROKEN CONTROL BUILD: the row-statistics exchange does not wait; results are wrong by design
        if (blockIdx.x >= 64) { const long long t0_ = clock64(); while (clock64() - t0_ < 60000) __builtin_amdgcn_s_sleep(8); }
#endif
        const int row = wid * 32 + (lane & 31);
        if (lane < 32) {
            const f32x2v a = P[row * 4 + 0], b = P[row * 4 + 1], c = P[row * 4 + 2], d = P[row * 4 + 3];
            const float mt = (a.x + b.x + c.x + d.x) * 0.25f;
            const float da = a.x - mt, db = b.x - mt, dc = c.x - mt, dd = d.x - mt;
            const float m2 = (a.y + b.y) + (c.y + d.y) + 64.0f * ((da * da + db * db) + (dc * dc + dd * dd));
            unsigned long long* slot = (unsigned long long*)xbuf + ((size_t)(u.pm * BM + row) * 4 + u.pn);
            __hip_atomic_store(slot, ((unsigned long long)__float_as_uint(m2) << 32) | __float_as_uint(mt), __ATOMIC_RELAXED, __HIP_MEMORY_SCOPE_AGENT);
        }
        asm volatile("s_waitcnt vmcnt(0)" ::: "memory");
        if (lane == 0) __hip_atomic_fetch_add(cnt + 64 * u.pm, 1u, __ATOMIC_RELAXED, __HIP_MEMORY_SCOPE_AGENT);
        if (wid == 0) {
            bool dead = false; const unsigned long long t0 = __builtin_amdgcn_s_memrealtime(); const unsigned want = 8u * (unsigned)ntn;
            for (;;) {
#if defined(BROKEN_EXCHANGE_NO_WAIT)
                break;
#endif
                if ((unsigned)__builtin_amdgcn_readfirstlane(__hip_atomic_load(cnt + 64 * u.pm, __ATOMIC_RELAXED, __HIP_MEMORY_SCOPE_AGENT)) >= want) break;
                if (__builtin_amdgcn_s_memrealtime() - t0 > 2000000ull) {
                    if (lane == 0) { unsigned expect = 0u; __hip_atomic_compare_exchange_strong(tmo + 1, &expect, code | (unsigned)(u.pm & 0xff), __ATOMIC_RELAXED, __ATOMIC_RELAXED, __HIP_MEMORY_SCOPE_AGENT);
                                     __hip_atomic_store(tmo, 1u, __ATOMIC_RELAXED, __HIP_MEMORY_SCOPE_AGENT); }
                    dead = true; break; }
                __builtin_amdgcn_s_sleep(2);
            }
            __builtin_amdgcn_fence(__ATOMIC_ACQUIRE, "agent");
            if (lane == 0) flag[0] = dead ? 1u : 0u;
        }
        asm volatile("s_waitcnt vmcnt(0) lgkmcnt(0)" ::: "memory"); __builtin_amdgcn_s_barrier(); asm volatile("" ::: "memory");
        const bool bad = flag[0] != 0u;
        if (lane < 32) {
            const unsigned long long* slot = (const unsigned long long*)xbuf + (size_t)(u.pm * BM + row) * 4; float mt[4], m2[4]; float ms = 0.f;
#pragma unroll
            for (int t = 0; t < 4; ++t) { if (t < ntn) { const unsigned long long w = __hip_atomic_load(slot + t, __ATOMIC_RELAXED, __HIP_MEMORY_SCOPE_AGENT); mt[t] = __uint_as_float((unsigned)w); m2[t] = __uint_as_float((unsigned)(w >> 32)); } else { mt[t] = 0.f; m2[t] = 0.f; } ms += mt[t]; }
            const float mean = ms / (float)ntn; float q = 0.f;
#pragma unroll
            for (int t = 0; t < 4; ++t) if (t < ntn) { const float dm = mt[t] - mean; q += m2[t] + 256.0f * dm * dm; }
            S[row] = (f32x2v){mean, 1.0f / sqrtf(q / (256.0f * (float)ntn) + eps)};
        }
        asm volatile("s_waitcnt lgkmcnt(0)" ::: "memory"); __builtin_amdgcn_s_barrier(); asm volatile("" ::: "memory");
        return bad;
    }
};
struct EpiLnRes {
    static constexpr bool PERM = false, AFTER_DRAIN = true; static constexpr bool HAS_MID = false;
    const float* base; float* out; int ldc; const float* bias; PanelStats st; unsigned poison;
    __device__ __forceinline__ void fused(f32x4 (&acc)[2][2][4][2], const Unit& u, int wr, int wc, int fr, int fq, PG8_LAS unsigned char* lds, int wid, int lane) const {
        typedef float f32x2v __attribute__((ext_vector_type(2)));
        const PG8_LAS f32x2v* S = (const PG8_LAS f32x2v*)(lds + 8192);
        const int col0 = u.pn * BM + wc * 32 + 4 * fq;
#pragma unroll
        for (int bj = 0; bj < 2; ++bj)
#pragma unroll
            for (int n = 0; n < 2; ++n) { const f32x4 bv = bias ? *(const f32x4*)(bias + col0 + bj * HALF + n * 16) : (f32x4){0.f, 0.f, 0.f, 0.f};
#pragma unroll
                for (int ai = 0; ai < 2; ++ai)
#pragma unroll
                    for (int m = 0; m < 4; ++m) acc[ai][bj][m][n] += bv; }
        f32x4 pre[4][2][2];
#pragma unroll
        for (int m = 0; m < 4; ++m) { const size_t off = (size_t)(u.pm * BM + wr * 64 + m * 16 + fr) * ldc + col0;
#pragma unroll
            for (int bj = 0; bj < 2; ++bj)
#pragma unroll
                for (int n = 0; n < 2; ++n) pre[m][bj][n] = *(const f32x4*)(base + off + bj * HALF + n * 16); }
        const bool bad = st.run(acc, u, wr, wc, fr, fq, lds, wid, lane) || poison != 0u;
        const float qnan = __builtin_nanf("");
#pragma unroll
        for (int ai = 0; ai < 2; ++ai)
#pragma unroll
            for (int m = 0; m < 4; ++m) { const int r = ai * HALF + wr * 64 + m * 16 + fr; const f32x2v sr = S[r]; const size_t off = (size_t)(u.pm * BM + r) * ldc + col0;
#pragma unroll
                for (int bj = 0; bj < 2; ++bj)
#pragma unroll
                    for (int n = 0; n < 2; ++n) { const f32x4 bs = ai == 0 ? pre[m][bj][n] : *(const f32x4*)(base + off + bj * HALF + n * 16); f32x4 o = bs + (acc[ai][bj][m][n] - sr.x) * sr.y;
                        if (bad) o = (f32x4){qnan, qnan, qnan, qnan}; *(f32x4*)(out + off + bj * HALF + n * 16) = o; }
                if (m & 1) asm volatile("" ::: "memory"); }
    }
};
struct EpiLnResLn {
    static constexpr bool PERM = false, AFTER_DRAIN = true; static constexpr bool HAS_MID = false;
    const float* base; float* out; bf16_t* xn; int ldc; const float* bias; PanelStats st1, st2; unsigned poison;
    __device__ __forceinline__ void fused(f32x4 (&acc)[2][2][4][2], const Unit& u, int wr, int wc, int fr, int fq, PG8_LAS unsigned char* lds, int wid, int lane) const {
        typedef float f32x2v __attribute__((ext_vector_type(2))); typedef unsigned u32x2v __attribute__((ext_vector_type(2)));
        const PG8_LAS f32x2v* S = (const PG8_LAS f32x2v*)(lds + 8192);
        const int col0 = u.pn * BM + wc * 32 + 4 * fq;
#pragma unroll
        for (int bj = 0; bj < 2; ++bj)
#pragma unroll
            for (int n = 0; n < 2; ++n) { const f32x4 bv = bias ? *(const f32x4*)(bias + col0 + bj * HALF + n * 16) : (f32x4){0.f, 0.f, 0.f, 0.f};
#pragma unroll
                for (int ai = 0; ai < 2; ++ai)
#pragma unroll
                    for (int m = 0; m < 4; ++m) acc[ai][bj][m][n] += bv; }
        bool bad = st1.run(acc, u, wr, wc, fr, fq, lds, wid, lane) || poison != 0u;
        const float qnan = __builtin_nanf("");
#pragma unroll
        for (int ai = 0; ai < 2; ++ai)
#pragma unroll
            for (int m = 0; m < 4; ++m) { const int r = ai * HALF + wr * 64 + m * 16 + fr; const f32x2v sr = S[r]; const size_t off = (size_t)(u.pm * BM + r) * ldc + col0;
#pragma unroll
                for (int bj = 0; bj < 2; ++bj)
#pragma unroll
                    for (int n = 0; n < 2; ++n) { const f32x4 bs = *(const f32x4*)(base + off + bj * HALF + n * 16); acc[ai][bj][m][n] = bs + (acc[ai][bj][m][n] - sr.x) * sr.y; }
                asm volatile("" : "+v"(acc[ai][0][m][0]), "+v"(acc[ai][0][m][1]), "+v"(acc[ai][1][m][0]), "+v"(acc[ai][1][m][1]));
                if (m & 1) asm volatile("" ::: "memory"); }
        const bool bad1 = bad;
        bad = st2.run(acc, u, wr, wc, fr, fq, lds, wid, lane) || bad;
#pragma unroll
        for (int ai = 0; ai < 2; ++ai)
#pragma unroll
            for (int m = 0; m < 4; ++m) { const int r = ai * HALF + wr * 64 + m * 16 + fr; const f32x2v sr = S[r]; const size_t off = (size_t)(u.pm * BM + r) * ldc + col0;
#pragma unroll
                for (int bj = 0; bj < 2; ++bj)
#pragma unroll
                    for (int n = 0; n < 2; ++n) { const f32x4 x1 = acc[ai][bj][m][n]; *(f32x4*)(out + off + bj * HALF + n * 16) = bad1 ? (f32x4){qnan, qnan, qnan, qnan} : x1;
                        const f32x4 o = (x1 - sr.x) * sr.y; u32x2v w; w.x = cvt_pk_bf16(o[0], o[1]); w.y = cvt_pk_bf16(o[2], o[3]);
                        if (bad) { w.x = 0x7fc07fc0u; w.y = 0x7fc07fc0u; } *(u32x2v*)(xn + off + bj * HALF + n * 16) = w; }
                asm volatile("" ::: "memory"); }
    }
};

template <class Epi, class Sched, bool ALIGN_EPI = false, bool SP2 = false, bool GATHER = false>
__device__ __forceinline__ void gemm_phase(PG8_LAS unsigned char* lds, const Gemm g, const Sched& S, const Epi& E, const int tid) {
    const int  wid = __builtin_amdgcn_readfirstlane(tid >> 6), lane = tid & 63, wr = wid >> 2, wc = wid & 3, fr = lane & 15, fq = lane >> 4;
    const int K = g.K, nt = K / BK;
    unsigned voffA[2], voffB[2]; int Rr[2], Cc[2];
#pragma unroll
    for (int i = 0; i < 2; ++i) { int R, C; stage_rc(tid * 16 + i * 8192, R, C); const int Rb = Epi::PERM ? ((R & ~31) + perm32(R & 31)) : R; Rr[i] = R; Cc[i] = C;
        voffA[i] = (unsigned)(R * g.lda + C) * 2u; voffB[i] = (unsigned)(Rb * g.ldb + C) * 2u; }
    unsigned gvC[2][2] = {{0u, 0u}, {0u, 0u}}, gvN[2][2] = {{0u, 0u}, {0u, 0u}};
#define PG8_GV(dst, un) do { _Pragma("unroll") for (int _h = 0; _h < 2; ++_h) _Pragma("unroll") for (int _i = 0; _i < 2; ++_i) { const int _r = (un).pm * BM + _h * HALF + Rr[_i]; \
        dst[_h][_i] = (unsigned)(((_r >> g.g_shift) * g.g_src + g.gidx[_r]) * g.lda + Cc[_i]) * 2u; } } while (0)
#define PG8_STAGE_A(bufoff, gbase, h, usenext) do { if constexpr (GATHER) { _Pragma("unroll") for (int _i = 0; _i < 2; ++_i) { const unsigned _vo = (usenext) ? gvN[h][_i] : gvC[h][_i]; \
        __builtin_amdgcn_global_load_lds((const unsigned*)((const char*)(gbase) + _vo), (PG8_LAS unsigned*)(lds + (bufoff) + ldsw + _i * 8192), 16, 0, 0); } } \
        else { PG8_STAGE(bufoff, (gbase) + (h) * hstepA, voffA); } } while (0)
    const size_t kstep = (size_t)(BK * 2);
    const size_t hstepA = (size_t)HALF * g.lda * 2, hstepB = (size_t)HALF * g.ldb * 2;
    const size_t tstepA = 2 * hstepA, tstepB = 2 * hstepB;
    const unsigned ldsw = (unsigned)wid * 1024u;
    const int aoff = lds_byte(wr * 64 + fr, fq * 8), boff = lds_byte(wc * 32 + fr, fq * 8);
#define PG8_SA(b, h) (((b) * 2 + (h)) * HTB)
#define PG8_SB(b, h) ((4 + (b) * 2 + (h)) * HTB)
#define PG8_STAGE(bufoff, gbase, voff) do { _Pragma("unroll") for (int _i = 0; _i < 2; ++_i) \
        __builtin_amdgcn_global_load_lds((const unsigned*)((const char*)(gbase) + (voff)[_i]), (PG8_LAS unsigned*)(lds + (bufoff) + ldsw + _i * 8192), 16, 0, 0); } while (0)
#define PG8_LDA(dst, b, h) do { _Pragma("unroll") for (int m = 0; m < 4; ++m) _Pragma("unroll") for (int k = 0; k < 2; ++k) dst[m][k] = *(const PG8_LAS bf16x8*)(lds + PG8_SA(b, h) + aoff + m * 2048 + k * 1024); } while (0)
#define PG8_LDB(dst, b, h) do { _Pragma("unroll") for (int n = 0; n < 2; ++n) _Pragma("unroll") for (int k = 0; k < 2; ++k) dst[n][k] = *(const PG8_LAS bf16x8*)(lds + PG8_SB(b, h) + boff + n * 2048 + k * 1024); } while (0)
#define PG8_MMA(ai, bj, At, Bt) do { __builtin_amdgcn_s_setprio(1); _Pragma("unroll") for (int m = 0; m < 4; ++m) _Pragma("unroll") for (int n = 0; n < 2; ++n) _Pragma("unroll") for (int k = 0; k < 2; ++k) \
        acc[ai][bj][m][n] = __builtin_amdgcn_mfma_f32_16x16x32_bf16(Bt[n][k], At[m][k], acc[ai][bj][m][n], 0, 0, 0); __builtin_amdgcn_s_setprio(0); } while (0)
#define PG8_WAIT_V(n) asm volatile("s_waitcnt vmcnt(" #n ")" ::: "memory")
#define PG8_WAIT_L(n) asm volatile("s_waitcnt lgkmcnt(" #n ")" ::: "memory")
#define PG8_BAR __builtin_amdgcn_s_barrier()
#define PG8_SCHED __builtin_amdgcn_sched_barrier(0)
    Unit cur, nxt; int ui = 0;
    if (!S.next(0, cur)) return;
    f32x4 acc[2][2][4][2];
#pragma unroll
    for (int a = 0; a < 2; ++a)
#pragma unroll
        for (int b = 0; b < 2; ++b)
#pragma unroll
            for (int m = 0; m < 4; ++m)
#pragma unroll
                for (int n = 0; n < 2; ++n) acc[a][b][m][n] = (f32x4){0.f, 0.f, 0.f, 0.f};
    bf16x8 At[4][2], B0[2][2], B1[2][2];
    const char* cA = (const char*)g.A + (GATHER ? (size_t)0 : (size_t)cur.pm * tstepA); if constexpr (GATHER) { PG8_GV(gvC, cur); }
    const char* cB = (const char*)g.Bt + (size_t)((cur.pm / g.pm_per_grp) % g.grp_mod) * g.b_grp_bytes + (size_t)cur.pn * tstepB;
    S.a_ready(cur);
    if constexpr (SP2) {
        PG8_STAGE(PG8_SB(0, 0), cB, voffB); PG8_STAGE(PG8_SB(0, 1), cB + hstepB, voffB); PG8_STAGE_A(PG8_SA(0, 0), cA, 0, false); PG8_STAGE_A(PG8_SA(0, 1), cA, 1, false);
        if (wr == 1) PG8_BAR;
        PG8_WAIT_V(2); PG8_BAR;
        PG8_STAGE(PG8_SB(1, 0), cB + kstep, voffB); PG8_STAGE_A(PG8_SA(1, 0), cA + kstep, 0, false); PG8_STAGE(PG8_SB(1, 1), cB + hstepB + kstep, voffB);
        PG8_WAIT_V(6); PG8_BAR;
    } else {
        PG8_STAGE(PG8_SB(0, 0), cB, voffB); PG8_STAGE_A(PG8_SA(0, 0), cA, 0, false); PG8_STAGE(PG8_SB(0, 1), cB + hstepB, voffB); PG8_STAGE_A(PG8_SA(0, 1), cA, 1, false);
        if (wr == 1) PG8_BAR;
        PG8_WAIT_V(4); PG8_BAR;
        PG8_STAGE(PG8_SB(1, 0), cB + kstep, voffB); PG8_STAGE_A(PG8_SA(1, 0), cA + kstep, 0, false); PG8_STAGE(PG8_SB(1, 1), cB + hstepB + kstep, voffB);
        PG8_WAIT_V(6); PG8_BAR;
    }
    for (;;) {
        const bool has_next = S.next(ui + 1, nxt);
        const char* nA = (has_next && !GATHER) ? (const char*)g.A + (size_t)nxt.pm * tstepA : cA;
        if constexpr (GATHER) { if (has_next) { PG8_GV(gvN, nxt); } else { _Pragma("unroll") for (int _h = 0; _h < 2; ++_h) _Pragma("unroll") for (int _i = 0; _i < 2; ++_i) gvN[_h][_i] = gvC[_h][_i]; } }
        const char* nB = has_next ? (const char*)g.Bt + (size_t)((nxt.pm / g.pm_per_grp) % g.grp_mod) * g.b_grp_bytes + (size_t)nxt.pn * tstepB : cB;
        for (int t = 0; t < nt; t += 2) {
            if constexpr (Epi::HAS_MID) { if (t == nt / 2) E.mid(acc, cur, wr, wc, fr, fq); }
            const bool last = (t == nt - 2);
            const char* a1 = cA + (size_t)(t + 1) * kstep;
            const char* a2 = last ? nA : cA + (size_t)(t + 2) * kstep; const char* b2 = last ? nB : cB + (size_t)(t + 2) * kstep;
            const char* a3 = a2 + kstep; const char* b3 = b2 + kstep;
            if (last && has_next) S.a_ready(nxt);
            if constexpr (SP2) {
            PG8_LDB(B0, 0, 0); PG8_LDB(B1, 0, 1); PG8_SCHED; PG8_LDA(At, 0, 0); PG8_STAGE_A(PG8_SA(1, 1), a1, 1, false);
            PG8_WAIT_V(8); PG8_WAIT_L(0); PG8_BAR; PG8_MMA(0, 0, At, B0); PG8_MMA(0, 1, At, B1); PG8_BAR; PG8_SCHED;
            PG8_LDA(At, 0, 1); PG8_STAGE(PG8_SB(0, 0), b2, voffB); PG8_STAGE(PG8_SB(0, 1), b2 + hstepB, voffB); PG8_STAGE_A(PG8_SA(0, 0), a2, 0, last);
            PG8_WAIT_V(8); PG8_WAIT_L(0); PG8_BAR; PG8_MMA(1, 0, At, B0); PG8_MMA(1, 1, At, B1); PG8_BAR; PG8_SCHED;
            PG8_LDB(B0, 1, 0); PG8_LDB(B1, 1, 1); PG8_SCHED; PG8_LDA(At, 1, 0); PG8_STAGE_A(PG8_SA(0, 1), a2, 1, last);
            PG8_WAIT_V(8); PG8_WAIT_L(0); PG8_BAR; PG8_MMA(0, 0, At, B0); PG8_MMA(0, 1, At, B1); PG8_BAR; PG8_SCHED;
            PG8_LDA(At, 1, 1); PG8_STAGE(PG8_SB(1, 0), b3, voffB); PG8_STAGE(PG8_SB(1, 1), b3 + hstepB, voffB); PG8_STAGE_A(PG8_SA(1, 0), a3, 0, last);
            PG8_WAIT_V(8); PG8_WAIT_L(0); PG8_BAR; PG8_MMA(1, 0, At, B0); PG8_MMA(1, 1, At, B1); PG8_BAR; PG8_SCHED;
            } else {
            PG8_LDB(B0, 0, 0); PG8_SCHED; PG8_LDA(At, 0, 0); PG8_STAGE_A(PG8_SA(1, 1), a1, 1, false);
            PG8_WAIT_L(8); PG8_BAR; PG8_WAIT_L(0); PG8_MMA(0, 0, At, B0); PG8_BAR; PG8_SCHED;
            PG8_LDB(B1, 0, 1); PG8_STAGE(PG8_SB(0, 0), b2, voffB);
            PG8_BAR; PG8_WAIT_L(0); PG8_MMA(0, 1, At, B1); PG8_BAR;
            PG8_LDA(At, 0, 1); PG8_STAGE_A(PG8_SA(0, 0), a2, 0, last);
            PG8_BAR; PG8_WAIT_L(0); PG8_MMA(1, 0, At, B0); PG8_BAR; PG8_SCHED;
            PG8_STAGE(PG8_SB(0, 1), b2 + hstepB, voffB);
            PG8_WAIT_V(6); PG8_BAR; PG8_MMA(1, 1, At, B1); PG8_BAR;
            PG8_LDB(B0, 1, 0); PG8_SCHED; PG8_LDA(At, 1, 0); PG8_STAGE_A(PG8_SA(0, 1), a2, 1, last);
            PG8_WAIT_L(8); PG8_BAR; PG8_WAIT_L(0); PG8_MMA(0, 0, At, B0); PG8_BAR; PG8_SCHED;
            PG8_LDB(B1, 1, 1); PG8_STAGE(PG8_SB(1, 0), b3, voffB);
            PG8_BAR; PG8_WAIT_L(0); PG8_MMA(0, 1, At, B1); PG8_BAR;
            PG8_LDA(At, 1, 1); PG8_STAGE_A(PG8_SA(1, 0), a3, 0, last);
            PG8_BAR; PG8_WAIT_L(0); PG8_MMA(1, 0, At, B0); PG8_BAR; PG8_SCHED;
            PG8_STAGE(PG8_SB(1, 1), b3 + hstepB, voffB);
            PG8_WAIT_V(6); PG8_BAR; PG8_MMA(1, 1, At, B1); PG8_BAR;
            }
        }
        if constexpr (ALIGN_EPI) { if (wr == 0) PG8_BAR; }
        if constexpr (!Epi::AFTER_DRAIN) { E(acc, cur, wr, wc, fr, fq); S.done(cur); }
        if (!has_next) break;
#pragma unroll
        for (int a = 0; a < 2; ++a)
#pragma unroll
            for (int b = 0; b < 2; ++b)
#pragma unroll
                for (int m = 0; m < 4; ++m)
#pragma unroll
                    for (int n = 0; n < 2; ++n) acc[a][b][m][n] = (f32x4){0.f, 0.f, 0.f, 0.f};
        cur = nxt; cA = nA; cB = nB; ++ui;
        if constexpr (GATHER) { _Pragma("unroll") for (int _h = 0; _h < 2; ++_h) _Pragma("unroll") for (int _i = 0; _i < 2; ++_i) gvC[_h][_i] = gvN[_h][_i]; }
        if constexpr (ALIGN_EPI) { if (wr == 1) PG8_BAR; }
    }
    PG8_WAIT_V(0);
    if constexpr (!ALIGN_EPI) { if (wr == 0) PG8_BAR; }
    PG8_BAR;
    if constexpr (Epi::AFTER_DRAIN) { E.fused(acc, cur, wr, wc, fr, fq, lds, wid, lane); S.done(cur); }
#undef PG8_SA
#undef PG8_SB
#undef PG8_STAGE
#undef PG8_STAGE_A
#undef PG8_GV
#undef PG8_LDA
#undef PG8_LDB
#undef PG8_MMA
#undef PG8_WAIT_V
#undef PG8_WAIT_L
#undef PG8_BAR
#undef PG8_SCHED
}
}

namespace epi {
using pg8::f32x4; using pg8::u32x4; using pg8::Unit; using pg8::bf16_t; using pg8::cvt_pk_bf16; using pg8::HALF; using pg8::BM;
typedef unsigned u32x2 __attribute__((ext_vector_type(2)));

struct EpiIn {
    static constexpr bool PERM = false, AFTER_DRAIN = false; static constexpr bool HAS_MID = false;
    bf16_t* cq; bf16_t* ckv; float* krr; bf16_t* hyT; float* ssq_q; float* ssq_kv; PG8_LAS unsigned char* stg;
    __device__ __forceinline__ void operator()(const f32x4 (&acc)[2][2][4][2], const Unit& u, int wr, int wc, int fr, int fq) const {
        PG8_LAS unsigned char* ws_ = stg + (wr * 4 + wc) * 2304; const int lane = fr + 16 * fq;
#pragma unroll
        for (int ai = 0; ai < 2; ++ai)
#pragma unroll
            for (int bj = 0; bj < 2; ++bj)
#pragma unroll
                for (int n = 0; n < 2; ++n) {
                    const int cg = u.pn * BM + bj * HALF + wc * 32 + n * 16;
                    if (cg >= 416 && cg < IN_COLS) {
#pragma unroll
                        for (int m = 0; m < 4; ++m) { const f32x4 v = acc[ai][bj][m][n]; const unsigned w0 = cvt_pk_bf16(v[0], v[1]), w1 = cvt_pk_bf16(v[2], v[3]);
                            PG8_LAS unsigned char* p = ws_ + (4 * fq) * 144 + (16 * m + fr) * 2;
                            *(PG8_LAS unsigned short*)(p) = (unsigned short)(w0 & 0xffffu); *(PG8_LAS unsigned short*)(p + 144) = (unsigned short)(w0 >> 16);
                            *(PG8_LAS unsigned short*)(p + 288) = (unsigned short)(w1 & 0xffffu); *(PG8_LAS unsigned short*)(p + 432) = (unsigned short)(w1 >> 16); }
                        asm volatile("s_waitcnt lgkmcnt(0)" ::: "memory");
                        const int rowbase = u.pm * BM + ai * HALF + wr * 64;
#pragma unroll
                        for (int h = 0; h < 2; ++h) { const int pc = lane + 64 * h, col = pc >> 3, oct = pc & 7;
                            const u32x4 w = *(const PG8_LAS u32x4*)(ws_ + col * 144 + oct * 16);
                            *(u32x4*)(hyT + (size_t)(cg - 416 + col) * T + rowbase + oct * 8) = w; }
                        asm volatile("s_waitcnt lgkmcnt(0)" ::: "memory");
                    }
                }
#pragma unroll
        for (int ai = 0; ai < 2; ++ai)
#pragma unroll
            for (int m = 0; m < 4; ++m) {
                const int rowp = u.pm * BM + ai * HALF + wr * 64 + m * 16 + fr;
                const int row = (rowp & 1) * SEQ + (rowp >> 1);
                float sq = 0.f, skv = 0.f;
#pragma unroll
                for (int bj = 0; bj < 2; ++bj)
#pragma unroll
                    for (int n = 0; n < 2; ++n) {
                        const int c0 = u.pn * BM + bj * HALF + wc * 32 + n * 16 + 4 * fq;
                        const f32x4 v = acc[ai][bj][m][n];
                        if (c0 < 256) {
                            u32x2 w; w.x = cvt_pk_bf16(v[0], v[1]); w.y = cvt_pk_bf16(v[2], v[3]);
                            *(u32x2*)(cq + (size_t)row * 256 + c0) = w;
                            sq += (v[0] * v[0] + v[1] * v[1]) + (v[2] * v[2] + v[3] * v[3]);
                        } else if (c0 < 384) {
                            u32x2 w; w.x = cvt_pk_bf16(v[0], v[1]); w.y = cvt_pk_bf16(v[2], v[3]);
                            *(u32x2*)(ckv + (size_t)row * 128 + (c0 - 256)) = w;
                            skv += (v[0] * v[0] + v[1] * v[1]) + (v[2] * v[2] + v[3] * v[3]);
                        } else if (c0 < 416) {
                            *(f32x4*)(krr + (size_t)row * 32 + (c0 - 384)) = v;
                        }
                    }
                if (u.pn == 0) { sq += __shfl_xor(sq, 16); sq += __shfl_xor(sq, 32); if (fq == 0) ssq_q[row * 4 + wc] = sq; }
                if (u.pn == 1) { skv += __shfl_xor(skv, 16); skv += __shfl_xor(skv, 32); if (fq == 0) ssq_kv[row * 4 + wc] = skv; }
            }
    }
};

struct EpiRowScale {
    static constexpr bool PERM = true, AFTER_DRAIN = false; static constexpr bool HAS_MID = false;
    bf16_t* O; int ldc; const float* ssq; float inv_n; float post;
    __device__ __forceinline__ void operator()(const f32x4 (&acc)[2][2][4][2], const Unit& u, int wr, int wc, int fr, int fq) const {
        const int col0 = u.pn * BM + wc * 32 + 8 * fq;
#pragma unroll
        for (int ai = 0; ai < 2; ++ai)
#pragma unroll
            for (int m = 0; m < 4; ++m) {
                const int row = u.pm * BM + ai * HALF + wr * 64 + m * 16 + fr;
                float s = 1.f; if (ssq) { const f32x4 pp = *(const f32x4*)(ssq + (size_t)row * 4); s = __builtin_amdgcn_rsqf(((pp[0] + pp[1]) + (pp[2] + pp[3])) * inv_n + EPS) * post; }
#pragma unroll
                for (int bj = 0; bj < 2; ++bj) {
                    const f32x4 v0 = acc[ai][bj][m][0] * s, v1 = acc[ai][bj][m][1] * s;
                    u32x4 w; w.x = cvt_pk_bf16(v0[0], v0[1]); w.y = cvt_pk_bf16(v0[2], v0[3]); w.z = cvt_pk_bf16(v1[0], v1[1]); w.w = cvt_pk_bf16(v1[2], v1[3]);
                    *(u32x4*)(O + (size_t)row * ldc + col0 + bj * HALF) = w;
                }
            }
    }
};

struct EpiOut {
    static constexpr bool PERM = true, AFTER_DRAIN = false, HAS_MID = true;
    bf16_t* O; int ldc; const float* ssq8;
    __device__ __forceinline__ void mid(f32x4 (&acc)[2][2][4][2], const Unit& u, int wr, int wc, int fr, int fq) const {
#pragma unroll
        for (int ai = 0; ai < 2; ++ai)
#pragma unroll
            for (int m = 0; m < 4; ++m) {
                const int row = u.pm * BM + ai * HALF + wr * 64 + m * 16 + fr;
                const f32x4 p0 = *(const f32x4*)(ssq8 + (size_t)row * 8), p1 = *(const f32x4*)(ssq8 + (size_t)row * 8 + 4);
                const float s = __builtin_amdgcn_rsqf((((p0[0] + p0[1]) + (p0[2] + p0[3])) + ((p1[0] + p1[1]) + (p1[2] + p1[3]))) * (1.0f / 512.0f) + EPS);
#pragma unroll
                for (int bj = 0; bj < 2; ++bj)
#pragma unroll
                    for (int n = 0; n < 2; ++n) acc[ai][bj][m][n] = acc[ai][bj][m][n] * s;
            }
    }
    __device__ __forceinline__ void operator()(const f32x4 (&acc)[2][2][4][2], const Unit& u, int wr, int wc, int fr, int fq) const {
        const int col0 = u.pn * BM + wc * 32 + 8 * fq;
#pragma unroll
        for (int ai = 0; ai < 2; ++ai)
#pragma unroll
            for (int m = 0; m < 4; ++m) {
                const int row = u.pm * BM + ai * HALF + wr * 64 + m * 16 + fr;
#pragma unroll
                for (int bj = 0; bj < 2; ++bj) {
                    const f32x4 v0 = acc[ai][bj][m][0], v1 = acc[ai][bj][m][1];
                    u32x4 w; w.x = cvt_pk_bf16(v0[0], v0[1]); w.y = cvt_pk_bf16(v0[2], v0[3]); w.z = cvt_pk_bf16(v1[0], v1[1]); w.w = cvt_pk_bf16(v1[2], v1[3]);
                    *(u32x4*)(O + (size_t)row * ldc + col0 + bj * HALF) = w;
                }
            }
    }
};

struct EpiFilt {
    static constexpr bool PERM = false, AFTER_DRAIN = false; static constexpr bool HAS_MID = false;
    unsigned* kT2; const float* b3; const float* decay;
    __device__ __forceinline__ void operator()(const f32x4 (&acc)[2][2][4][2], const Unit& u, int wr, int wc, int fr, int fq) const {
        typedef float f32x2 __attribute__((ext_vector_type(2)));
#pragma unroll
        for (int bj = 0; bj < 2; ++bj)
#pragma unroll
            for (int n = 0; n < 2; ++n) {
                const int c0 = u.pn * BM + bj * HALF + wc * 32 + n * 16 + 4 * fq;
                const int dir = c0 >> 10, cp = (c0 & 1023) >> 1;
                const f32x2 b_o0 = *(const f32x2*)(b3 + dir * 1024 + cp), b_o1 = *(const f32x2*)(b3 + dir * 1024 + 512 + cp);
                const f32x2 d_o0 = *(const f32x2*)(decay + dir * 1024 + cp), d_o1 = *(const f32x2*)(decay + dir * 1024 + 512 + cp);
                const float bb[4] = {b_o0.x, b_o1.x, b_o0.y, b_o1.y}; const float dd[4] = {fabsf(d_o0.x), fabsf(d_o1.x), fabsf(d_o0.y), fabsf(d_o1.y)};
#pragma unroll
                for (int ai = 0; ai < 2; ++ai)
#pragma unroll
                    for (int m = 0; m < 4; ++m) {
                        const int row = u.pm * BM + ai * HALF + wr * 64 + m * 16 + fr;
                        const float tl = (float)row * (1.0f / (float)(SEQ - 1));
                        const f32x4 v = acc[ai][bj][m][n];
                        float val[4];
#pragma unroll
                        for (int j = 0; j < 4; ++j) val[j] = (v[j] + bb[j]) * __expf(-tl * dd[j]);
                        kT2[(size_t)(dir * 512 + cp) * SEQ + row] = cvt_pk_bf16(val[0], val[1]);
                        kT2[(size_t)(dir * 512 + cp + 1) * SEQ + row] = cvt_pk_bf16(val[2], val[3]);
                    }
            }
    }
};

struct EpiGU {
    static constexpr bool PERM = true, AFTER_DRAIN = false; static constexpr bool HAS_MID = false;
    bf16_t* H;
    __device__ __forceinline__ void operator()(const f32x4 (&acc)[2][2][4][2], const Unit& u, int wr, int wc, int fr, int fq) const {
        const int col0 = u.pn * BM + wc * 32 + 8 * fq;
#pragma unroll
        for (int ai = 0; ai < 2; ++ai)
#pragma unroll
            for (int m = 0; m < 4; ++m) {
                const int row = u.pm * BM + ai * HALF + wr * 64 + m * 16 + fr;
#pragma unroll
                for (int bj = 0; bj < 2; ++bj) {
                    const f32x4 v0 = acc[ai][bj][m][0], v1 = acc[ai][bj][m][1];
                    float h[4];
                    { const float g = v0[0], up = v0[1]; h[0] = g * __builtin_amdgcn_rcpf(1.f + __expf(-g)) * up; }
                    { const float g = v0[2], up = v0[3]; h[1] = g * __builtin_amdgcn_rcpf(1.f + __expf(-g)) * up; }
                    { const float g = v1[0], up = v1[1]; h[2] = g * __builtin_amdgcn_rcpf(1.f + __expf(-g)) * up; }
                    { const float g = v1[2], up = v1[3]; h[3] = g * __builtin_amdgcn_rcpf(1.f + __expf(-g)) * up; }
                    u32x2 w; w.x = cvt_pk_bf16(h[0], h[1]); w.y = cvt_pk_bf16(h[2], h[3]);
                    *(u32x2*)(H + (size_t)row * EFF + ((col0 + bj * HALF) >> 1)) = w;
                }
            }
    }
};

struct EpiDown {
    static constexpr bool PERM = true, AFTER_DRAIN = false; static constexpr bool HAS_MID = false;
    bf16_t* O; const float* gate;
    __device__ __forceinline__ void operator()(const f32x4 (&acc)[2][2][4][2], const Unit& u, int wr, int wc, int fr, int fq) const {
        const int col0 = u.pn * BM + wc * 32 + 8 * fq;
#pragma unroll
        for (int ai = 0; ai < 2; ++ai)
#pragma unroll
            for (int m = 0; m < 4; ++m) {
                const int row = u.pm * BM + ai * HALF + wr * 64 + m * 16 + fr;
                const float s = gate[row];
#pragma unroll
                for (int bj = 0; bj < 2; ++bj) {
                    const f32x4 v0 = acc[ai][bj][m][0] * s, v1 = acc[ai][bj][m][1] * s;
                    u32x4 w; w.x = cvt_pk_bf16(v0[0], v0[1]); w.y = cvt_pk_bf16(v0[2], v0[3]); w.z = cvt_pk_bf16(v1[0], v1[1]); w.w = cvt_pk_bf16(v1[2], v1[3]);
                    *(u32x4*)(O + (size_t)row * DM + col0 + bj * HALF) = w;
                }
            }
    }
};
}

namespace attn {
using bf16x8 = __attribute__((ext_vector_type(8))) short;
using s16x4  = __attribute__((ext_vector_type(4))) short;
using f32x16 = __attribute__((ext_vector_type(16))) float;
using f32x8  = __attribute__((ext_vector_type(8))) float;
using u32x4  = __attribute__((ext_vector_type(4))) unsigned;
typedef unsigned short bf16_t;
constexpr int NW = 8, QBLK = 32, KVBLK = 64;
constexpr float SCALE = 0.10206207261596575f;
constexpr float THR = 8.f;
constexpr int LDQ = NH * QKD;
constexpr int LDKV = NH * 128;
constexpr int LDO = NH * VD;
constexpr int SHM_V = KVBLK * 128 * 2, SHM_K = KVBLK * 128 * 2;
constexpr int SHM_ATTN = 2 * SHM_V + 2 * SHM_K + NW * 64 * 4;
#define KSWZ(row, colB) ((row) * 256 + ((colB) ^ (((row) & 7) << 4)))
#define SBAR() __builtin_amdgcn_sched_barrier(0)
__device__ __forceinline__ int crow(int r, int hi) { return (r & 3) + 8 * (r >> 2) + 4 * hi; }
__device__ __forceinline__ unsigned cvtpk(float lo, float hi) { unsigned r; asm volatile("v_cvt_pk_bf16_f32 %0, %1, %2" : "=v"(r) : "v"(lo), "v"(hi)); return r; }
__device__ __forceinline__ float bf2f(short s) { return __uint_as_float(((unsigned)(unsigned short)s) << 16); }

__device__ __forceinline__ void partialSM(f32x16& p0, f32x16& p1, float& m_reg, float& mn, float& alpha) {
  constexpr float C = SCALE * 1.4426950408889634f;
  float pmax = p0[0]; for (int r = 1; r < 16; ++r) pmax = fmaxf(pmax, p0[r]); for (int r = 0; r < 16; ++r) pmax = fmaxf(pmax, p1[r]);
  { auto rr = __builtin_amdgcn_permlane32_swap(__float_as_uint(pmax), __float_as_uint(pmax), false, false);
    pmax = fmaxf(__uint_as_float(rr[0]), __uint_as_float(rr[1])); }
  if (__builtin_expect(__all(pmax - m_reg <= THR / SCALE), 1)) { mn = m_reg; alpha = 1.f; }
  else { mn = fmaxf(m_reg, pmax); alpha = __builtin_amdgcn_exp2f((m_reg - mn) * C); m_reg = mn; }
  float mnC = -mn * C;
  for (int r = 0; r < 16; ++r) p0[r] = fmaf(p0[r], C, mnC); for (int r = 0; r < 16; ++r) p1[r] = fmaf(p1[r], C, mnC);
  for (int r = 0; r < 16; ++r) p0[r] = __builtin_amdgcn_exp2f(p0[r]);
}
__device__ __forceinline__ void finishSM(f32x16& p0, f32x16& p1, float alpha, float& l_reg, bf16x8& pa0, bf16x8& pa1, bf16x8& pa2, bf16x8& pa3) {
  for (int r = 0; r < 16; ++r) p1[r] = __builtin_amdgcn_exp2f(p1[r]);
  float ps = 0; for (int r = 0; r < 16; ++r) ps += p0[r]; for (int r = 0; r < 16; ++r) ps += p1[r];
  { auto rr = __builtin_amdgcn_permlane32_swap(__float_as_uint(ps), __float_as_uint(ps), false, false);
    ps = __uint_as_float(rr[0]) + __uint_as_float(rr[1]); }
  l_reg = l_reg * alpha + ps;
#define PK4(P, BASE, OUT) do { unsigned a0 = cvtpk(P[BASE + 0], P[BASE + 1]), a1 = cvtpk(P[BASE + 2], P[BASE + 3]);   \
    unsigned b0 = cvtpk(P[BASE + 4], P[BASE + 5]), b1 = cvtpk(P[BASE + 6], P[BASE + 7]);                              \
    auto r0 = __builtin_amdgcn_permlane32_swap(a0, b0, false, false); auto r1 = __builtin_amdgcn_permlane32_swap(a1, b1, false, false); \
    u32x4 w = {r0[0], r1[0], r0[1], r1[1]}; OUT = *reinterpret_cast<bf16x8*>(&w); } while (0)
  PK4(p0, 0, pa0); PK4(p0, 8, pa1); PK4(p1, 0, pa2); PK4(p1, 8, pa3);
#undef PK4
}
__device__ __forceinline__ void qkt(f32x16& p0, f32x16& p1, const bf16_t* Ks, const bf16x8* qr, int r32, int hi) {
  p0 = f32x16{}; p1 = f32x16{};
#pragma unroll
  for (int d0 = 0; d0 < 6; ++d0) { int cb = (d0 * 16 + hi * 8) * 2;
    bf16x8 b0 = *reinterpret_cast<const bf16x8*>((const char*)Ks + KSWZ(r32, cb));
    bf16x8 b1 = *reinterpret_cast<const bf16x8*>((const char*)Ks + KSWZ(32 + r32, cb));
    p0 = __builtin_amdgcn_mfma_f32_32x32x16_bf16(b0, qr[d0], p0, 0, 0, 0);
    p1 = __builtin_amdgcn_mfma_f32_32x32x16_bf16(b1, qr[d0], p1, 0, 0, 0); }
}
__device__ __forceinline__ int v_st(int k, int c) { const int kk = (k & ~0xC) | ((k & 4) << 1) | ((k & 8) >> 1); return ((kk >> 3) * 4 + (c >> 5)) * 512 + ((kk & 7) * 32 + (c & 31)) * 2; }
__device__ __forceinline__ int v_rd_base(int lane) { return ((lane & 3) << 3) | (((lane >> 2) & 3) << 6) | (((lane >> 4) & 1) << 5) | (((lane >> 5) & 1) << 8); }
constexpr int v_rd_off(int d0, int ks, int half) { return d0 * 512 + ks * 4096 + half * 2048; }
template <int OFF> __device__ __forceinline__ s16x4 tr_read(int vb) {
  s16x4 r; asm volatile("ds_read_b64_tr_b16 %0, %1 offset:%2" : "=&v"(r) : "v"(vb), "i"(OFF) : "memory"); return r;
}
template <int D0> __device__ __forceinline__ void pv_one(f32x16& od, int vb, bf16x8 pa0, bf16x8 pa1, bf16x8 pa2, bf16x8 pa3) {
  const s16x4 l0 = tr_read<v_rd_off(D0, 0, 0)>(vb), h0 = tr_read<v_rd_off(D0, 0, 1)>(vb), l1 = tr_read<v_rd_off(D0, 1, 0)>(vb), h1 = tr_read<v_rd_off(D0, 1, 1)>(vb);
  const s16x4 l2 = tr_read<v_rd_off(D0, 2, 0)>(vb), h2 = tr_read<v_rd_off(D0, 2, 1)>(vb), l3 = tr_read<v_rd_off(D0, 3, 0)>(vb), h3 = tr_read<v_rd_off(D0, 3, 1)>(vb);
  asm volatile("s_waitcnt lgkmcnt(0)" ::: "memory"); SBAR();
#define PK(L, H) (bf16x8){L[0], L[1], L[2], L[3], H[0], H[1], H[2], H[3]}
  od = __builtin_amdgcn_mfma_f32_32x32x16_bf16(pa0, PK(l0, h0), od, 0, 0, 0);
  od = __builtin_amdgcn_mfma_f32_32x32x16_bf16(pa1, PK(l1, h1), od, 0, 0, 0);
  od = __builtin_amdgcn_mfma_f32_32x32x16_bf16(pa2, PK(l2, h2), od, 0, 0, 0);
  od = __builtin_amdgcn_mfma_f32_32x32x16_bf16(pa3, PK(l3, h3), od, 0, 0, 0);
#undef PK
}
__device__ __forceinline__ void pv_d0(f32x16* o, int vb, bf16x8 pa0, bf16x8 pa1, bf16x8 pa2, bf16x8 pa3) {
  pv_one<0>(o[0], vb, pa0, pa1, pa2, pa3); pv_one<1>(o[1], vb, pa0, pa1, pa2, pa3);
}

__device__ __forceinline__ void attn_unit(const bf16_t* __restrict__ Q, const bf16_t* __restrict__ KV, const bf16_t* __restrict__ KR, const float* __restrict__ CS,
                                          bf16_t* __restrict__ O, int h, long tq0, long tk0, int seq, char* lds, const int tid) {
  const int wid = tid >> 6, lane = tid & 63, r32 = lane & 31, hi = lane >> 5;
  bf16_t* V_lds = (bf16_t*)lds; bf16_t* K_lds = (bf16_t*)(lds + 2 * SHM_V);
  float* ws = (float*)(lds + 2 * SHM_V + 2 * SHM_K) + wid * 64; float* li_l = ws; float* al_l = ws + 32;
  float m_reg = -1e30f, l_reg = 0; f32x16 o[2] = {}; bf16x8 qr[6];
  { const long trow = tq0 + wid * QBLK + r32;
    const bf16_t* Qw = Q + trow * LDQ + h * QKD + hi * 8;
#pragma unroll
    for (int d0 = 0; d0 < 6; ++d0) qr[d0] = *reinterpret_cast<const bf16x8*>(Qw + d0 * 16);
    const float* cs = CS + trow * 32 + hi * 16;
    bf16x8 q4 = qr[4], q5 = qr[5];
    unsigned w4[4], w5[4];
#pragma unroll
    for (int jj = 0; jj < 4; ++jj) {
      const float4 c2 = *reinterpret_cast<const float4*>(cs + jj * 4);
      const float a0 = bf2f(q4[2 * jj]), b0 = bf2f(q5[2 * jj]), a1 = bf2f(q4[2 * jj + 1]), b1 = bf2f(q5[2 * jj + 1]);
      w4[jj] = cvtpk(a0 * c2.x - b0 * c2.y, a1 * c2.z - b1 * c2.w);
      w5[jj] = cvtpk(b0 * c2.x + a0 * c2.y, b1 * c2.z + a1 * c2.w);
    }
    u32x4 W4 = {w4[0], w4[1], w4[2], w4[3]}, W5 = {w5[0], w5[1], w5[2], w5[3]};
    qr[4] = *reinterpret_cast<bf16x8*>(&W4); qr[5] = *reinterpret_cast<bf16x8*>(&W5);
  }
  const int sr = tid >> 3, sc = (tid & 7) * 8, vst0 = v_st(sr, sc);
  const int rr = (tid & 255) >> 2, rc = (tid & 3) * 8;
  const bool rope_w = tid < 256;
  const bf16_t* Vg = KV + (tk0 + sr) * LDKV + h * 128 + 64 + sc;
  const bf16_t* Kg = KV + (tk0 + sr) * LDKV + h * 128 + sc;
  const bf16_t* Rg = KR + (tk0 + rr) * 32 + rc;
  const int vb0 = (int)(uintptr_t)V_lds + v_rd_base(lane);
  struct { bf16x8 vs, ks, rs; } sr_[2];
#define SLOAD(i, k0) do { sr_[i].vs = *reinterpret_cast<const bf16x8*>(Vg + (long)(k0) * LDKV); sr_[i].ks = *reinterpret_cast<const bf16x8*>(Kg + (long)(k0) * LDKV); \
    sr_[i].rs = *reinterpret_cast<const bf16x8*>(Rg + (long)(k0) * 32); } while (0)
#define SWRITE(b, i) do { *(bf16x8*)((char*)V_lds + (b) * SHM_V + vst0) = sr_[i].vs;          \
    *(bf16x8*)((char*)K_lds + (b) * SHM_K + KSWZ(sr, sc * 2)) = sr_[i].ks;                       \
    if (rope_w) *(bf16x8*)((char*)K_lds + (b) * SHM_K + KSWZ(rr, (64 + rc) * 2)) = sr_[i].rs; } while (0)
#define SWAIT() asm volatile("s_waitcnt vmcnt(3)" ::: "memory")
#define RESC(a) do { if (__any((a) < 1.f)) { if (hi == 0) al_l[r32] = (a); asm volatile("s_waitcnt lgkmcnt(0)" ::: "memory"); \
    for (int d = 0; d < 2; ++d) for (int r = 0; r < 16; ++r) o[d][r] *= al_l[crow(r, hi)]; } } while (0)
  f32x16 pA0, pA1, pB0, pB1; float mnA, mnB, alA, alB; bf16x8 pa0, pa1, pa2, pa3; const int NT = seq / KVBLK;
  constexpr int SE = 0, SO = 1;
  SLOAD(SE, 0); asm volatile("s_waitcnt vmcnt(0)" ::: "memory"); SWRITE(0, SE); __syncthreads();
  qkt(pA0, pA1, K_lds, qr, r32, hi); partialSM(pA0, pA1, m_reg, mnA, alA);
  SLOAD(SO, KVBLK); if (2 < NT) SLOAD(SE, 2 * KVBLK);
  SWAIT(); SWRITE(1, SO); __syncthreads();
  for (int j = 1; j + 1 < NT; j += 2) {
    SBAR(); qkt(pB0, pB1, (bf16_t*)((char*)K_lds + SHM_K), qr, r32, hi);
    finishSM(pA0, pA1, alA, l_reg, pa0, pa1, pa2, pa3); SBAR();
    SLOAD(SO, (j + 2) * KVBLK); SBAR();
    pv_d0(o, vb0, pa0, pa1, pa2, pa3); partialSM(pB0, pB1, m_reg, mnB, alB);
    __syncthreads(); SWAIT(); SWRITE(0, SE);
    RESC(alB); __syncthreads();
    SBAR(); qkt(pA0, pA1, K_lds, qr, r32, hi);
    finishSM(pB0, pB1, alB, l_reg, pa0, pa1, pa2, pa3); SBAR();
    if (j + 3 < NT) SLOAD(SE, (j + 3) * KVBLK); SBAR();
    pv_d0(o, vb0 + (int)SHM_V, pa0, pa1, pa2, pa3); partialSM(pA0, pA1, m_reg, mnA, alA);
    __syncthreads(); SWAIT(); SWRITE(1, SO);
    RESC(alA); __syncthreads();
  }
  SBAR(); qkt(pB0, pB1, (bf16_t*)((char*)K_lds + SHM_K), qr, r32, hi);
  finishSM(pA0, pA1, alA, l_reg, pa0, pa1, pa2, pa3); SBAR();
  pv_d0(o, vb0, pa0, pa1, pa2, pa3); partialSM(pB0, pB1, m_reg, mnB, alB);
  __syncthreads(); RESC(alB);
  finishSM(pB0, pB1, alB, l_reg, pa0, pa1, pa2, pa3); SBAR();
  pv_d0(o, vb0 + (int)SHM_V, pa0, pa1, pa2, pa3);
  if (hi == 0) li_l[r32] = l_reg; asm volatile("s_waitcnt lgkmcnt(0)" ::: "memory");
  float rli[16];
#pragma unroll
  for (int r = 0; r < 16; ++r) rli[r] = __builtin_amdgcn_rcpf(li_l[crow(r, hi)]);
  bf16_t* Ow = O + (tq0 + wid * QBLK) * LDO + h * VD;
#pragma unroll
  for (int r = 0; r < 16; ++r) { int orow = crow(r, hi);
#pragma unroll
    for (int d0 = 0; d0 < 2; ++d0) Ow[(long)orow * LDO + d0 * 32 + r32] = (bf16_t)(cvtpk(o[d0][r] * rli[r], 0.f) & 0xffffu); }
  __syncthreads();
#undef SLOAD
#undef SWRITE
#undef SWAIT
#undef RESC
}
#undef KSWZ
#undef SBAR
}

namespace attn2 {
using bf16=__hip_bfloat16;
using bf16x8=__attribute__((ext_vector_type(8)))short;
using s16x4=__attribute__((ext_vector_type(4)))short;
using f32x16=__attribute__((ext_vector_type(16)))float;
using u32x4=__attribute__((ext_vector_type(4)))unsigned;
constexpr int NHEAD=8,DQK=96,DV=64,PQ=NHEAD*DQK  ,PKV=NHEAD*128  ,PKR=32  ,PO=2*NHEAD*DV  ;
constexpr int NW=8,QBLK=32,QB=QBLK*NW,KVBLK=64,NQB=SEQ/QB;
constexpr int ATTN_UNIT_ROWS=QB;
__device__ __forceinline__ int crow(int r,int hi){return (r&3)+8*(r>>2)+4*hi;}
#define SBAR() __builtin_amdgcn_sched_barrier(0)
__device__ __forceinline__ void cmask(f32x16&p0,f32x16&p1,int jb,int qrel,int hi){
  const float NEG=-INFINITY; int kb=64*jb+4*hi;
  #pragma unroll
  for(int r=0;r<16;++r){int kv=kb+(r&3)+8*(r>>2); if(kv>qrel)p0[r]=NEG; if(kv+32>qrel)p1[r]=NEG;}
}

constexpr int NSLOT=3, SLOTK=8192, SLOTR=4096, SLOTV=8192;
constexpr int LDS_K=0, LDS_V=NSLOT*SLOTK, LDS_R=LDS_V+NSLOT*SLOTV, LDS_WS=LDS_R+NSLOT*SLOTR, LDS_OST=LDS_WS+NW*64*4, LDS_BYTES=LDS_OST+NW*4096;
constexpr float C2=0.10206207261596575f*1.4426950408889634f;
__device__ __forceinline__ void glds16(const void*gsrc,unsigned lds_dst){
  asm volatile("s_mov_b32 m0, %1\n\ts_nop 0\n\tglobal_load_lds_dwordx4 %0, off"::"v"(gsrc),"s"(lds_dst):"memory");}
__device__ __forceinline__ float max3f(float a,float b,float c){float r;asm("v_max3_f32 %0, %1, %2, %3":"=v"(r):"v"(a),"v"(b),"v"(c));return r;}
__device__ __forceinline__ float max2f(float a,float b){float r;asm("v_max_f32_e32 %0, %1, %2":"=v"(r):"v"(a),"v"(b));return r;}
__device__ __forceinline__ float fadd_s(float a,float b){float r;asm("v_add_f32_e32 %0, %1, %2":"=v"(r):"v"(a),"v"(b));return r;}
__device__ __forceinline__ float fsub_s(float a,float b){float r;asm("v_sub_f32_e32 %0, %1, %2":"=v"(r):"v"(a),"v"(b));return r;}
typedef float f32x2_t __attribute__((ext_vector_type(2))); typedef __bf16 bf16x2_t __attribute__((ext_vector_type(2)));
__device__ __forceinline__ unsigned cvtpk_s(float lo,float hi){f32x2_t v={lo,hi};bf16x2_t b=__builtin_convertvector(v,bf16x2_t);return __builtin_bit_cast(unsigned,b);}
#define WAIT_BAR(N) asm volatile("s_waitcnt vmcnt(" #N ") lgkmcnt(0)\n\ts_barrier":::"memory")

__device__ __forceinline__ void qkt(f32x16&p0,f32x16&p1,const char*Kslot,const char*Rslot,const bf16x8*qr,const f32x16&negm,int r32,int hi){
  const char*kb=Kslot+hi*1024+r32*16; const char*rb=Rslot+hi*1024+r32*16-4*2048;
  #pragma unroll
  for(int d0=0;d0<6;++d0){
    const bf16x8 b0=*reinterpret_cast<const bf16x8*>((d0<4?kb:rb)+d0*2048);
    const bf16x8 b1=*reinterpret_cast<const bf16x8*>((d0<4?kb:rb)+d0*2048+512);
    if(d0==0){p0=__builtin_amdgcn_mfma_f32_32x32x16_bf16(b0,qr[0],negm,0,0,0);p1=__builtin_amdgcn_mfma_f32_32x32x16_bf16(b1,qr[0],negm,0,0,0);}
    else{p0=__builtin_amdgcn_mfma_f32_32x32x16_bf16(b0,qr[d0],p0,0,0,0);p1=__builtin_amdgcn_mfma_f32_32x32x16_bf16(b1,qr[d0],p1,0,0,0);}}
}
typedef __attribute__((address_space(3))) const char* lds_cptr;
typedef short v4i16_t __attribute__((ext_vector_type(4)));
__device__ __forceinline__ void kload8(bf16x8*kf,lds_cptr kp){
  kf[0]=*(const __attribute__((address_space(3))) bf16x8*)(kp);      kf[1]=*(const __attribute__((address_space(3))) bf16x8*)(kp+512);
  kf[2]=*(const __attribute__((address_space(3))) bf16x8*)(kp+2048); kf[3]=*(const __attribute__((address_space(3))) bf16x8*)(kp+2560);
  kf[4]=*(const __attribute__((address_space(3))) bf16x8*)(kp+4096); kf[5]=*(const __attribute__((address_space(3))) bf16x8*)(kp+4608);
  kf[6]=*(const __attribute__((address_space(3))) bf16x8*)(kp+6144); kf[7]=*(const __attribute__((address_space(3))) bf16x8*)(kp+6656);
}
__device__ __forceinline__ void kload2(bf16x8*kf,lds_cptr kp,int j){ kf[2*j]=*(const __attribute__((address_space(3))) bf16x8*)(kp+j*2048); kf[2*j+1]=*(const __attribute__((address_space(3))) bf16x8*)(kp+j*2048+512); }
__device__ __forceinline__ s16x4 vtr(lds_cptr p){ return __builtin_bit_cast(s16x4,__builtin_amdgcn_ds_read_tr16_b64_v4i16((__attribute__((address_space(3))) v4i16_t*)p)); }
__device__ __forceinline__ float rowmax(const f32x16&p0,const f32x16&p1){
  float a=max3f(p0[0],p0[1],p1[0]),b=max3f(p0[2],p0[3],p1[1]);a=max3f(a,p1[2],p1[3]);
  #pragma unroll
  for(int r=4;r<16;r+=4){a=max3f(a,p0[r],p0[r+1]);b=max3f(b,p0[r+2],p0[r+3]);a=max3f(a,p1[r],p1[r+1]);b=max3f(b,p1[r+2],p1[r+3]);}
  const float m=max2f(a,b);
  auto rr=__builtin_amdgcn_permlane32_swap(__float_as_uint(m),__float_as_uint(m),false,false);
  return max2f(__uint_as_float(rr[0]),__uint_as_float(rr[1]));
}
__device__ __forceinline__ void pv(f32x16*o,int vb,bf16x8 pa0,bf16x8 pa1,bf16x8 pa2,bf16x8 pa3){
  #pragma unroll
  for(int d0=0;d0<2;++d0){s16x4 lo[4],hi[4];
    #pragma unroll
    for(int ks=0;ks<4;++ks){
      asm volatile("ds_read_b64_tr_b16 %0,%1 offset:%c2":"=&v"(lo[ks]):"v"(vb),"i"(d0*4096+ks*1024):"memory");
      asm volatile("ds_read_b64_tr_b16 %0,%1 offset:%c2":"=&v"(hi[ks]):"v"(vb),"i"(d0*4096+ks*1024+512):"memory");}
    asm volatile("s_waitcnt lgkmcnt(0)":::"memory");SBAR();
    #define PK(k) (bf16x8){lo[k][0],lo[k][1],lo[k][2],lo[k][3],hi[k][0],hi[k][1],hi[k][2],hi[k][3]}
    o[d0]=__builtin_amdgcn_mfma_f32_32x32x16_bf16(pa0,PK(0),o[d0],0,0,0);
    o[d0]=__builtin_amdgcn_mfma_f32_32x32x16_bf16(pa1,PK(1),o[d0],0,0,0);
    o[d0]=__builtin_amdgcn_mfma_f32_32x32x16_bf16(pa2,PK(2),o[d0],0,0,0);
    o[d0]=__builtin_amdgcn_mfma_f32_32x32x16_bf16(pa3,PK(3),o[d0],0,0,0);
    #undef PK
  }
}

#ifndef ATTN_STORE16
#define ATTN_STORE16(p,v) (*(u32x4*)(p)=(v))
#endif
template<int THRL> __device__ __forceinline__ void attn_unit(int b,int h,int qb,const bf16*Q,const bf16*__restrict__ KV,const bf16*__restrict__ KR,const float*__restrict__ CS,bf16*O,float*SSQ,char*shm,const int tid){
  const int lane=tid&63,r32=lane&31,hi=lane>>5; const int wid=__builtin_amdgcn_readfirstlane(tid>>6);
  unsigned m0keep; asm volatile("s_mov_b32 %0, m0":"=s"(m0keep));
  const long rowbase=(long)b*SEQ; const int q0=qb*QB;
  const bf16*Qw=Q+(rowbase+q0+wid*QBLK)*PQ+h*DQK;
  const bf16*Kh=KV+rowbase*PKV+h*128,*Vh=KV+rowbase*PKV+h*128+64,*Rh=KR+rowbase*PKR;
  const unsigned lds0=(unsigned)(uintptr_t)shm;
  float*wsf=(float*)(shm+LDS_WS)+wid*64;
  const bf16*ksrc=Kh+(long)lane*PKV+wid*8;
  const bf16*rsrc=Rh+(long)lane*PKR+(wid&3)*8;
  const bf16*vsrc=Vh+(long)(16*(wid&3)+(lane>>2))*PKV+(wid>>2)*32+(lane&3)*8;
  const unsigned kdst=lds0+LDS_K+wid*1024, rdst=lds0+LDS_R+(wid&3)*1024, vdst=lds0+LDS_V+wid*1024;
  #define DMA_K(t,slot) glds16(ksrc+(long)(t)*KVBLK*PKV,(unsigned)__builtin_amdgcn_readfirstlane(kdst+(slot)*SLOTK))
  #define DMA_R(t,slot) glds16(rsrc+(long)(t)*KVBLK*PKR,(unsigned)__builtin_amdgcn_readfirstlane(rdst+(slot)*SLOTR))
  #define DMA_V(t,slot) glds16(vsrc+(long)(t)*KVBLK*PKV,(unsigned)__builtin_amdgcn_readfirstlane(vdst+(slot)*SLOTV))
  const int vb0=(int)(lds0+LDS_V)+((lane>>4)&1)*32+(lane&3)*8+(4*hi+((lane&15)>>2))*64;
  const char*Kbase=shm+LDS_K; bf16x8 kf[8];
  const lds_cptr shm3=(lds_cptr)shm; const lds_cptr kp0=shm3+LDS_K+hi*1024+r32*16; const lds_cptr rp0=shm3+LDS_R+hi*1024+r32*16; const lds_cptr vp0=shm3+LDS_V+((lane>>4)&1)*32+(lane&3)*8+(4*hi+((lane&15)>>2))*64;
  const int NT=SEQ/KVBLK;
  DMA_K(0,0);DMA_R(0,0);DMA_V(0,0);DMA_K(1,1);DMA_R(1,1);
  bf16x8 qr[6];
  #pragma unroll
  for(int d0=0;d0<6;++d0)qr[d0]=*reinterpret_cast<const bf16x8*>(&Qw[(long)r32*PQ+d0*16+hi*8]);
  {
    const float*cs=CS+(rowbase+q0+wid*QBLK+r32)*32+hi*16; const bf16x8 q4=qr[4],q5=qr[5]; unsigned w4[4],w5[4];
    #pragma unroll
    for(int jj=0;jj<4;++jj){ const float4 c2=*reinterpret_cast<const float4*>(cs+jj*4);
      const float a0=__uint_as_float(((unsigned)(unsigned short)q4[2*jj])<<16),b0=__uint_as_float(((unsigned)(unsigned short)q5[2*jj])<<16),a1=__uint_as_float(((unsigned)(unsigned short)q4[2*jj+1])<<16),b1=__uint_as_float(((unsigned)(unsigned short)q5[2*jj+1])<<16);
      w4[jj]=cvtpk_s(a0*c2.x-b0*c2.y,a1*c2.z-b1*c2.w); w5[jj]=cvtpk_s(b0*c2.x+a0*c2.y,b1*c2.z+a1*c2.w); }
    const u32x4 W4={w4[0],w4[1],w4[2],w4[3]},W5={w5[0],w5[1],w5[2],w5[3]}; qr[4]=__builtin_bit_cast(bf16x8,W4); qr[5]=__builtin_bit_cast(bf16x8,W5); }
  float mhat=0.f,l_reg=0.f;f32x16 o[2];o[0]=f32x16{};o[1]=f32x16{};f32x16 negm=f32x16{};asm volatile("":"+v"(negm));
  #define CMASK(P0,P1,t) do{}while(0)
  bool resc=false;
  #define START(P0,P1) do{ const float rm=rowmax(P0,P1); resc=false; \
    { const float dl=rm; mhat=fadd_s(mhat,dl); \
      _Pragma("unroll") for(int r=0;r<16;++r){P0[r]=fsub_s(P0[r],dl);P1[r]=fsub_s(P1[r],dl);} \
      _Pragma("unroll") for(int r=0;r<16;++r)negm[r]=-mhat; asm volatile("":"+v"(negm)); } \
    _Pragma("unroll") for(int r=0;r<16;++r)P0[r]=__builtin_amdgcn_exp2f(P0[r]); }while(0)
  #define RESC() do{ if(resc){ asm volatile("s_waitcnt lgkmcnt(0)":::"memory"); \
      _Pragma("unroll") for(int d_=0;d_<2;++d_) _Pragma("unroll") for(int r=0;r<16;++r)o[d_][r]*=wsf[crow(r,hi)]; } }while(0)
  f32x16 pA0,pA1,pB0,pB1;
  int sl_prev=0,sl_cur=0,sl_next=1;
  #define ROT() do{sl_prev=sl_cur;sl_cur=sl_next;sl_next=(sl_next==NSLOT-1)?0:sl_next+1;}while(0)
  DMA_K(2,2);
  WAIT_BAR(3);
  qkt(pA0,pA1,Kbase,shm+LDS_R,qr,negm,r32,hi);asm volatile("s_nop 15\n\ts_nop 7":"+v"(pA0),"+v"(pA1));CMASK(pA0,pA1,0);
  START(pA0,pA1);
  _Pragma("unroll") for(int r=0;r<16;++r)pA1[r]=__builtin_amdgcn_exp2f(pA1[r]);
  WAIT_BAR(0);
  DMA_K(3,0);DMA_R(2,2);DMA_V(1,1);
  ROT();
  kload8(kf,kp0+sl_cur*SLOTK);
  WAIT_BAR(3);
  s16x4 vlo[8],vhi[8]; u32x4 pw0,pw1,pw2,pw3;
  #define PKW(P,B) cvtpk_s(P[B],P[B+1])
  #define PAF(k) __builtin_bit_cast(bf16x8,pw##k)
  #define VFR(i) (bf16x8){vlo[i][0],vlo[i][1],vlo[i][2],vlo[i][3],vhi[i][0],vhi[i][1],vhi[i][2],vhi[i][3]}
  #define PIN(x) asm volatile("":"+v"(x))
  #define MX3(a,b,c) __builtin_fmaxf(__builtin_fmaxf((a),(b)),(c))
  #define MX2(a,b) __builtin_fmaxf((a),(b))
  #define LGKM0() __builtin_amdgcn_s_waitcnt(0xC07F)
  #define GAPA(MF,A0,A1,A2,A3,W0,W1,PW) do{ MF; sacc+=A0; sacc+=A1; sacc+=A2; sacc+=A3; PIN(sacc); W0; W1; PIN(PW); SBAR(); }while(0)
  #define EX(v) __builtin_amdgcn_exp2f(v)
  #define GAPB(MF,X,B) do{ MF; X[B]=EX(X[B]); X[B+1]=EX(X[B+1]); X[B+2]=EX(X[B+2]); X[B+3]=EX(X[B+3]); PIN(X); SBAR(); }while(0)
  #define VRD(i) do{ vlo[i]=vtr(vp_+(((i)>>2)*4096+((i)&3)*1024)); vhi[i]=vtr(vp_+(((i)>>2)*4096+((i)&3)*1024+512)); }while(0)
  #define KRD(G,j) do{ if(G){ kload2(kf,kp0+sl_next*SLOTK,j); SBAR(); } }while(0)
  #define STEP(C0,C1,P0,P1,t,GK,GR,GV,GL) do{ SBAR(); bf16x8 krf0,krf1,krf2,krf3; \
    const lds_cptr vp_=vp0+sl_prev*SLOTV; \
    float sacc=(P0[0]+P0[1]); LGKM0(); \
    C0=__builtin_amdgcn_mfma_f32_32x32x16_bf16(kf[0],qr[0],negm,0,0,0); sacc+=P0[2]; sacc+=P0[3]; sacc+=P0[4]; PIN(sacc); pw0[0]=PKW(P0,0); pw0[1]=PKW(P0,2); PIN(pw0); SBAR(); \
    C1=__builtin_amdgcn_mfma_f32_32x32x16_bf16(kf[1],qr[0],negm,0,0,0); sacc+=P0[5]; sacc+=P0[6]; sacc+=P0[7]; PIN(sacc); pw0[2]=PKW(P0,4); PIN(pw0); SBAR(); \
    C0=__builtin_amdgcn_mfma_f32_32x32x16_bf16(kf[2],qr[1],C0,0,0,0); sacc+=P0[8]; sacc+=P0[9]; sacc+=P0[10]; PIN(sacc); pw0[3]=PKW(P0,6); PIN(pw0); SBAR(); \
    C1=__builtin_amdgcn_mfma_f32_32x32x16_bf16(kf[3],qr[1],C1,0,0,0); sacc+=P0[11]; sacc+=P0[12]; sacc+=P0[13]; PIN(sacc); pw1[0]=PKW(P0,8); pw1[1]=PKW(P0,10); PIN(pw1); SBAR(); \
    { const lds_cptr rp_=rp0+sl_cur*SLOTR; krf0=*(const __attribute__((address_space(3))) bf16x8*)(rp_); krf1=*(const __attribute__((address_space(3))) bf16x8*)(rp_+512); krf2=*(const __attribute__((address_space(3))) bf16x8*)(rp_+2048); krf3=*(const __attribute__((address_space(3))) bf16x8*)(rp_+2560); } SBAR(); \
    C0=__builtin_amdgcn_mfma_f32_32x32x16_bf16(kf[4],qr[2],C0,0,0,0); sacc+=P0[14]; sacc+=P0[15]; PIN(sacc); pw1[2]=PKW(P0,12); PIN(pw1); SBAR(); \
    C1=__builtin_amdgcn_mfma_f32_32x32x16_bf16(kf[5],qr[2],C1,0,0,0); sacc+=P1[0]; sacc+=P1[1]; PIN(sacc); pw1[3]=PKW(P0,14); PIN(pw1); SBAR(); \
    C0=__builtin_amdgcn_mfma_f32_32x32x16_bf16(kf[6],qr[3],C0,0,0,0); sacc+=P1[2]; sacc+=P1[3]; PIN(sacc); pw2[0]=PKW(P1,0); pw2[1]=PKW(P1,2); PIN(pw2); SBAR(); \
    C1=__builtin_amdgcn_mfma_f32_32x32x16_bf16(kf[7],qr[3],C1,0,0,0); sacc+=P1[4]; sacc+=P1[5]; PIN(sacc); pw2[2]=PKW(P1,4); PIN(pw2); SBAR(); \
    LGKM0(); C0=__builtin_amdgcn_mfma_f32_32x32x16_bf16(krf0,qr[4],C0,0,0,0); sacc+=P1[6]; sacc+=P1[7]; sacc+=P1[8]; PIN(sacc); pw2[3]=PKW(P1,6); PIN(pw2); SBAR(); \
    C1=__builtin_amdgcn_mfma_f32_32x32x16_bf16(krf1,qr[4],C1,0,0,0); sacc+=P1[9]; sacc+=P1[10]; sacc+=P1[11]; PIN(sacc); pw3[0]=PKW(P1,8); pw3[1]=PKW(P1,10); PIN(pw3); SBAR(); \
    C0=__builtin_amdgcn_mfma_f32_32x32x16_bf16(krf2,qr[5],C0,0,0,0); sacc+=P1[12]; sacc+=P1[13]; PIN(sacc); pw3[2]=PKW(P1,12); PIN(pw3); SBAR(); \
    C1=__builtin_amdgcn_mfma_f32_32x32x16_bf16(krf3,qr[5],C1,0,0,0); sacc+=P1[14]; sacc+=P1[15]; PIN(sacc); pw3[3]=PKW(P1,14); PIN(pw3); SBAR(); \
    l_reg+=sacc; \
    if(GK){DMA_K((t)+3,sl_cur);} if(GR){DMA_R((t)+2,sl_prev);} if(GV){DMA_V((t)+1,sl_next);} \
    CMASK(C0,C1,t); \
    { float a=MX3(C0[0],C0[1],C1[0]),b=MX3(C0[2],C0[3],C1[1]); a=MX3(a,C1[2],C1[3]); \
      _Pragma("unroll") for(int r=4;r<16;r+=4){a=MX3(a,C0[r],C0[r+1]);b=MX3(b,C0[r+2],C0[r+3]);a=MX3(a,C1[r],C1[r+1]);b=MX3(b,C1[r+2],C1[r+3]);} \
      float rm=MX2(a,b); { auto rr=__builtin_amdgcn_permlane32_swap(__float_as_uint(rm),__float_as_uint(rm),false,false); rm=MX2(__uint_as_float(rr[0]),__uint_as_float(rr[1])); } \
      resc=false; \
      if(__builtin_expect(__any(rm>(float)THRL),0)){ const float dl=__builtin_fmaxf(rm,0.f); mhat+=dl; \
        _Pragma("unroll") for(int r=0;r<16;++r){C0[r]-=dl;C1[r]-=dl;} \
        _Pragma("unroll") for(int r=0;r<16;++r)negm[r]=-mhat; asm volatile("":"+v"(negm)); \
        const float f=__builtin_amdgcn_exp2f(-dl); l_reg*=f; if(hi==0)wsf[r32]=f; resc=true; } } \
    SBAR(); VRD(0); VRD(4); SBAR(); \
    GAPB(o[0]=__builtin_amdgcn_mfma_f32_32x32x16_bf16(PAF(0),VFR(0),o[0],0,0,0), C0,0); VRD(1); SBAR(); \
    GAPB(o[1]=__builtin_amdgcn_mfma_f32_32x32x16_bf16(PAF(0),VFR(4),o[1],0,0,0), C0,4); VRD(5); SBAR(); \
    KRD(GL,0); GAPB(o[0]=__builtin_amdgcn_mfma_f32_32x32x16_bf16(PAF(1),VFR(1),o[0],0,0,0), C0,8); VRD(2); SBAR(); \
    KRD(GL,1); GAPB(o[1]=__builtin_amdgcn_mfma_f32_32x32x16_bf16(PAF(1),VFR(5),o[1],0,0,0), C0,12); VRD(6); SBAR(); \
    KRD(GL,2); GAPB(o[0]=__builtin_amdgcn_mfma_f32_32x32x16_bf16(PAF(2),VFR(2),o[0],0,0,0), C1,0); VRD(3); SBAR(); \
    KRD(GL,3); GAPB(o[1]=__builtin_amdgcn_mfma_f32_32x32x16_bf16(PAF(2),VFR(6),o[1],0,0,0), C1,4); VRD(7); SBAR(); \
    GAPB(o[0]=__builtin_amdgcn_mfma_f32_32x32x16_bf16(PAF(3),VFR(3),o[0],0,0,0), C1,8); \
    GAPB(o[1]=__builtin_amdgcn_mfma_f32_32x32x16_bf16(PAF(3),VFR(7),o[1],0,0,0), C1,12); \
    }while(0)
  int t=1;
  #undef CMASK
  #define CMASK(P0,P1,t) do{}while(0)
  for(;t+5<NT;t+=2){
    STEP(pB0,pB1,pA0,pA1,t,true,true,true,true);     WAIT_BAR(3); RESC(); ROT();
    STEP(pA0,pA1,pB0,pB1,t+1,true,true,true,true);   WAIT_BAR(3); RESC(); ROT();
  }
  #define ENDW(tt) do{ if((tt)+3<NT){WAIT_BAR(3);} else if((tt)+2<NT){WAIT_BAR(2);} else {WAIT_BAR(0);} }while(0)
  for(;t+1<NT;t+=2){
    STEP(pB0,pB1,pA0,pA1,t,(t+3<NT),(t+2<NT),(t+1<NT),(t+1<NT));       ENDW(t);   RESC(); ROT();
    STEP(pA0,pA1,pB0,pB1,t+1,(t+4<NT),(t+3<NT),(t+2<NT),(t+2<NT));     ENDW(t+1); RESC(); ROT();
  }
  STEP(pB0,pB1,pA0,pA1,NT-1,false,false,false,false); RESC();
  { float sacc=pB0[0]+pB0[1]; _Pragma("unroll") for(int r=2;r<16;++r)sacc+=pB0[r]; _Pragma("unroll") for(int r=0;r<16;++r)sacc+=pB1[r]; l_reg+=sacc;
    pw0=(u32x4){PKW(pB0,0),PKW(pB0,2),PKW(pB0,4),PKW(pB0,6)};pw1=(u32x4){PKW(pB0,8),PKW(pB0,10),PKW(pB0,12),PKW(pB0,14)};pw2=(u32x4){PKW(pB1,0),PKW(pB1,2),PKW(pB1,4),PKW(pB1,6)};pw3=(u32x4){PKW(pB1,8),PKW(pB1,10),PKW(pB1,12),PKW(pB1,14)};
    SBAR(); pv(o,vb0+sl_cur*SLOTV,PAF(0),PAF(1),PAF(2),PAF(3)); }
  #undef PKW
  #undef PAF
  #undef VFR
  #undef PIN
  #undef MX3
  #undef GAPA
  #undef GAPB
  #undef EX
  #undef VRD
  #undef KRD
  #undef STEP
  #undef ENDW
  {auto rr=__builtin_amdgcn_permlane32_swap(__float_as_uint(l_reg),__float_as_uint(l_reg),false,false);l_reg=__uint_as_float(rr[0])+__uint_as_float(rr[1]);}
  if(hi==0)wsf[32+r32]=l_reg;asm volatile("s_waitcnt lgkmcnt(0)":::"memory");
  float rli[16];
  #pragma unroll
  for(int r=0;r<16;++r)rli[r]=__builtin_amdgcn_rcpf(wsf[32+crow(r,hi)]);
  bf16*Ow=O+(rowbase+q0+wid*QBLK)*PO+h*DV;
  { bf16*stg=(bf16*)(shm+LDS_OST)+wid*2048;
    #pragma unroll
    for(int r=0;r<16;++r){const int orow=crow(r,hi);
      #pragma unroll
      for(int d0=0;d0<2;++d0)stg[orow*64+d0*32+r32]=__float2bfloat16(o[d0][r]*rli[r]);}
    asm volatile("s_waitcnt lgkmcnt(0)":::"memory");
    #pragma unroll
    for(int i=0;i<4;++i){const int row=i*8+(lane>>3),ch=lane&7; const u32x4 v=*(const u32x4*)(stg+row*64+ch*8); ATTN_STORE16(Ow+(long)row*PO+ch*8,v);
      float q_=0.f; _Pragma("unroll") for(int c_=0;c_<4;++c_){const float lo_=__uint_as_float(v[c_]<<16),hi_=__uint_as_float(v[c_]&0xffff0000u); q_+=lo_*lo_+hi_*hi_;}
      q_+=__int_as_float(__builtin_amdgcn_update_dpp(0,__float_as_int(q_),0xB1,0xf,0xf,true)); q_+=__int_as_float(__builtin_amdgcn_update_dpp(0,__float_as_int(q_),0x4E,0xf,0xf,true)); q_+=__int_as_float(__builtin_amdgcn_update_dpp(0,__float_as_int(q_),0x141,0xf,0xf,true));
      if(ch==0)SSQ[(rowbase+q0+wid*QBLK+row)*8+h]=q_; } }
  asm volatile("s_waitcnt lgkmcnt(0)\n\ts_barrier":::"memory");
  asm volatile("s_mov_b32 m0, %0"::"s"(m0keep));
  #undef DMA_K
  #undef DMA_V
  #undef CMASK
  #undef START
  #undef RESC
  #undef ROT
}
constexpr int ATTN_LDS_BYTES=LDS_BYTES;
#undef SBAR
#undef WAIT_BAR
}

namespace hy {
typedef float2 cf;
typedef unsigned short bf16_t;
constexpr int N = NFFT, L = SEQ;
constexpr int ZELEMS = 17408;
__device__ __forceinline__ float fadd_(float a, float b) { float r; asm("v_add_f32_e32 %0, %1, %2" : "=v"(r) : "v"(a), "v"(b)); return r; }
__device__ __forceinline__ float fsub_(float a, float b) { float r; asm("v_sub_f32_e32 %0, %1, %2" : "=v"(r) : "v"(a), "v"(b)); return r; }
__device__ __forceinline__ float fmul_(float a, float b) { float r; asm("v_mul_f32_e32 %0, %1, %2" : "=v"(r) : "v"(a), "v"(b)); return r; }
__device__ __forceinline__ float ffma_(float a, float b, float c) { float r; asm("v_fma_f32 %0, %1, %2, %3" : "=v"(r) : "v"(a), "v"(b), "v"(c)); return r; }
__device__ __forceinline__ float fnma_(float a, float b, float c) { float r; asm("v_fma_f32 %0, -%1, %2, %3" : "=v"(r) : "v"(a), "v"(b), "v"(c)); return r; }
__device__ __forceinline__ cf cmul(cf a, cf b) { return make_float2(fnma_(a.y, b.y, fmul_(a.x, b.x)), ffma_(a.x, b.y, fmul_(a.y, b.x))); }
__device__ __forceinline__ cf cadd(cf a, cf b) { return make_float2(fadd_(a.x, b.x), fadd_(a.y, b.y)); }
__device__ __forceinline__ cf csub(cf a, cf b) { return make_float2(fsub_(a.x, b.x), fsub_(a.y, b.y)); }
__device__ __forceinline__ float bf_lo(unsigned w) { return __uint_as_float(w << 16); }
__device__ __forceinline__ float bf_hi(unsigned w) { return __uint_as_float(w & 0xffff0000u); }
__device__ constexpr int BR16[16] = {0, 8, 4, 12, 2, 10, 6, 14, 1, 9, 5, 13, 3, 11, 7, 15};
__device__ constexpr int BR4[4] = {0, 2, 1, 3};
#define bitrev(p, R) (((R) == 16) ? BR16[(p) & 15] : BR4[(p) & 3])
__device__ constexpr float C32[16] = {1.0f, 0.98078528040323043f, 0.92387953251128674f, 0.83146961230254524f, 0.70710678118654752f, 0.55557023301960218f, 0.38268343236508977f, 0.19509032201612825f,
                                      0.0f, -0.19509032201612825f, -0.38268343236508977f, -0.55557023301960218f, -0.70710678118654752f, -0.83146961230254524f, -0.92387953251128674f, -0.98078528040323043f};
__device__ constexpr float S32[16] = {0.0f, 0.19509032201612825f, 0.38268343236508977f, 0.55557023301960218f, 0.70710678118654752f, 0.83146961230254524f, 0.92387953251128674f, 0.98078528040323043f,
                                      1.0f, 0.98078528040323043f, 0.92387953251128674f, 0.83146961230254524f, 0.70710678118654752f, 0.55557023301960218f, 0.38268343236508977f, 0.19509032201612825f};
template <int SGN> __device__ __forceinline__ cf twc(cf d, int tk) {
    if (tk == 0) return d;
    if (tk == 8) return (SGN < 0) ? make_float2(d.y, -d.x) : make_float2(-d.y, d.x);
    const float c = C32[tk], s = (SGN < 0) ? -S32[tk] : S32[tk]; return make_float2(fnma_(d.y, s, fmul_(d.x, c)), ffma_(d.x, s, fmul_(d.y, c)));
}
template <int R, int LEN, int SGN> struct DftStage {
    static __device__ __forceinline__ void run(cf (&v)[R]) {
        constexpr int half = LEN / 2;
#pragma unroll
        for (int blk = 0; blk < R; blk += LEN) {
#pragma unroll
            for (int k = 0; k < half; ++k) {
                const cf a = v[blk + k], b = v[blk + k + half];
                v[blk + k] = cadd(a, b);
                v[blk + k + half] = twc<SGN>(csub(a, b), k * (32 / LEN));
            }
        }
        DftStage<R, LEN / 2, SGN>::run(v);
    }
};
template <int R, int SGN> struct DftStage<R, 1, SGN> { static __device__ __forceinline__ void run(cf (&)[R]) {} };
template <int R, int SGN> __device__ __forceinline__ void dft_reg(cf (&v)[R]) { DftStage<R, R, SGN>::run(v); }
__device__ __forceinline__ void dft16_fwd_halfzero(cf (&v)[16]) {
#pragma unroll
    for (int k = 0; k < 8; ++k) v[k + 8] = twc<-1>(v[k], 2 * k);
    DftStage<16, 8, -1>::run(v);
}
__device__ __forceinline__ void tw_apply_br(cf (&v)[16], cf w1) {
    const cf w2 = cmul(w1, w1), w3 = cmul(w2, w1), w4 = cmul(w2, w2);
    cf c0 = w4, c1 = w1, c2 = w2, c3 = w3;
#pragma unroll
    for (int k = 0; k < 4; ++k) {
        if (k > 0) { v[bitrev(4 * k, 16)] = cmul(v[bitrev(4 * k, 16)], c0); c0 = cmul(c0, w4); }
        v[bitrev(4 * k + 1, 16)] = cmul(v[bitrev(4 * k + 1, 16)], c1); c1 = cmul(c1, w4);
        v[bitrev(4 * k + 2, 16)] = cmul(v[bitrev(4 * k + 2, 16)], c2); c2 = cmul(c2, w4);
        v[bitrev(4 * k + 3, 16)] = cmul(v[bitrev(4 * k + 3, 16)], c3); c3 = cmul(c3, w4);
    }
}
__device__ __forceinline__ void tw_apply_nat(cf (&v)[16], cf w1) {
    const cf w2 = cmul(w1, w1), w3 = cmul(w2, w1), w4 = cmul(w2, w2);
    cf c0 = w4, c1 = w1, c2 = w2, c3 = w3;
#pragma unroll
    for (int k = 0; k < 4; ++k) {
        if (k > 0) { v[4 * k] = cmul(v[4 * k], c0); c0 = cmul(c0, w4); }
        v[4 * k + 1] = cmul(v[4 * k + 1], c1); c1 = cmul(c1, w4);
        v[4 * k + 2] = cmul(v[4 * k + 2], c2); c2 = cmul(c2, w4);
        v[4 * k + 3] = cmul(v[4 * k + 3], c3); c3 = cmul(c3, w4);
    }
}
__device__ __forceinline__ constexpr int eoff1(int q) { return q * 1088; }
__device__ __forceinline__ void bf_geom1(int b, int& base, int& twi) { base = b + (b >> 4); twi = b; }
template <bool HALFZERO> __device__ __forceinline__ void fwd_store1(cf* Z, int base, cf w1, cf (&v)[16]) {
    if (HALFZERO) dft16_fwd_halfzero(v); else dft_reg<16, -1>(v);
    tw_apply_br(v, w1);
#pragma unroll
    for (int p = 0; p < 16; ++p) Z[base + eoff1(p)] = v[bitrev(p, 16)];
}
__device__ __forceinline__ void inv_load1(const cf* Z, int base, cf w1c, cf (&v)[16]) {
#pragma unroll
    for (int p = 0; p < 16; ++p) v[p] = Z[base + eoff1(p)];
    tw_apply_nat(v, w1c);
    dft_reg<16, 1>(v);
}
template <bool FWD> __device__ __forceinline__ void lds_passes(cf* Z, const cf* TW, int tid) {
#pragma unroll 1
    for (int ps = 0; ps < 2; ++ps) {
        int p2 = FWD ? (ps == 0) : (ps == 1); asm volatile("" : "+s"(p2));
        const int shift = p2 ? 6 : 2, bmul = p2 ? 1088 : 68, tws = p2 ? 4 : 8, es = p2 ? 68 : 4, ex = p2 ? 0 : 1;
#pragma unroll
        for (int i = 0; i < 2; ++i) {
            const int b = tid + 512 * i, blk = b >> shift, j = b & ((1 << shift) - 1);
            const int base = bmul * blk + j + (j >> 4);
            cf w = TW[j << tws];
            cf v[16];
            if (FWD) {
#pragma unroll
                for (int q = 0; q < 16; ++q) v[q] = Z[base + q * es + (q >> 2) * ex];
                dft_reg<16, -1>(v);
                tw_apply_br(v, w);
#pragma unroll
                for (int p = 0; p < 16; ++p) Z[base + p * es + (p >> 2) * ex] = v[bitrev(p, 16)];
            } else {
                w.y = -w.y;
#pragma unroll
                for (int p = 0; p < 16; ++p) v[p] = Z[base + p * es + (p >> 2) * ex];
                tw_apply_nat(v, w);
                dft_reg<16, 1>(v);
#pragma unroll
                for (int q = 0; q < 16; ++q) Z[base + q * es + (q >> 2) * ex] = v[bitrev(q, 16)];
            }
        }
        __syncthreads();
    }
}
__device__ __forceinline__ void mid_pass(cf* Z, const cf* Hs, int conv, int tid) {
#pragma unroll 1
    for (int i = 0; i < 2; ++i) {
        const int b = tid + 512 * i, base = 17 * b;
        float4 h[8];
        if (conv) {
#pragma unroll
            for (int g = 0; g < 8; ++g) h[g] = *reinterpret_cast<const float4*>(Hs + 16 * b + 2 * g);
        } else {
#pragma unroll
            for (int g = 0; g < 8; ++g) h[g] = make_float4(0.f, 0.f, 0.f, 0.f);
        }
        cf v[16];
#pragma unroll
        for (int q = 0; q < 16; ++q) v[q] = Z[base + q];
#pragma unroll
        for (int g = 0; g < 4; ++g) { cf u[4] = {v[4 * g], v[4 * g + 1], v[4 * g + 2], v[4 * g + 3]};
            dft_reg<4, -1>(u);
            if (conv) {
                const float4 h0 = h[2 * g], h1 = h[2 * g + 1];
                cf t[4];
                t[0] = cmul(u[bitrev(0, 4)], make_float2(h0.x, h0.y)); t[1] = cmul(u[bitrev(1, 4)], make_float2(h0.z, h0.w));
                t[2] = cmul(u[bitrev(2, 4)], make_float2(h1.x, h1.y)); t[3] = cmul(u[bitrev(3, 4)], make_float2(h1.z, h1.w));
                dft_reg<4, 1>(t);
#pragma unroll
                for (int q = 0; q < 4; ++q) Z[base + 4 * g + q] = t[bitrev(q, 4)];
            } else {
#pragma unroll
                for (int p2 = 0; p2 < 4; ++p2) Z[base + 4 * g + p2] = u[bitrev(p2, 4)];
            }
        }
    }
}

__device__ __forceinline__ cf conv3x2(const unsigned* row, int s, float w0, float w1, float w2, float cb) {
    const unsigned a = (s > 0) ? row[s - 1] : 0u, b = row[s], c = (s < SEQ - 1) ? row[s + 1] : 0u;
    return make_float2(cb + w0 * bf_lo(a) + w1 * bf_lo(b) + w2 * bf_lo(c), cb + w0 * bf_hi(a) + w1 * bf_hi(b) + w2 * bf_hi(c));
}

__device__ __forceinline__ void hyena_channel(int c, cf* Z, const cf* TW, const bf16_t* HYT2, const bf16_t* KT,
                                              const float* conv_w, const float* conv_b, const float* hbias,
                                              cf* Hs, cf* Z1S, bf16_t* HYOT, const int tid) {
    const float w00 = conv_w[0 * 1536 + c], w01 = conv_w[1 * 1536 + c], w02 = conv_w[2 * 1536 + c], cb0 = conv_b[c];
    const float w10 = conv_w[0 * 1536 + 512 + c], w11 = conv_w[1 * 1536 + 512 + c], w12 = conv_w[2 * 1536 + 512 + c], cb1 = conv_b[512 + c];
    const float w20 = conv_w[0 * 1536 + 1024 + c], w21 = conv_w[1 * 1536 + 1024 + c], w22 = conv_w[2 * 1536 + 1024 + c], cb2 = conv_b[1024 + c];
    const float bias0 = hbias[c], bias1 = hbias[512 + c];
    const unsigned* r0 = (const unsigned*)HYT2 + (size_t)c * SEQ; const unsigned* r1 = (const unsigned*)HYT2 + (size_t)(512 + c) * SEQ; const unsigned* r2 = (const unsigned*)HYT2 + (size_t)(1024 + c) * SEQ;
#pragma unroll 1
    for (int round = 0; round < 3; ++round) {
        int it = round; asm volatile("" : "+s"(it));
        if (it == 0) {
            const bf16_t* f0 = KT + (size_t)(0 * 1024 + 0 * 512 + c) * SEQ; const bf16_t* f1 = KT + (size_t)(0 * 1024 + 1 * 512 + c) * SEQ;
            const bf16_t* g0 = KT + (size_t)(1 * 1024 + 0 * 512 + c) * SEQ; const bf16_t* g1 = KT + (size_t)(1 * 1024 + 1 * 512 + c) * SEQ;
#pragma unroll 1
            for (int i = 0; i < 2; ++i) { const int j = tid + 512 * i; cf v[16];
#pragma unroll
                for (int q = 0; q < 8; ++q) { const int n = j + 1024 * q; v[q] = make_float2(__uint_as_float((unsigned)f0[n] << 16), __uint_as_float((unsigned)f1[n] << 16)); }
#pragma unroll
                for (int q = 8; q < 16; ++q) { const int m = L - (j + 1024 * (q - 8));
                    v[q] = (m == L) ? make_float2(0.f, 0.f) : make_float2(__uint_as_float((unsigned)g0[m & (L - 1)] << 16), __uint_as_float((unsigned)g1[m & (L - 1)] << 16)); }
                int base, twi; bf_geom1(j, base, twi);
                fwd_store1<false>(Z, base, TW[twi], v); }
        } else if (it == 1) {
#pragma unroll 1
            for (int i = 0; i < 2; ++i) { const int j = tid + 512 * i; cf v[16];
#pragma unroll
                for (int q = 0; q < 8; ++q) v[q] = conv3x2(r0, j + 1024 * q, w00, w01, w02, cb0);
                int base, twi; bf_geom1(j, base, twi);
                fwd_store1<true>(Z, base, TW[twi], v); }
        }
        __syncthreads();
        lds_passes<true>(Z, TW, tid);
        mid_pass(Z, Hs + (it == 2 ? N : 0), it > 0, tid);
        __syncthreads();
        if (it == 0) {
            const float sc = 0.5f / (float)N;
#pragma unroll 4
            for (int i = 0; i < 32; ++i) { const int pos = tid + 512 * i;
                const int k = (pos >> 10) + (((pos >> 6) & 15) << 4) + (((pos >> 2) & 15) << 8) + ((pos & 3) << 12);
                const int k2 = (N - k) & (N - 1);
                const int pos2 = ((k2 & 15) << 10) + (((k2 >> 4) & 15) << 6) + (((k2 >> 8) & 15) << 2) + (k2 >> 12);
                const cf F = Z[pos + (pos >> 4)], G = Z[pos2 + (pos2 >> 4)];
                Hs[pos] = make_float2((F.x + G.x) * sc, (F.y - G.y) * sc);
                Hs[N + pos] = make_float2((F.y + G.y) * sc, (G.x - F.x) * sc); }
            __syncthreads();
        } else {
            lds_passes<false>(Z, TW, tid);
            if (it == 1) {
#pragma unroll 1
                for (int i = 0; i < 2; ++i) { const int j = tid + 512 * i; int base, twi; bf_geom1(j, base, twi); const cf w = TW[twi];
                    cf v[16]; inv_load1(Z, base, make_float2(w.x, -w.y), v);
                    cf z[16];
#pragma unroll
                    for (int q = 0; q < 8; ++q) { const int s = j + 1024 * q; const cf y = v[bitrev(q, 16)];
                        const cf z0 = conv3x2(r0, s, w00, w01, w02, cb0), x1 = conv3x2(r1, s, w10, w11, w12, cb1);
                        z[q] = make_float2(x1.x * (y.x + z0.x * bias0), x1.y * (y.y + z0.y * bias0));
                        Z1S[s] = z[q]; }
                    fwd_store1<true>(Z, base, w, z); }
            } else {
#pragma unroll 1
                for (int i = 0; i < 2; ++i) { const int j = tid + 512 * i; int base, twi; bf_geom1(j, base, twi); const cf w = TW[twi];
                    cf v[16]; inv_load1(Z, base, make_float2(w.x, -w.y), v);
#pragma unroll
                    for (int q = 0; q < 8; ++q) { const int s = j + 1024 * q; const cf y = v[bitrev(q, 16)]; const cf z1 = Z1S[s];
                        const cf x2 = conv3x2(r2, s, w20, w21, w22, cb2);
                        HYOT[(size_t)c * T + s] = (bf16_t)(pg8::cvt_pk_bf16(x2.x * (y.x + z1.x * bias1), 0.f) & 0xffffu);
                        HYOT[(size_t)c * T + SEQ + s] = (bf16_t)(pg8::cvt_pk_bf16(x2.y * (y.y + z1.y * bias1), 0.f) & 0xffffu); } }
            }
        }
    }
    __syncthreads();
}
}

namespace hy16 {
typedef _Float16 h2 __attribute__((ext_vector_type(2)));
typedef float2 cf;
typedef unsigned short bf16_t;
constexpr int N = NFFT, L = SEQ;
constexpr int ZELEMS = 17408;
constexpr int TWROW = 18;
constexpr int HLW = 2 * 4096 + 2 * 512;
constexpr int LDS_Z = 0, LDS_H = ZELEMS * 4, LDS_T2 = LDS_H + 2 * HLW * 4, LDS_T3 = LDS_T2 + 64 * TWROW * 4, LDS_HX = LDS_T3 + 4 * TWROW * 4, LDS_END = LDS_HX + 16;
constexpr float S_IN = 1.0f / 16.0f, S_H = 1.0f / 8.0f, S_OUT = 1.0f / 128.0f;
constexpr float S_IN2 = 1.0f / 128.0f, S_OUT2 = 1.0f / 16.0f;
using hy::bf_lo; using hy::bf_hi;
__device__ __forceinline__ h2 mk(float re, float im) { h2 r; r.x = (_Float16)re; r.y = (_Float16)im; return r; }
template <bool CONJ> __device__ __forceinline__ h2 cmul(h2 a, h2 b) {
    h2 t, r;
    if (!CONJ) {
        asm("v_pk_mul_f16 %0, %1, %2 op_sel:[0,0] op_sel_hi:[0,1]" : "=v"(t) : "v"(a), "v"(b));
        asm("v_pk_fma_f16 %0, %1, %2, %3 op_sel:[1,1,0] op_sel_hi:[1,0,1] neg_lo:[1,0,0]" : "=v"(r) : "v"(a), "v"(b), "v"(t));
    } else {
        asm("v_pk_mul_f16 %0, %1, %2 op_sel:[0,0] op_sel_hi:[0,1] neg_hi:[1,0]" : "=v"(t) : "v"(a), "v"(b));
        asm("v_pk_fma_f16 %0, %1, %2, %3 op_sel:[1,1,0] op_sel_hi:[1,0,1]" : "=v"(r) : "v"(a), "v"(b), "v"(t));
    }
    return r;
}
template <int SGN> __device__ __forceinline__ h2 muli(h2 a) {
    h2 r; const h2 one = {(_Float16)1.0f, (_Float16)1.0f};
    if (SGN < 0) asm("v_pk_mul_f16 %0, %1, %2 op_sel:[1,0] op_sel_hi:[0,1] neg_hi:[1,0]" : "=v"(r) : "v"(a), "v"(one));
    else         asm("v_pk_mul_f16 %0, %1, %2 op_sel:[1,0] op_sel_hi:[0,1] neg_lo:[1,0]" : "=v"(r) : "v"(a), "v"(one));
    return r;
}
template <int SGN> __device__ __forceinline__ h2 sub_muli(h2 a, h2 b) {
    h2 r;
    if (SGN < 0) asm("v_pk_add_f16 %0, %1, %2 op_sel:[1,1] op_sel_hi:[0,0] neg_lo:[0,1] neg_hi:[1,0]" : "=v"(r) : "v"(a), "v"(b));
    else         asm("v_pk_add_f16 %0, %1, %2 op_sel:[1,1] op_sel_hi:[0,0] neg_lo:[1,0] neg_hi:[0,1]" : "=v"(r) : "v"(a), "v"(b));
    return r;
}
__device__ constexpr int BR16[16] = {0, 8, 4, 12, 2, 10, 6, 14, 1, 9, 5, 13, 3, 11, 7, 15};
__device__ constexpr int BR4[4] = {0, 2, 1, 3};
#define br16(p) BR16[(p) & 15]
#define br4(p) BR4[(p) & 3]
template <int SGN> __device__ __forceinline__ h2 twc(h2 d, int tk) {
    if (tk == 0) return d;
    if (tk == 8) return muli<SGN>(d);
    const h2 w = {(_Float16)hy::C32[tk], (_Float16)((SGN < 0) ? -hy::S32[tk] : hy::S32[tk])};
    return cmul<false>(d, w);
}
template <int R, int LEN, int SGN> struct DftStage {
    static __device__ __forceinline__ void run(h2 (&v)[R]) {
        constexpr int half = LEN / 2;
#pragma unroll
        for (int blk = 0; blk < R; blk += LEN) {
#pragma unroll
            for (int k = 0; k < half; ++k) {
                const h2 a = v[blk + k], b = v[blk + k + half];
                v[blk + k] = a + b;
                v[blk + k + half] = (k * (32 / LEN) == 8) ? sub_muli<SGN>(a, b) : twc<SGN>(a - b, k * (32 / LEN));
            }
        }
        DftStage<R, LEN / 2, SGN>::run(v);
    }
};
template <int R, int SGN> struct DftStage<R, 1, SGN> { static __device__ __forceinline__ void run(h2 (&)[R]) {} };
template <int R, int SGN> __device__ __forceinline__ void dft_reg(h2 (&v)[R]) { DftStage<R, R, SGN>::run(v); }
__device__ __forceinline__ void dft16_fwd_halfzero(h2 (&v)[16]) {
#pragma unroll
    for (int k = 0; k < 8; ++k) v[k + 8] = twc<-1>(v[k], 2 * k);
    DftStage<16, 8, -1>::run(v);
}
__device__ __forceinline__ h2 mk2(_Float16 x, _Float16 y) { h2 r = {x, y}; return r; }
__device__ __forceinline__ void tw_load(const h2* row, h2 (&w)[16]) {
#pragma unroll
    for (int i = 0; i < 8; ++i) { const uint2 u = *reinterpret_cast<const uint2*>(row + 2 * i); w[2 * i] = __builtin_bit_cast(h2, u.x); w[2 * i + 1] = __builtin_bit_cast(h2, u.y); }
}
__device__ __forceinline__ void ld2(const h2* Z, int idx, h2& a, h2& b) { const uint2 u = *reinterpret_cast<const uint2*>(Z + idx); a = __builtin_bit_cast(h2, u.x); b = __builtin_bit_cast(h2, u.y); }
__device__ __forceinline__ void st2(h2* Z, int idx, h2 a, h2 b) { uint2 u; u.x = __builtin_bit_cast(unsigned, a); u.y = __builtin_bit_cast(unsigned, b); *reinterpret_cast<uint2*>(Z + idx) = u; }
__device__ __forceinline__ constexpr int eoff1(int q) { return q * 1088; }
__device__ __forceinline__ int base1(int j) { return j + 2 * (j >> 5); }
template <bool HALFZERO> __device__ __forceinline__ void fwd_store1(h2* Z, const h2 (&wa)[16], const h2 (&wb)[16], int j, h2 (&va)[16], h2 (&vb)[16]) {
    if (HALFZERO) { dft16_fwd_halfzero(va); dft16_fwd_halfzero(vb); } else { dft_reg<16, -1>(va); dft_reg<16, -1>(vb); }
    const int base = base1(j);
    st2(Z, base, va[0], vb[0]);
#pragma unroll
    for (int p = 1; p < 16; ++p) st2(Z, base + eoff1(p), cmul<false>(va[br16(p)], wa[p - 1]), cmul<false>(vb[br16(p)], wb[p - 1]));
}
__device__ __forceinline__ void inv_load1(const h2* Z, const h2 (&wa)[16], const h2 (&wb)[16], int j, h2 (&va)[16], h2 (&vb)[16]) {
    const int base = base1(j);
    ld2(Z, base, va[0], vb[0]);
#pragma unroll
    for (int p = 1; p < 16; ++p) { h2 a, b; ld2(Z, base + eoff1(p), a, b); va[p] = cmul<true>(a, wa[p - 1]); vb[p] = cmul<true>(b, wb[p - 1]); }
    dft_reg<16, 1>(va); dft_reg<16, 1>(vb);
}
__device__ __forceinline__ void wave_lds_sync() { asm volatile("s_waitcnt lgkmcnt(0)" ::: "memory"); __builtin_amdgcn_wave_barrier(); }
template <bool FWD> __device__ __forceinline__ void lds_passes(h2* Z, const h2* T2, const h2* T3, int tid) {
#pragma unroll 1
    for (int ps = 0; ps < 2; ++ps) {
        int p2 = FWD ? (ps == 0) : (ps == 1); asm volatile("" : "+s"(p2));
        const int shift = p2 ? 6 : 2, bmul = p2 ? 1088 : 68, es = p2 ? 68 : 4, ex = p2 ? 0 : 2;
        const h2* TT = p2 ? T2 : T3;
        const int b = 2 * tid, blk = b >> shift, j = b & ((1 << shift) - 1);
        const int base = bmul * blk + j + 2 * (j >> 5);
        h2 wa[16], wb[16]; tw_load(TT + j * TWROW, wa); tw_load(TT + (j + 1) * TWROW, wb);
        h2 va[16], vb[16];
        if (FWD) {
#pragma unroll
            for (int q = 0; q < 16; ++q) ld2(Z, base + q * es + (q >> 3) * ex, va[q], vb[q]);
            dft_reg<16, -1>(va); dft_reg<16, -1>(vb);
            st2(Z, base, va[0], vb[0]);
#pragma unroll
            for (int p = 1; p < 16; ++p) st2(Z, base + p * es + (p >> 3) * ex, cmul<false>(va[br16(p)], wa[p - 1]), cmul<false>(vb[br16(p)], wb[p - 1]));
        } else {
            ld2(Z, base, va[0], vb[0]);
#pragma unroll
            for (int p = 1; p < 16; ++p) { h2 a, c; ld2(Z, base + p * es + (p >> 3) * ex, a, c); va[p] = cmul<true>(a, wa[p - 1]); vb[p] = cmul<true>(c, wb[p - 1]); }
            dft_reg<16, 1>(va); dft_reg<16, 1>(vb);
#pragma unroll
            for (int q = 0; q < 16; ++q) st2(Z, base + q * es + (q >> 3) * ex, va[br16(q)], vb[br16(q)]);
        }
        wave_lds_sync();
    }
}
__device__ __forceinline__ void mid_pass(h2* Z, const h2* HL, const h2* HX, int conv, int tid) {
    const int lo8 = (tid >> 5) + 16 * ((tid >> 1) & 15), r8 = (256 - lo8) & 255;
    const int M2 = ((r8 & 15) << 8) + ((r8 >> 4) << 4) + (lo8 ? 15 : 16) - 8 * (tid & 1);
#pragma unroll 1
    for (int i = 0; i < 2; ++i) {
        const int base = 34 * tid + 16 * i;
        h2 hd[8], hm[8];
        if (conv) {
#pragma unroll
            for (int g = 0; g < 4; ++g) { const int c = 4 * i + g, m2 = M2 - c;
                ld2(HL, 18 * tid + 2 * c, hd[2 * g], hd[2 * g + 1]);
                ld2(HL, 2 * m2 + 2 * (m2 >> 3), hm[2 * g], hm[2 * g + 1]); }
            if (tid + i == 0) { const h2 x = HX[0]; hm[1] = mk2(x.x, -x.y); hm[0] = hd[1]; }
        } else {
#pragma unroll
            for (int g = 0; g < 8; ++g) { hd[g] = mk(0.f, 0.f); hm[g] = mk(0.f, 0.f); }
        }
        h2 v[16];
#pragma unroll
        for (int q = 0; q < 16; q += 2) ld2(Z, base + q, v[q], v[q + 1]);
#pragma unroll
        for (int g = 0; g < 4; ++g) { h2 u[4] = {v[4 * g], v[4 * g + 1], v[4 * g + 2], v[4 * g + 3]};
            dft_reg<4, -1>(u);
            if (conv) {
                h2 t[4];
                t[0] = cmul<false>(u[br4(0)], hd[2 * g]); t[1] = cmul<false>(u[br4(1)], hd[2 * g + 1]);
                t[2] = cmul<true>(u[br4(2)], hm[2 * g + 1]); t[3] = cmul<true>(u[br4(3)], hm[2 * g]);
                dft_reg<4, 1>(t);
                st2(Z, base + 4 * g, t[br4(0)], t[br4(1)]); st2(Z, base + 4 * g + 2, t[br4(2)], t[br4(3)]);
            } else {
                st2(Z, base + 4 * g, u[br4(0)], u[br4(1)]); st2(Z, base + 4 * g + 2, u[br4(2)], u[br4(3)]);
            }
        }
    }
}
__device__ __forceinline__ void build_tables(h2* T2, h2* T3, const cf* TWg, int tid) {
    for (int i = tid; i < 64 * 16; i += 512) { const int j = i >> 4, p = (i & 15) + 1; const cf w = TWg[(16 * j * p) & (N - 1)]; T2[j * TWROW + p - 1] = mk(w.x, w.y); }
    if (tid < 64) { const int j = tid >> 4, p = (tid & 15) + 1; const cf w = TWg[(256 * j * p) & (N - 1)]; T3[j * TWROW + p - 1] = mk(w.x, w.y); }
}
__device__ __forceinline__ void load_tw1(const cf* TWg, int tid, h2 (&wa)[16], h2 (&wb)[16]) {
#pragma unroll
    for (int k = 0; k < 15; ++k) { const cf a = TWg[(2 * tid * (k + 1)) & (N - 1)], b = TWg[((2 * tid + 1) * (k + 1)) & (N - 1)]; wa[k] = mk(a.x, a.y); wb[k] = mk(b.x, b.y); }
    wa[15] = mk(0.f, 0.f); wb[15] = mk(0.f, 0.f);
}

__device__ __forceinline__ void taps_load(const unsigned* row, int s, unsigned (&t)[4]) {
    t[0] = (s > 0) ? __builtin_nontemporal_load(row + s - 1) : 0u; typedef unsigned u2v_ __attribute__((ext_vector_type(2))); const u2v_ bc = __builtin_nontemporal_load(reinterpret_cast<const u2v_*>(row + s)); t[1] = bc.x; t[2] = bc.y; t[3] = (s + 2 < SEQ) ? __builtin_nontemporal_load(row + s + 2) : 0u;
}
__device__ __forceinline__ void taps_conv(const unsigned (&t)[4], float w0, float w1, float w2, float cb, cf& z0, cf& z1) {
    z0 = make_float2(cb + w0 * bf_lo(t[0]) + w1 * bf_lo(t[1]) + w2 * bf_lo(t[2]), cb + w0 * bf_hi(t[0]) + w1 * bf_hi(t[1]) + w2 * bf_hi(t[2]));
    z1 = make_float2(cb + w0 * bf_lo(t[1]) + w1 * bf_lo(t[2]) + w2 * bf_lo(t[3]), cb + w0 * bf_hi(t[1]) + w1 * bf_hi(t[2]) + w2 * bf_hi(t[3]));
}
__device__ __forceinline__ void conv3x2_pair(const unsigned* row, int s, float w0, float w1, float w2, float cb, cf& z0, cf& z1) {
    const unsigned a = (s > 0) ? row[s - 1] : 0u; const uint2 bc = *reinterpret_cast<const uint2*>(row + s); const unsigned d = (s + 2 < SEQ) ? row[s + 2] : 0u;
    z0 = make_float2(cb + w0 * bf_lo(a) + w1 * bf_lo(bc.x) + w2 * bf_lo(bc.y), cb + w0 * bf_hi(a) + w1 * bf_hi(bc.x) + w2 * bf_hi(bc.y));
    z1 = make_float2(cb + w0 * bf_lo(bc.x) + w1 * bf_lo(bc.y) + w2 * bf_lo(d), cb + w0 * bf_hi(bc.x) + w1 * bf_hi(bc.y) + w2 * bf_hi(d));
}
__device__ __forceinline__ void hyena_channel(int c, unsigned char* lds, const bf16_t* HYT2, const bf16_t* KT,
                                              const float* conv_w, const float* conv_b, const float* hbias,
                                              const h2 (&w1a)[16], const h2 (&w1b)[16], bf16_t* HYOT, const int tid) {
    h2* Z = (h2*)(lds + LDS_Z); h2* HL = (h2*)(lds + LDS_H); h2* HX = (h2*)(lds + LDS_HX); const h2* T2 = (const h2*)(lds + LDS_T2); const h2* T3 = (const h2*)(lds + LDS_T3);
    const float w00 = conv_w[0 * 1536 + c], w01 = conv_w[1 * 1536 + c], w02 = conv_w[2 * 1536 + c], cb0 = conv_b[c];
    const float w10 = conv_w[0 * 1536 + 512 + c], w11 = conv_w[1 * 1536 + 512 + c], w12 = conv_w[2 * 1536 + 512 + c], cb1 = conv_b[512 + c];
    const float w20 = conv_w[0 * 1536 + 1024 + c], w21 = conv_w[1 * 1536 + 1024 + c], w22 = conv_w[2 * 1536 + 1024 + c], cb2 = conv_b[1024 + c];
    const float bias0 = hbias[c], bias1 = hbias[512 + c];
    const unsigned* r0 = (const unsigned*)HYT2 + (size_t)c * SEQ; const unsigned* r1 = (const unsigned*)HYT2 + (size_t)(512 + c) * SEQ; const unsigned* r2 = (const unsigned*)HYT2 + (size_t)(1024 + c) * SEQ;
    h2 z1a[8], z1b[8];
#pragma unroll
    for (int q = 0; q < 8; ++q) { z1a[q] = mk(0.f, 0.f); z1b[q] = mk(0.f, 0.f); }
#ifndef REP_R0
#define REP_R0 0
#endif
#ifndef REP_SPLIT
#define REP_SPLIT 1
#endif
#pragma unroll 1
    for (int round = -REP_R0; round < 3; ++round) {
        int it = round < 0 ? 0 : round; asm volatile("" : "+s"(it));
        int j = 2 * tid; asm volatile("" : "+v"(j));
        if (it == 0) {
            const unsigned* fp = (const unsigned*)KT + (size_t)c * SEQ; const unsigned* gp = (const unsigned*)KT + (size_t)(512 + c) * SEQ;
            h2 va[16], vb[16];
#pragma unroll
            for (int q = 0; q < 8; ++q) { typedef unsigned u2v_ __attribute__((ext_vector_type(2))); const u2v_ w = __builtin_nontemporal_load(reinterpret_cast<const u2v_*>(fp + j + 1024 * q)); va[q] = mk(bf_lo(w.x), bf_hi(w.x)); vb[q] = mk(bf_lo(w.y), bf_hi(w.y)); }
#pragma unroll
            for (int q = 8; q < 16; ++q) { const int m = L - (j + 1024 * (q - 8));
                const unsigned wa_ = __builtin_nontemporal_load(gp + (m & (L - 1))), wb_ = __builtin_nontemporal_load(gp + m - 1);
                va[q] = (m == L) ? mk(0.f, 0.f) : mk(bf_lo(wa_), bf_hi(wa_)); vb[q] = mk(bf_lo(wb_), bf_hi(wb_)); }
            fwd_store1<false>(Z, w1a, w1b, j, va, vb);
        }
        __syncthreads();
        lds_passes<true>(Z, T2, T3, tid);
        mid_pass(Z, HL + (it == 2 ? HLW : 0), HX + (it == 2 ? 1 : 0), it > 0, tid);
        if (it == 0) {
            unsigned pz[8][4];
#pragma unroll
            for (int q = 0; q < 8; ++q) taps_load(r0, j + 1024 * q, pz[q]);
            __syncthreads();
            const h2 scv = mk(0.5f * S_H, 0.5f * S_H);
            for (int rs = 0; rs < REP_SPLIT; ++rs) {
#pragma unroll 2
            for (int i = 0; i < 8; ++i) { const int m = tid + 512 * i;
                if (m != 0) {
                    const int klow = (m >> 8) + (((m >> 4) & 15) << 4) + ((m & 15) << 8);
                    const int k2 = 4096 - klow;
                    const int m2 = ((k2 & 15) << 8) + (((k2 >> 4) & 15) << 4) + (k2 >> 8);
                    h2 F0, F1, Ga, Gb; ld2(Z, 4 * m + 2 * (m >> 3), F0, F1); ld2(Z, 4 * m2 + 2 + 2 * (m2 >> 3), Ga, Gb);
                    const h2 cb = mk2(Gb.x, -Gb.y), ca = mk2(Ga.x, -Ga.y);
                    const h2 h00 = (F0 + cb) * scv, h01 = (F1 + ca) * scv;
                    const h2 d0 = F0 - cb, d1 = F1 - ca;
                    const h2 h10 = mk2(d0.y, -d0.x) * scv, h11 = mk2(d1.y, -d1.x) * scv;
                    st2(HL, 2 * m + 2 * (m >> 3), h00, h01); st2(HL, HLW + 2 * m + 2 * (m >> 3), h10, h11);
                }
            }
            if (tid == 0) {
                const h2 F0 = Z[0], F1 = Z[1], F2 = Z[2], F3 = Z[3];
                const h2 c0 = mk2(F0.x, -F0.y), c3 = mk2(F3.x, -F3.y), c2 = mk2(F2.x, -F2.y);
                const h2 e0 = F0 - c0, e1 = F1 - c3, e2 = F2 - c2;
                st2(HL, 0, (F0 + c0) * scv, (F1 + c3) * scv); st2(HL, HLW, mk2(e0.y, -e0.x) * scv, mk2(e1.y, -e1.x) * scv);
                HX[0] = (F2 + c2) * scv; HX[1] = mk2(e2.y, -e2.x) * scv;
            }
            }
            __syncthreads();
            {
                h2 va[16], vb[16];
#pragma unroll
                for (int q = 0; q < 8; ++q) { cf za, zb; taps_conv(pz[q], w00, w01, w02, cb0, za, zb); va[q] = mk(za.x * S_IN, za.y * S_IN); vb[q] = mk(zb.x * S_IN, zb.y * S_IN);
                    z1a[q] = mk(za.x, za.y); z1b[q] = mk(zb.x, zb.y); }
                fwd_store1<true>(Z, w1a, w1b, j, va, vb);
            }
        } else {
            unsigned pa[8][4];
            const unsigned* ra = (it == 1) ? r1 : r2;
#pragma unroll
            for (int q = 0; q < 8; ++q) taps_load(ra, j + 1024 * q, pa[q]);
            wave_lds_sync();
            lds_passes<false>(Z, T2, T3, tid);
            __syncthreads();
            h2 va[16], vb[16]; inv_load1(Z, w1a, w1b, j, va, vb);
            if (it == 1) {
                h2 za[16], zb[16];
#pragma unroll
                for (int q = 0; q < 8; ++q) { const int s = j + 1024 * q; const h2 ya = va[br16(q)], yb = vb[br16(q)];
                    cf x1a, x1b; taps_conv(pa[q], w10, w11, w12, cb1, x1a, x1b);
                    const cf z0a = make_float2((float)z1a[q].x, (float)z1a[q].y), z0b = make_float2((float)z1b[q].x, (float)z1b[q].y);
                    const cf oa = make_float2(x1a.x * ((float)ya.x * S_OUT + z0a.x * bias0), x1a.y * ((float)ya.y * S_OUT + z0a.y * bias0));
                    const cf ob = make_float2(x1b.x * ((float)yb.x * S_OUT + z0b.x * bias0), x1b.y * ((float)yb.y * S_OUT + z0b.y * bias0));
                    z1a[q] = mk(oa.x, oa.y); z1b[q] = mk(ob.x, ob.y);
                    za[q] = mk(oa.x * S_IN2, oa.y * S_IN2); zb[q] = mk(ob.x * S_IN2, ob.y * S_IN2); }
                fwd_store1<true>(Z, w1a, w1b, j, za, zb);
            } else {
#pragma unroll
                for (int q = 0; q < 8; ++q) { const int s = j + 1024 * q; const h2 ya = va[br16(q)], yb = vb[br16(q)];
                    const float z1x = (float)z1a[q].x, z1y = (float)z1a[q].y, z1z = (float)z1b[q].x, z1w = (float)z1b[q].y;
                    cf x2a, x2b; taps_conv(pa[q], w20, w21, w22, cb2, x2a, x2b);
                    const float oa0 = x2a.x * ((float)ya.x * S_OUT2 + z1x * bias1), oa1 = x2a.y * ((float)ya.y * S_OUT2 + z1y * bias1);
                    const float ob0 = x2b.x * ((float)yb.x * S_OUT2 + z1z * bias1), ob1 = x2b.y * ((float)yb.y * S_OUT2 + z1w * bias1);
                    *reinterpret_cast<unsigned*>(HYOT + (unsigned)(((s >> 6) * 512 + c) * 64 + (s & 63))) = pg8::cvt_pk_bf16(oa0, ob0);
                    *reinterpret_cast<unsigned*>(HYOT + (unsigned)((((SEQ + s) >> 6) * 512 + c) * 64 + (s & 63))) = pg8::cvt_pk_bf16(oa1, ob1); }
            }
        }
    }
    __syncthreads();
}
#undef br16
#undef br4
}

#define GAS __attribute__((address_space(1)))
#define LAS __attribute__((address_space(3)))
typedef unsigned short bf16;
typedef unsigned v4u __attribute__((ext_vector_type(4)));
typedef unsigned v2u __attribute__((ext_vector_type(2)));
typedef float f32x4 __attribute__((ext_vector_type(4)));
constexpr int NWAVES = 8, NTHR = 512;
constexpr size_t MiB = 1u << 20;
constexpr size_t WS_MOD = 0  , WS_MODP = 256 * 1024  ;
constexpr size_t WS_SSQQ = 2 * MiB + 256 * 1024, WS_SSQKV = 2 * MiB + 512 * 1024;
constexpr size_t WS_BAR = 128 * 1024;
constexpr size_t WS_TW = 2 * MiB;
constexpr size_t WS_CS = 3 * MiB;
constexpr size_t WS_WTIN = 5 * MiB;
constexpr size_t WS_WTO = 9 * MiB;
constexpr size_t WS_WTQB = 11 * MiB;
constexpr size_t WS_WTKVB = 11 * MiB + 512 * 1024;
constexpr size_t WS_WT3 = 12 * MiB;
constexpr size_t WS_H2 = 13 * MiB;
constexpr size_t WS_AFF = 15 * MiB;
constexpr size_t WS_IDX = 16 * MiB;
constexpr size_t WS_GATE = 16 * MiB + 128 * 1024;
constexpr size_t WS_STATS = 16 * MiB + 256 * 1024;
constexpr size_t WS_INV = 17 * MiB;
constexpr size_t WS_U1 = 18 * MiB;
constexpr size_t WS_HYOT = 18 * MiB;
constexpr size_t WS_AATT = 34 * MiB;
constexpr size_t WS_MIXED = 18 * MiB;
constexpr size_t WS_HYT = 50 * MiB;
constexpr size_t WS_APRIME = 50 * MiB;
constexpr size_t WS_XE = 50 * MiB;
constexpr size_t WS_YE = 210 * MiB;
constexpr size_t WS_KT = 98 * MiB;
constexpr size_t WS_CQ = 130 * MiB;
constexpr size_t WS_CKV = 138 * MiB;
constexpr size_t WS_KRR = 142 * MiB;
constexpr size_t WS_KR = 144 * MiB;
constexpr size_t WS_FFTS = 146 * MiB;
constexpr size_t FFTS_PER_WG = 320 * 1024;
constexpr size_t WS_WTGU = 114 * MiB;
constexpr size_t WS_WTD = 178 * MiB;
constexpr size_t WS_U2 = 210 * MiB;
constexpr size_t WS_HB = 50 * MiB;
constexpr size_t WS_Q = 226 * MiB;
constexpr size_t WS_KV = 250 * MiB;
constexpr size_t WS_X1 = WS_MIXED;
constexpr size_t WS_END = 282 * MiB;
constexpr int LDS_BYTES = 148 * 1024;

struct Params {
    const float* x; const float* c; const int* positions; const float* w_ada; const float* b_ada; const float* w_in; const float* q_norm_g; const float* w_qb;
    const float* kv_norm_g; const float* w_kvb; const float* conv_w; const float* conv_b; const float* filt_w1; const float* filt_b1; const float* filt_freq;
    const float* filt_w2; const float* filt_b2; const float* filt_w3; const float* filt_b3; const float* hyena_decay; const float* hyena_bias;
    const float* attn_out_g; const float* hyena_out_g; const float* w_o; const float* ln1_g; const float* ln1_b; const float* w_router;
    const float* w_gate; const float* w_up; const float* w_down; const float* ln2_g; const float* ln2_b;
    float* out; unsigned char* ws;
};

__device__ __forceinline__ unsigned f2bf(float f) { unsigned u = __builtin_bit_cast(unsigned, f); return (u + 0x7fffu + ((u >> 16) & 1u)) >> 16; }
__device__ __forceinline__ unsigned pk2(float lo, float hi) { return pg8::cvt_pk_bf16(lo, hi); }
__device__ __forceinline__ float bf_lo(unsigned w) { return __uint_as_float(w << 16); }
__device__ __forceinline__ float bf_hi(unsigned w) { return __uint_as_float(w & 0xffff0000u); }
__device__ __forceinline__ float wave_sum(float v) {
#pragma unroll
    for (int o = 1; o < 64; o <<= 1) v += __shfl_xor(v, o);
    return v;
}
struct Ctx { int tid, lane, wave, vcu, G, gw, NGW; unsigned char* lds; };

__device__ __forceinline__ void transpose_item(const float* __restrict__ W, int ldw, int N, bf16* WT, int ldk, int nmul, int nadd, const float* __restrict__ kscale, float* scr, int item, int lane) {
    const int nblk = N / 32, kb = item / nblk, nb = item % nblk, k0 = 64 * kb, n0 = 32 * nb;
#pragma unroll
    for (int i = 0; i < 8; ++i) { const int kk = 8 * i + (lane >> 3), nq = 4 * (lane & 7);
        f32x4 v = __builtin_nontemporal_load((const f32x4*)(W + (size_t)(k0 + kk) * ldw + n0 + nq)); if (kscale) v = v * kscale[k0 + kk];
        scr[kk * 33 + nq] = v.x; scr[kk * 33 + nq + 1] = v.y; scr[kk * 33 + nq + 2] = v.z; scr[kk * 33 + nq + 3] = v.w; }
    asm volatile("s_waitcnt lgkmcnt(0)" ::: "memory");
    const int c = lane & 7;
#pragma unroll
    for (int j = 0; j < 4; ++j) { const int n = (lane >> 3) + 8 * j; const float* s = scr + (8 * c) * 33 + n;
        v4u o; o.x = pk2(s[0 * 33], s[1 * 33]); o.y = pk2(s[2 * 33], s[3 * 33]); o.z = pk2(s[4 * 33], s[5 * 33]); o.w = pk2(s[6 * 33], s[7 * 33]);
        *(v4u*)(WT + (size_t)((n0 + n) * nmul + nadd) * ldk + k0 + 8 * c) = o; }
    asm volatile("s_waitcnt lgkmcnt(0)" ::: "memory");
}

__device__ __forceinline__ void phase0(const Params& P, const Ctx& X) {
    unsigned char* ws = P.ws;
    const int gt = X.vcu * NTHR + X.tid, NGT = X.G * NTHR;
    for (int k = gt; k < NFFT; k += NGT) { float s, c; sincospif(2.0f * (float)k / (float)NFFT, &s, &c); ((float2*)(ws + WS_TW))[k] = make_float2(c, -s); }
    { double* invf = (double*)(X.lds + 131072);
      if (X.tid < 16) invf[X.tid] = pow(10000.0, -(double)X.tid / 16.0);
      __syncthreads();
      for (int i = gt; i < T * 16; i += NGT) { const int t = i >> 4, f = i & 15; const double ang = (double)P.positions[t] * invf[f];
          const double k = rint(ang * 0.15915494309189535); const float r = (float)(ang - k * 6.283185307179586476925);
          float sn, cs; sincosf(r, &sn, &cs); ((float2*)(ws + WS_CS))[i] = make_float2(cs, sn); } }
    for (int i = gt; i < 96 * 1024 / 8; i += NGT) ((v4u*)(ws + WS_WTIN + (size_t)IN_COLS * 1024 * 2))[i] = (v4u){0u, 0u, 0u, 0u};
    for (int i = gt; i < 2048 * 8; i += NGT) { const int r = i >> 3, cc = i & 7; ((v4u*)(ws + WS_WT3 + (size_t)r * 256 + 128))[cc] = (v4u){0u, 0u, 0u, 0u}; }
    for (int i = gt; i < 8192 * 8; i += NGT) { const int r = i >> 3, cc = i & 7; ((v4u*)(ws + WS_H2 + (size_t)r * 256 + 128))[cc] = (v4u){0u, 0u, 0u, 0u}; }
    float* scr = (float*)(X.lds + X.wave * 16384);
    {
        constexpr int I_IN = (1024 / 64) * (IN_COLS / 32), I_O = 16 * 32, I_QB = (256 / 64) * (768 / 32), I_KVB = (128 / 64) * (1024 / 32), I_3 = 1 * (2048 / 32);
        constexpr int NIT = I_IN + I_O + I_QB + I_KVB + I_3;
        for (int it = X.gw; it < NIT; it += X.NGW) {
            int r = it;
            if (r < I_IN) { transpose_item(P.w_in, IN_COLS, IN_COLS, (bf16*)(ws + WS_WTIN), 1024, 1, 0, nullptr, scr, r, X.lane); continue; } r -= I_IN;
            if (r < I_O) { transpose_item(P.w_o, 1024, 1024, (bf16*)(ws + WS_WTO), 1024, 1, 0, (r < 256) ? P.attn_out_g : nullptr, scr, r, X.lane); continue; } r -= I_O;
            if (r < I_QB) { transpose_item(P.w_qb, 768, 768, (bf16*)(ws + WS_WTQB), 256, 1, 0, P.q_norm_g, scr, r, X.lane); continue; } r -= I_QB;
            if (r < I_KVB) { transpose_item(P.w_kvb, 1024, 1024, (bf16*)(ws + WS_WTKVB), 128, 1, 0, P.kv_norm_g, scr, r, X.lane); continue; } r -= I_KVB;
            { const int n0 = 32 * r, dir = n0 >> 10, o = (n0 >> 9) & 1;
              transpose_item(P.filt_w3, 2048, 2048, (bf16*)(ws + WS_WT3), 128, 2, o - (dir + o) * 1024, nullptr, scr, r, X.lane); }
        }
    }
    for (int l = X.gw; l < SEQ; l += X.NGW) {
        const int j = X.lane;
        float feat;
        { const float pos = (float)l; const int i = j;
          if (i == 0) feat = pos / (float)(SEQ - 1);
          else if (i <= 32) { const int kk = (i - 1) & 15; const float fk = 1e-4f + (float)kk * ((15.0f - 1e-4f) / 15.0f);
              const float ph = (6.283185307179586f / (float)SEQ) * pos * fk; feat = (i <= 16) ? cosf(ph) : -sinf(ph); }
          else feat = 0.f; }
        float a = P.filt_b1[j];
#pragma unroll
        for (int i = 0; i < FEMB; ++i) a += __uint_as_float(__builtin_amdgcn_readlane(__float_as_uint(feat), i)) * P.filt_w1[i * 64 + j];
        const float fr = P.filt_freq[j];
        const float h1 = sinf(fr * a);
        float b2 = P.filt_b2[j];
#pragma unroll
        for (int i = 0; i < 64; ++i) b2 += __uint_as_float(__builtin_amdgcn_readlane(__float_as_uint(h1), i)) * P.filt_w2[i * 64 + j];
        const float h2 = sinf(fr * b2);
        ((bf16*)(ws + WS_H2))[(size_t)l * 128 + j] = (bf16)f2bf(h2);
    }
    for (int it = X.gw; it < 32 * 24; it += X.NGW) {
        const int kc = it / 24, nc = it % 24, n = nc * 256 + X.lane * 4;
        f32x4 a0 = {0.f, 0.f, 0.f, 0.f}, a1 = {0.f, 0.f, 0.f, 0.f};
#pragma unroll 8
        for (int kk = 0; kk < 32; ++kk) { const int k = kc * 32 + kk; const f32x4 w = __builtin_nontemporal_load((const f32x4*)(P.w_ada + (size_t)k * 6144 + n));
            const float c0 = P.c[k], c1 = P.c[1024 + k]; const float s0 = c0 * __builtin_amdgcn_rcpf(1.f + __expf(-c0)), s1 = c1 * __builtin_amdgcn_rcpf(1.f + __expf(-c1));
            a0 += w * s0; a1 += w * s1; }
        float* mp = (float*)(ws + WS_MODP);
        *(f32x4*)(mp + ((size_t)kc * 2 + 0) * 6144 + n) = a0; *(f32x4*)(mp + ((size_t)kc * 2 + 1) * 6144 + n) = a1;
    }
}

__device__ __forceinline__ void phase1(const Params& P, const Ctx& X) {
    unsigned char* ws = P.ws;
    float* modl = (float*)X.lds;
    const float* mp = (const float*)(ws + WS_MODP);
    f32x4 xv[8][4];
#pragma unroll
    for (int r = 0; r < 8; ++r) { const int m = X.gw + r * X.NGW;
        if (m < T) { const f32x4* xr = (const f32x4*)(P.x + (size_t)m * DM) + X.lane;
#pragma unroll
            for (int j = 0; j < 4; ++j) xv[r][j] = __builtin_nontemporal_load(xr + 64 * j); } }
    for (int i = X.tid; i < 4096; i += NTHR) { const int b = i >> 11, n = i & 2047;
        float part[32];
#pragma unroll
        for (int kc = 0; kc < 32; ++kc) part[kc] = mp[((size_t)kc * 2 + b) * 6144 + n];
        float s = P.b_ada[n];
#pragma unroll
        for (int kc = 0; kc < 32; ++kc) s += part[kc];
        modl[i] = s; }
    for (int i0 = X.vcu * 48; i0 < 2 * 6144; i0 += X.G * 48) { const int i = i0 + X.tid;
      if (X.tid < 48 && i < 2 * 6144) { const int b = i / 6144, n = i % 6144;
        float part[32];
#pragma unroll
        for (int kc = 0; kc < 32; ++kc) part[kc] = mp[((size_t)kc * 2 + b) * 6144 + n];
        float s2 = P.b_ada[n];
#pragma unroll
        for (int kc = 0; kc < 32; ++kc) s2 += part[kc];
        ((float*)(ws + WS_MOD))[i] = s2; } }
    __syncthreads();
#pragma unroll
    for (int r = 0; r < 8; ++r) { const int m = X.gw + r * X.NGW;
        if (m < T) { const int b = m / SEQ; const float* sh = modl + b * 2048; const float* sc = sh + 1024;
            unsigned long long* o8 = (unsigned long long*)(ws + WS_U1 + (size_t)(2 * (m % SEQ) + b) * DM * 2) + X.lane;
#pragma unroll
            for (int j = 0; j < 4; ++j) { const f32x4 v = xv[r][j]; const int c0 = 4 * X.lane + 256 * j;
                const float u0 = v.x * (1.f + sc[c0]) + sh[c0], u1 = v.y * (1.f + sc[c0 + 1]) + sh[c0 + 1], u2 = v.z * (1.f + sc[c0 + 2]) + sh[c0 + 2], u3 = v.w * (1.f + sc[c0 + 3]) + sh[c0 + 3];
                o8[64 * j] = (unsigned long long)pk2(u0, u1) | ((unsigned long long)pk2(u2, u3) << 32); } } }
#pragma unroll 4
    for (int m = X.gw + 8 * X.NGW; m < T; m += X.NGW) {
        const int b = m / SEQ; const float* sh = modl + b * 2048; const float* sc = sh + 1024;
        const f32x4* xr = (const f32x4*)(P.x + (size_t)m * DM) + X.lane;
        unsigned long long* o8 = (unsigned long long*)(ws + WS_U1 + (size_t)(2 * (m % SEQ) + b) * DM * 2) + X.lane;
#pragma unroll
        for (int j = 0; j < 4; ++j) { const f32x4 v = xr[64 * j]; const int c0 = 4 * X.lane + 256 * j;
            const float u0 = v.x * (1.f + sc[c0]) + sh[c0], u1 = v.y * (1.f + sc[c0 + 1]) + sh[c0 + 1], u2 = v.z * (1.f + sc[c0 + 2]) + sh[c0 + 2], u3 = v.w * (1.f + sc[c0 + 3]) + sh[c0 + 3];
            o8[64 * j] = (unsigned long long)pk2(u0, u1) | ((unsigned long long)pk2(u2, u3) << 32); }
    }
    __syncthreads();
}

__device__ __forceinline__ void krope_pass(const Params& P, const Ctx& X) {
    unsigned char* ws = P.ws;
    const int gt = X.vcu * NTHR + X.tid, NGT = X.G * NTHR;
    const float* krr = (const float*)(ws + WS_KRR); const float2* cs = (const float2*)(ws + WS_CS); bf16* kr = (bf16*)(ws + WS_KR);
    for (int i = gt; i < T * 16; i += NGT) { const int t = i >> 4, f = i & 15;
        const float x1 = krr[t * 32 + f], x2 = krr[t * 32 + 16 + f]; const float2 c = cs[i];
        kr[t * 32 + f] = (bf16)f2bf(x1 * c.x - x2 * c.y); kr[t * 32 + 16 + f] = (bf16)f2bf(x2 * c.x + x1 * c.y); }
}

__device__ __forceinline__ void phase5(const Params& P, const Ctx& X) {
    unsigned char* ws = P.ws;
    const bf16* hyot = (const bf16*)(ws + WS_HYOT); const bf16* aatt = (const bf16*)(ws + WS_AATT); bf16* ap = (bf16*)(ws + WS_APRIME);
    float* red = (float*)X.lds;
    for (int tile = X.vcu; tile < T / 64; tile += X.G) {
        const int t0 = tile * 64;
        { const int tl = X.tid & 63, cgp = X.tid >> 6; float v[64]; float ss = 0.f;
          unsigned char* raw = X.lds + 71680;
          { const int oct = X.tid & 7, c0 = X.tid >> 3; v4u tmp[8];
#pragma unroll
            for (int i = 0; i < 8; ++i) tmp[i] = *(const v4u*)(hyot + ((size_t)tile * 512 + c0 + 64 * i) * 64 + oct * 8);
#pragma unroll
            for (int i = 0; i < 8; ++i) *(v4u*)(raw + (c0 + 64 * i) * 144 + oct * 16) = tmp[i]; }
          __syncthreads();
#pragma unroll
          for (int i = 0; i < 64; ++i) { v[i] = __uint_as_float(((unsigned)*(const unsigned short*)(raw + (cgp * 64 + i) * 144 + tl * 2)) << 16); ss += v[i] * v[i]; }
          red[cgp * 64 + tl] = ss;
          __syncthreads();
          float tot = 0.f;
#pragma unroll
          for (int g = 0; g < 8; ++g) tot += red[g * 64 + tl];
          const float rs = __builtin_amdgcn_rsqf(tot * (1.0f / 512.0f) + EPS);
          const float* gg = P.hyena_out_g + cgp * 64;
          unsigned char* stg = X.lds + 4096;
          v4u* dst = (v4u*)(stg + (size_t)tl * 1040 + cgp * 128);
#pragma unroll
          for (int i = 0; i < 8; ++i) { v4u o; o.x = pk2(v[8 * i] * rs * gg[8 * i], v[8 * i + 1] * rs * gg[8 * i + 1]); o.y = pk2(v[8 * i + 2] * rs * gg[8 * i + 2], v[8 * i + 3] * rs * gg[8 * i + 3]);
              o.z = pk2(v[8 * i + 4] * rs * gg[8 * i + 4], v[8 * i + 5] * rs * gg[8 * i + 5]); o.w = pk2(v[8 * i + 6] * rs * gg[8 * i + 6], v[8 * i + 7] * rs * gg[8 * i + 7]); dst[i] = o; }
          __syncthreads();
#pragma unroll
          for (int k = 0; k < 8; ++k) { const int r = X.wave + 8 * k; const v4u o = *(const v4u*)(stg + (size_t)r * 1040 + X.lane * 16);
              *(v4u*)(ap + (size_t)(t0 + r) * DM + 512 + X.lane * 8) = o; }
          __syncthreads(); }
    }
}

struct Y1Raw { f32x4 x[4]; v2u m[4]; };
__device__ __forceinline__ void load_raw(const Params& P, const unsigned char* ws, int m, int lane, Y1Raw& r) {
    const f32x4* xr = (const f32x4*)(P.x + (size_t)m * DM) + lane;
    const v2u* mr = (const v2u*)(ws + WS_MIXED + (size_t)m * DM * 2) + lane;
#pragma unroll
    for (int j = 0; j < 4; ++j) { r.x[j] = __builtin_nontemporal_load(xr + 64 * j); r.m[j] = mr[64 * j]; }
}
__device__ __forceinline__ void make_y1(const Y1Raw& r, int lane, const float* mod_b, f32x4 (&y)[4]) {
    const float* g1 = mod_b + 2 * 1024;
#pragma unroll
    for (int j = 0; j < 4; ++j) { const f32x4 xv = r.x[j]; const v2u mw = r.m[j]; const f32x4 gv = *(const f32x4*)(g1 + 4 * lane + 256 * j);
        y[j].x = DN_ALPHA * xv.x + gv.x * bf_lo(mw.x); y[j].y = DN_ALPHA * xv.y + gv.y * bf_hi(mw.x); y[j].z = DN_ALPHA * xv.z + gv.z * bf_lo(mw.y); y[j].w = DN_ALPHA * xv.w + gv.w * bf_hi(mw.y); }
}
__device__ __forceinline__ void load_y1(const Params& P, const unsigned char* ws, int m, int lane, const float* mod_b, f32x4 (&y)[4]) {
    Y1Raw r; load_raw(P, ws, m, lane, r); make_y1(r, lane, mod_b, y);
}
__device__ __forceinline__ void row_stats(const f32x4 (&y)[4], float& mean, float& rstd) {
    float s = 0.f, q = 0.f;
#pragma unroll
    for (int j = 0; j < 4; ++j) { s += (y[j].x + y[j].y) + (y[j].z + y[j].w); q += (y[j].x * y[j].x + y[j].y * y[j].y) + (y[j].z * y[j].z + y[j].w * y[j].w); }
#pragma unroll
    for (int o = 1; o < 64; o <<= 1) { s += __shfl_xor(s, o); q += __shfl_xor(q, o); }
    mean = s * (1.0f / DM); const float var = fmaxf(q * (1.0f / DM) - mean * mean, 0.f); rstd = __builtin_amdgcn_rsqf(var + EPS);
}
__device__ __forceinline__ void phase7(const Params& P, const Ctx& X) {
    unsigned char* ws = P.ws;
    float* wr = (float*)X.lds;
    for (int c = X.tid; c < 1024; c += NTHR) {
        const f32x4* rp = (const f32x4*)(P.w_router + (size_t)c * 16);
        const f32x4 r0 = rp[0], r1 = rp[1], r2 = rp[2], r3 = rp[3];
        wr[0 * 1024 + c] = r0.x; wr[1 * 1024 + c] = r0.y; wr[2 * 1024 + c] = r0.z; wr[3 * 1024 + c] = r0.w;
        wr[4 * 1024 + c] = r1.x; wr[5 * 1024 + c] = r1.y; wr[6 * 1024 + c] = r1.z; wr[7 * 1024 + c] = r1.w;
        wr[8 * 1024 + c] = r2.x; wr[9 * 1024 + c] = r2.y; wr[10 * 1024 + c] = r2.z; wr[11 * 1024 + c] = r2.w;
        wr[12 * 1024 + c] = r3.x; wr[13 * 1024 + c] = r3.y; wr[14 * 1024 + c] = r3.z; wr[15 * 1024 + c] = r3.w; }
    __syncthreads();
    const float* mod = (const float*)(ws + WS_MOD);
    int m = X.gw;
    Y1Raw raw; if (m < T) load_raw(P, ws, m, X.lane, raw);
    f32x4 g1c[4], b1c[4];
#pragma unroll
    for (int j = 0; j < 4; ++j) { g1c[j] = *(const f32x4*)(P.ln1_g + 4 * X.lane + 256 * j); b1c[j] = *(const f32x4*)(P.ln1_b + 4 * X.lane + 256 * j); }
    for (; m < T; m += X.NGW) {
        const int b = m / SEQ; const float* mb = mod + b * 6144;
        f32x4 y[4]; make_y1(raw, X.lane, mb, y);
        if (m + X.NGW < T) load_raw(P, ws, m + X.NGW, X.lane, raw);
        float mean, rstd; row_stats(y, mean, rstd);
        if (X.lane == 0) ((float2*)(ws + WS_STATS))[m] = make_float2(mean, rstd);
        typedef float f32x2_ __attribute__((ext_vector_type(2)));
        f32x2_ lgp[16];
#pragma unroll
        for (int e = 0; e < 16; ++e) lgp[e] = (f32x2_){0.f, 0.f};
        unsigned long long* o8 = (unsigned long long*)(ws + WS_U2 + (size_t)m * DM * 2) + X.lane;
        unsigned long long* x8 = (unsigned long long*)(ws + WS_X1 + (size_t)m * DM * 2) + X.lane;
#pragma unroll
        for (int j = 0; j < 4; ++j) { const int c0 = 4 * X.lane + 256 * j;
            const f32x4 g = g1c[j], bb = b1c[j], sh = *(const f32x4*)(mb + 3 * 1024 + c0), sc = *(const f32x4*)(mb + 4 * 1024 + c0);
            f32x4 u; u = ((y[j] - mean) * rstd * g + bb);
            x8[64 * j] = (unsigned long long)pk2(u.x, u.y) | ((unsigned long long)pk2(u.z, u.w) << 32);
            u = u * (sc + 1.0f) + sh;
            o8[64 * j] = (unsigned long long)pk2(u.x, u.y) | ((unsigned long long)pk2(u.z, u.w) << 32);
            { const f32x2_ ulo = {u.x, u.y}, uhi = {u.z, u.w};
#pragma unroll
              for (int e = 0; e < 16; ++e) { const f32x4 w = *(const f32x4*)(wr + e * 1024 + c0); const f32x2_ wlo = {w.x, w.y}, whi = {w.z, w.w};
                  lgp[e] = __builtin_elementwise_fma(ulo, wlo, lgp[e]); lgp[e] = __builtin_elementwise_fma(uhi, whi, lgp[e]); } } }
        float lg[16];
#pragma unroll
        for (int e = 0; e < 16; ++e) lg[e] = lgp[e].x + lgp[e].y;
#pragma unroll
        for (int n = 8, B = 32; n >= 1; n >>= 1, B >>= 1) { const bool up = (X.lane & B) != 0;
#pragma unroll
            for (int i = 0; i < n; ++i) { const float lo = lg[i], hi = lg[i + n]; const float send = up ? lo : hi, keep = up ? hi : lo; lg[i] = keep + __shfl_xor(send, B); } }
        float lv = lg[0]; lv += __shfl_xor(lv, 2); lv += __shfl_xor(lv, 1);
        float mx = lv;
#pragma unroll
        for (int o = 4; o < 64; o <<= 1) mx = fmaxf(mx, __shfl_xor(mx, o));
        const float ex = __expf(lv - mx); float den = ex;
#pragma unroll
        for (int o = 4; o < 64; o <<= 1) den += __shfl_xor(den, o);
        const int e = ((X.lane >> 5) & 1) * 8 + ((X.lane >> 4) & 1) * 4 + ((X.lane >> 3) & 1) * 2 + ((X.lane >> 2) & 1);
        if ((X.lane & 3) == 0) ((float*)(ws + WS_AFF))[(size_t)m * 16 + e] = ex * __builtin_amdgcn_rcpf(den);
    }
    __syncthreads();
}

__device__ __forceinline__ int block_excl_scan(int v, int& total, volatile int* sh, const Ctx& X) {
    int inc = v;
#pragma unroll
    for (int o = 1; o < 64; o <<= 1) { const int t = __shfl_up(inc, o); if (X.lane >= o) inc += t; }
    __syncthreads();
    if (X.lane == 63) sh[X.wave] = inc;
    __syncthreads();
    int base = 0, tot = 0;
#pragma unroll
    for (int w = 0; w < NWAVES; ++w) { const int c = sh[w]; if (w < X.wave) base += c; tot += c; }
    total = tot;
    return base + inc - v;
}
__device__ __forceinline__ void topk_be(const Params& P, const Ctx& X, int be) {
    unsigned char* ws = P.ws;
    const int b = be >> 4, e = be & 15;
    volatile int* sh = (volatile int*)X.lds;
    const float* aff = (const float*)(ws + WS_AFF) + ((size_t)b * SEQ + 16 * X.tid) * 16 + e;
    unsigned u[16];
#pragma unroll
    for (int i = 0; i < 16; ++i) u[i] = __float_as_uint(aff[i * 16]);
    unsigned Tv = 0u;
    for (int bit = 30; bit >= 0; --bit) {
        const unsigned cand = Tv | (1u << bit);
        int c = 0;
#pragma unroll
        for (int i = 0; i < 16; ++i) c += __popcll(__ballot(u[i] >= cand));
        volatile int* slot = sh + 16 + 16 * (bit & 1);
        if (X.lane == 0) slot[X.wave] = c;
        __syncthreads();
        const int4 s0 = *(const int4*)(const void*)(X.lds + 4 * (16 + 16 * (bit & 1))), s1 = *(const int4*)(const void*)(X.lds + 4 * (16 + 16 * (bit & 1)) + 16);
        const int tot = ((s0.x + s0.y) + (s0.z + s0.w)) + ((s1.x + s1.y) + (s1.z + s1.w));
        if (tot >= CAP) Tv = cand;
    }
    int ngt = 0, neq = 0;
#pragma unroll
    for (int i = 0; i < 16; ++i) { ngt += (u[i] > Tv) ? 1 : 0; neq += (u[i] == Tv) ? 1 : 0; }
    int tot_gt, tot_eq;
    const int eq_before = block_excl_scan(neq, tot_eq, sh, X);
    (void)block_excl_scan(ngt, tot_gt, sh, X);
    const int need_eq = CAP - tot_gt;
    int nsel = 0; unsigned selmask = 0u; int er = eq_before;
#pragma unroll
    for (int i = 0; i < 16; ++i) { bool sel = u[i] > Tv; if (u[i] == Tv) { sel = er < need_eq; ++er; } if (sel) { selmask |= 1u << i; ++nsel; } }
    int tot_sel;
    int slot0 = block_excl_scan(nsel, tot_sel, sh, X);
    int* idx = (int*)(ws + WS_IDX) + be * CAP; float* gate = (float*)(ws + WS_GATE) + be * CAP; int* inv = (int*)(ws + WS_INV) + ((size_t)b * SEQ + 16 * X.tid) * 16 + e;
#pragma unroll
    for (int i = 0; i < 16; ++i) { const bool sel = (selmask >> i) & 1u;
        if (sel) { idx[slot0] = 16 * X.tid + i; gate[slot0] = __uint_as_float(u[i]); }
        inv[i * 16] = sel ? slot0 : -1;
        slot0 += sel ? 1 : 0; }
    __syncthreads();
}

__device__ __forceinline__ void transpose_item64(const float* __restrict__ W, int ldw, bf16* WT, int ldk, int nmul, int nadd, float* scr, int k0, int n0, int lane) {
    f32x4 v[16];
    const int kr = lane >> 4, nc = 4 * (lane & 15);
#pragma unroll
    for (int i = 0; i < 16; ++i) v[i] = __builtin_nontemporal_load((const f32x4*)(W + (size_t)(k0 + 4 * i + kr) * ldw + n0 + nc));
#pragma unroll
    for (int i = 0; i < 16; ++i) { const int k = 4 * i + kr;
        scr[(nc + 0) * 65 + k] = v[i].x; scr[(nc + 1) * 65 + k] = v[i].y; scr[(nc + 2) * 65 + k] = v[i].z; scr[(nc + 3) * 65 + k] = v[i].w; }
    asm volatile("s_waitcnt lgkmcnt(0)" ::: "memory");
    const int c = lane & 7;
#pragma unroll
    for (int j = 0; j < 8; ++j) { const int n = 8 * j + (lane >> 3); const float* sp = scr + n * 65 + 8 * c;
        v4u o; o.x = pk2(sp[0], sp[1]); o.y = pk2(sp[2], sp[3]); o.z = pk2(sp[4], sp[5]); o.w = pk2(sp[6], sp[7]);
        *(v4u*)(WT + (size_t)((n0 + n) * nmul + nadd) * ldk + k0 + 8 * c) = o; }
    asm volatile("s_waitcnt lgkmcnt(0)" ::: "memory");
}
__device__ __forceinline__ void expert_weight_copies(const Params& P, const Ctx& X, int wg_rel, int nwg) {
    unsigned char* ws = P.ws;
    float* scr = (float*)(X.lds + X.wave * 16640);
    constexpr int I_E = 16 * 16;
    const int gw = wg_rel * NWAVES + X.wave, ngw = nwg * NWAVES;
    for (int it = gw; it < 48 * I_E; it += ngw) {
        const int mat = it / I_E, r = it % I_E, e = mat / 3, which = mat % 3;
        const int pnl = r >> 3, w8 = r & 7, k0 = 256 * (pnl >> 3) + 64 * (w8 >> 1), n0 = 128 * (pnl & 7) + 64 * (w8 & 1);
        if (which == 0) transpose_item64(P.w_gate + (size_t)e * 1048576, 1024, (bf16*)(ws + WS_WTGU) + (size_t)e * 2048 * 1024, 1024, 2, 0, scr, k0, n0, X.lane);
        else if (which == 1) transpose_item64(P.w_up + (size_t)e * 1048576, 1024, (bf16*)(ws + WS_WTGU) + (size_t)e * 2048 * 1024, 1024, 2, 1, scr, k0, n0, X.lane);
        else transpose_item64(P.w_down + (size_t)e * 1048576, 1024, (bf16*)(ws + WS_WTD) + (size_t)e * 1024 * 1024, 1024, 1, 0, scr, k0, n0, X.lane);
    }
}

__device__ __forceinline__ void phase9(const Params& P, const Ctx& X) {
    unsigned char* ws = P.ws;
    const int* idx = (const int*)(ws + WS_IDX);
#pragma unroll 4
    for (int r = X.gw; r < 32 * CAP; r += X.NGW) { const int b = r >> 14; const int s = idx[r];
        const v4u* src = (const v4u*)(ws + WS_U2 + ((size_t)b * SEQ + s) * DM * 2) + X.lane; v4u* dst = (v4u*)(ws + WS_XE + (size_t)r * DM * 2) + X.lane;
        dst[0] = src[0]; dst[64] = src[64]; }
}

struct P12Row { v2u yr[4][4]; v2u x1[4]; int cnt; unsigned rest; };
__device__ __forceinline__ void p12_issue(const unsigned char* ws, const Ctx& X, int m, int invm, P12Row& R) {
    const int b = m / SEQ;
    unsigned msk = (unsigned)(__ballot(invm >= 0) & 0xffffull);
    R.cnt = __popc(msk);
    int sl[4];
#pragma unroll
    for (int i = 0; i < 4; ++i) { sl[i] = -1; if (msk) { const int e = __ffs(msk) - 1; msk &= msk - 1; sl[i] = (b * 16 + e) * CAP + __shfl(invm, e); } }
    R.rest = msk;
#pragma unroll
    for (int i = 0; i < 4; ++i) if (R.cnt > i) { const v2u* p = (const v2u*)(ws + WS_YE + (size_t)sl[i] * DM * 2) + X.lane;
#pragma unroll
        for (int j = 0; j < 4; ++j) R.yr[i][j] = __builtin_nontemporal_load(p + 64 * j); }
    const v2u* xp = (const v2u*)(ws + WS_X1 + (size_t)m * DM * 2) + X.lane;
#pragma unroll
    for (int j = 0; j < 4; ++j) R.x1[j] = __builtin_nontemporal_load(xp + 64 * j);
}
__device__ __forceinline__ void phase12(const Params& P, const Ctx& X) {
    unsigned char* ws = P.ws;
    const float* mod = (const float*)(ws + WS_MOD); const int* inv = (const int*)(ws + WS_INV);
    int m = X.gw;
    int inv0 = (m < T && X.lane < 16) ? inv[(size_t)m * 16 + X.lane] : -1;
    int inv1 = (m + X.NGW < T && X.lane < 16) ? inv[(size_t)(m + X.NGW) * 16 + X.lane] : -1;
    P12Row cur, nxt;
    if (m < T) p12_issue(ws, X, m, inv0, cur);
    f32x4 g2c[4], b2c[4];
#pragma unroll
    for (int j = 0; j < 4; ++j) { g2c[j] = *(const f32x4*)(P.ln2_g + 4 * X.lane + 256 * j); b2c[j] = *(const f32x4*)(P.ln2_b + 4 * X.lane + 256 * j); }
    for (; m < T; m += X.NGW) {
        const int b = m / SEQ; const float* mb = mod + b * 6144;
        const int nm = m + X.NGW;
        const int inv2 = (nm + X.NGW < T && X.lane < 16) ? inv[(size_t)(nm + X.NGW) * 16 + X.lane] : -1;
        if (nm < T) p12_issue(ws, X, nm, inv1, nxt);
        f32x4 y[4];
#pragma unroll
        for (int j = 0; j < 4; ++j) { y[j].x = bf_lo(cur.x1[j].x); y[j].y = bf_hi(cur.x1[j].x); y[j].z = bf_lo(cur.x1[j].y); y[j].w = bf_hi(cur.x1[j].y); }
        f32x4 f[4];
#pragma unroll
        for (int j = 0; j < 4; ++j) f[j] = (f32x4){0.f, 0.f, 0.f, 0.f};
#pragma unroll
        for (int i = 0; i < 4; ++i) if (cur.cnt > i) {
#pragma unroll
            for (int j = 0; j < 4; ++j) { const v2u w = cur.yr[i][j]; f[j].x += bf_lo(w.x); f[j].y += bf_hi(w.x); f[j].z += bf_lo(w.y); f[j].w += bf_hi(w.y); } }
        unsigned msk = cur.rest;
        while (msk) { const int e = __ffs(msk) - 1; msk &= msk - 1; const int r = (b * 16 + e) * CAP + __shfl(inv0, e);
            const v2u* p = (const v2u*)(ws + WS_YE + (size_t)r * DM * 2) + X.lane;
#pragma unroll
            for (int j = 0; j < 4; ++j) { const v2u w = p[64 * j]; f[j].x += bf_lo(w.x); f[j].y += bf_hi(w.x); f[j].z += bf_lo(w.y); f[j].w += bf_hi(w.y); } }
#pragma unroll
        for (int j = 0; j < 4; ++j) { const int c0 = 4 * X.lane + 256 * j;
            const f32x4 g2 = *(const f32x4*)(mb + 5 * 1024 + c0);
            y[j] = y[j] * DN_ALPHA + g2 * f[j]; }
        float mean, rstd; row_stats(y, mean, rstd);
#pragma unroll
        for (int j = 0; j < 4; ++j) y[j] = y[j] - mean;
        f32x4* orow = (f32x4*)(P.out + (size_t)m * DM) + X.lane;
#pragma unroll
        for (int j = 0; j < 4; ++j) { const f32x4 g = g2c[j], bb = b2c[j];
            __builtin_nontemporal_store(y[j] * rstd * g + bb, orow + 64 * j); }
        cur = nxt; inv0 = inv1; inv1 = inv2;
    }
}

#ifndef DBG_LAST_PHASE
#define DBG_LAST_PHASE 99
#endif
#define XB_TMO      128
#define XB_XCNT(j)  (256  + 64 * (j))
#define XB_XSUB(j)  (1280 + 64 * (j))
#define XB_XGEN(j)  (2304 + 64 * (j))
#define XB_TOP      3328
#define XB_TOPGEN   3392
#define XCD_BAR_WORDS 3456
#define XB_SPIN_CAP (1u << 18)

__device__ __forceinline__ unsigned xb_ld(unsigned* p)              { return __hip_atomic_load(p, __ATOMIC_RELAXED, __HIP_MEMORY_SCOPE_AGENT); }
__device__ __forceinline__ unsigned xb_add(unsigned* p, unsigned v) { return __hip_atomic_fetch_add(p, v, __ATOMIC_RELAXED, __HIP_MEMORY_SCOPE_AGENT); }
__device__ __forceinline__ unsigned xb_xcc_id() { return (unsigned)__builtin_amdgcn_s_getreg((3 << 11) | 20) & 0xFu; }
#define XB_SPIN(cond, bar) do { unsigned _sp = 0; while (cond) { __builtin_amdgcn_s_sleep(1); \
    if ((++_sp & 255u) == 0u) { if (xb_ld(&(bar)[XB_TMO])) break; if (_sp > XB_SPIN_CAP) { atomicAdd(&(bar)[XB_TMO], 1u); break; } } } } while (0)

struct XcdBarrier {
    unsigned* bar; unsigned x;
    volatile LAS unsigned* st;
};

__device__ __forceinline__ XcdBarrier xcd_barrier_post(unsigned* bar, volatile LAS unsigned* st) {
    XcdBarrier b; b.bar = bar; b.x = xb_xcc_id(); b.st = st;
    if (threadIdx.x == 0) (void)xb_add(&bar[XB_XCNT(b.x)], 1u);
    return b;
}
__device__ __forceinline__ void xcd_barrier_complete(unsigned* bar, unsigned x, unsigned& nloc, unsigned& nx) {
    const unsigned G = gridDim.x * gridDim.y * gridDim.z;
    unsigned sum, cnt, mine, sp = 0u;
    for (;;) {
        sum = 0u; cnt = 0u; mine = 0u;
#pragma unroll
        for (unsigned j = 0; j < 16; ++j) { const unsigned c = xb_ld(&bar[XB_XCNT(j)]); sum += c; cnt += (c > 0u) ? 1u : 0u; mine = (j == x) ? c : mine; }
        if (sum == G) break;
        __builtin_amdgcn_s_sleep(1);
        if ((++sp & 255u) == 0u) { if (xb_ld(&bar[XB_TMO])) break; if (sp > XB_SPIN_CAP) { atomicAdd(&bar[XB_TMO], 1u); break; } }
    }
    nloc = mine > 0u ? mine : 1u; nx = cnt > 0u ? cnt : 1u;
}

__device__ __forceinline__ void xcd_barrier(const XcdBarrier& b) {
    asm volatile("s_waitcnt vmcnt(0)" ::: "memory");
    __syncthreads();
    if (threadIdx.x == 0) {
        unsigned* bar = b.bar;
        __builtin_amdgcn_s_waitcnt(0);
        unsigned nloc = b.st[0], nx = b.st[1];
        if (nloc == 0u) { xcd_barrier_complete(bar, b.x, nloc, nx); b.st[0] = nloc; b.st[1] = nx; }
        const unsigned old = xb_add(&bar[XB_XSUB(b.x)], 1u);
        const unsigned gen = old / nloc;
        if (old + 1u == (gen + 1u) * nloc) {
            __builtin_amdgcn_fence(__ATOMIC_RELEASE, "agent");
            asm volatile("s_waitcnt vmcnt(0)" ::: "memory");
            const unsigned og = xb_add(&bar[XB_TOP], 1u);
            const unsigned tg = og / nx;
            if (og + 1u == (tg + 1u) * nx) xb_add(&bar[XB_TOPGEN], 1u);
            else XB_SPIN(xb_ld(&bar[XB_TOPGEN]) == tg, bar);
            __builtin_amdgcn_fence(__ATOMIC_ACQUIRE, "agent");
            xb_add(&bar[XB_XGEN(b.x)], 1u);
            asm volatile("s_waitcnt vmcnt(0)" ::: "memory");
        } else {
            XB_SPIN(xb_ld(&bar[XB_XGEN(b.x)]) == gen, bar);
            __builtin_amdgcn_fence(__ATOMIC_ACQUIRE, "agent");
            asm volatile("s_waitcnt vmcnt(0)" ::: "memory");
        }
    }
    __syncthreads();
}

#ifndef ATTN_V2
#define ATTN_V2 1
#endif
#ifndef P6_ALIGN
#define P6_ALIGN true
#endif
#ifndef EXP_WGM
#define EXP_WGM 8
#endif
#ifndef HY16
#define HY16 1
#endif
#ifndef REP_P0
#define REP_P0 1
#endif
#ifndef REP_P1
#define REP_P1 1
#endif
#ifndef REP_P2
#define REP_P2 1
#endif
#ifndef REP_P3
#define REP_P3 1
#endif
#ifndef REP_P4
#define REP_P4 1
#endif
#ifndef REP_P5
#define REP_P5 1
#endif
#ifndef REP_P6
#define REP_P6 1
#endif
#ifndef REP_P7
#define REP_P7 1
#endif
#ifndef REP_P8
#define REP_P8 1
#endif
#ifndef REP_P9
#define REP_P9 1
#endif
#ifndef REP_P10
#define REP_P10 1
#endif
#ifndef REP_P11
#define REP_P11 1
#endif
#ifndef REP_P12
#define REP_P12 1
#endif
#ifndef REP_HY
#define REP_HY 1
#endif
typedef const __attribute__((address_space(4))) Params* KParams;
__device__ __forceinline__ KParams launder_kp(KParams p) { asm volatile("" : "+s"(p)); return p; }
__device__ __forceinline__ Params load_params(KParams p) { Params r{};
#if defined(__HIP_DEVICE_COMPILE__)
    r = *launder_kp(p);
#endif
    return r; }
#define LOADP() const Params P = load_params(kp); unsigned char* ws = P.ws; MKCTX()
__global__ void __launch_bounds__(NTHR, 2) fwd_megakernel(Params Pv) {
    extern __shared__ __attribute__((aligned(16))) unsigned char lds[];
    cg::grid_group grid = cg::this_grid();
    const int wave0 = __builtin_amdgcn_readfirstlane(threadIdx.x >> 6);
#define MKCTX() Ctx X; { int w_ = wave0; asm volatile("" : "+s"(w_)); X.wave = w_; unsigned m_ = ~0u; asm volatile("" : "+s"(m_)); X.lane = __builtin_amdgcn_mbcnt_hi(m_, __builtin_amdgcn_mbcnt_lo(m_, 0u)); X.tid = w_ * 64 + X.lane; \
    X.G = gridDim.x; const int bx_ = blockIdx.x; X.vcu = (X.G % 8 == 0) ? (bx_ % 8) * (X.G / 8) + bx_ / 8 : bx_; X.gw = X.vcu * NWAVES + X.wave; X.NGW = X.G * NWAVES; X.lds = lds; }
    KParams kp = (KParams)__builtin_amdgcn_kernarg_segment_ptr();
    volatile LAS unsigned* bar_st = (volatile LAS unsigned*)((LAS unsigned char*)lds + (LDS_BYTES - 64));
    if (threadIdx.x < 2) bar_st[threadIdx.x] = 0u;
    __syncthreads();
    XcdBarrier xbar; xbar.bar = nullptr; xbar.x = 0; xbar.st = bar_st;
    PG8_LAS unsigned char* ring = (PG8_LAS unsigned char*)lds;

    for (int rep = 0; rep < REP_P0; ++rep) {
    { LOADP(); if (blockIdx.x == 0) for (int i = X.tid; i < XCD_BAR_WORDS; i += NTHR) ((unsigned*)(ws + WS_BAR))[i] = 0u; phase0(P, X); }
    grid.sync(); if (rep + 1 == REP_P0) { LOADP(); (void)X; xbar = xcd_barrier_post((unsigned*)(ws + WS_BAR), bar_st); }
    }
    for (int rep = 0; rep < REP_P1; ++rep) {
    { LOADP(); (void)ws; phase1(P, X); }
    xcd_barrier(xbar);
    }
    for (int rep = 0; rep < REP_P2; ++rep) {
    { LOADP();
        { pg8::Gemm g{(const pg8::bf16_t*)(ws + WS_U1), (const pg8::bf16_t*)(ws + WS_WTIN), T, IN_PAD, 1024, 1024, 1024, 1 << 30, 1, 0, nullptr, 0, 0};
          pg8::StaticOrder S; S.init(T, IN_PAD, X.G, (int)blockIdx.x, 4);
          epi::EpiIn E{(pg8::bf16_t*)(ws + WS_CQ), (pg8::bf16_t*)(ws + WS_CKV), (float*)(ws + WS_KRR), (pg8::bf16_t*)(ws + WS_HYT), (float*)(ws + (rep ? WS_FFTS : WS_SSQQ)), (float*)(ws + (rep ? WS_FFTS + 65536 : WS_SSQKV)), ring + pg8::STAGE_BYTES};
          pg8::gemm_phase<epi::EpiIn, pg8::StaticOrder, true, true>(ring, g, S, E, X.tid); }
        __syncthreads();
        { pg8::Gemm g{(const pg8::bf16_t*)(ws + WS_H2), (const pg8::bf16_t*)(ws + WS_WT3), SEQ, 2048, 128, 128, 128, 1 << 30, 1, 0, nullptr, 0, 0};
          pg8::StaticOrder S; S.init(SEQ, 2048, X.G, (int)blockIdx.x);
          epi::EpiFilt E{(unsigned*)(ws + WS_KT), P.filt_b3, P.hyena_decay};
          pg8::gemm_phase<epi::EpiFilt, pg8::StaticOrder, true, true>(ring, g, S, E, X.tid); }
    }
    xcd_barrier(xbar);
    }
    for (int rep = 0; rep < REP_P3; ++rep) {
    { LOADP();
        { pg8::Gemm g{(const pg8::bf16_t*)(ws + WS_CQ), (const pg8::bf16_t*)(ws + WS_WTQB), T, 768, 256, 256, 256, 1 << 30, 1, 0, nullptr, 0, 0};
          pg8::StaticOrder S; S.init(T, 768, X.G, (int)blockIdx.x);
          epi::EpiRowScale E{(pg8::bf16_t*)(ws + WS_Q), 768, (const float*)(ws + WS_SSQQ), 1.0f / 256.0f, ATTN_V2 ? attn2::C2 : 1.0f};
          pg8::gemm_phase<epi::EpiRowScale, pg8::StaticOrder, true, true>(ring, g, S, E, X.tid); }
        __syncthreads();
        { pg8::Gemm g{(const pg8::bf16_t*)(ws + WS_CKV), (const pg8::bf16_t*)(ws + WS_WTKVB), T, 1024, 128, 128, 128, 1 << 30, 1, 0, nullptr, 0, 0};
          pg8::StaticOrder S; S.init(T, 1024, X.G, (int)blockIdx.x);
          epi::EpiRowScale E{(pg8::bf16_t*)(ws + WS_KV), 1024, (const float*)(ws + WS_SSQKV), 1.0f / 128.0f, 1.0f};
          pg8::gemm_phase<epi::EpiRowScale, pg8::StaticOrder, true, true>(ring, g, S, E, X.tid); }
        __syncthreads();
        krope_pass(P, X);
        __syncthreads();
#if HY16
        hy16::build_tables((hy16::h2*)(lds + hy16::LDS_T2), (hy16::h2*)(lds + hy16::LDS_T3), (const hy16::cf*)(ws + WS_TW), X.tid);
        hy16::h2 w1a[16], w1b[16]; hy16::load_tw1((const hy16::cf*)(ws + WS_TW), X.tid, w1a, w1b);
        __syncthreads();
        if ((X.tid >> 6) < 4) __builtin_amdgcn_s_setprio(2);
        for (int rh = 0; rh < REP_HY; ++rh)
        for (int c = X.vcu; c < HW; c += X.G) {
            hy16::hyena_channel(c, lds, (const hy16::bf16_t*)(ws + WS_HYT), (const hy16::bf16_t*)(ws + WS_KT), P.conv_w, P.conv_b, P.hyena_bias,
                                w1a, w1b, (hy16::bf16_t*)(ws + WS_HYOT), X.tid);
        }
        __builtin_amdgcn_s_setprio(0);
    }
#else
        { hy::cf* twl = (hy::cf*)(lds + hy::ZELEMS * 8);
          for (int i = X.tid; i < 1024; i += NTHR) twl[i] = ((const hy::cf*)(ws + WS_TW))[i]; }
        __syncthreads();
        for (int rh = 0; rh < REP_HY; ++rh)
        for (int c = X.vcu; c < HW; c += X.G) {
            unsigned char* fs = ws + WS_FFTS + (size_t)blockIdx.x * FFTS_PER_WG;
            hy::hyena_channel(c, (hy::cf*)lds, (const hy::cf*)(lds + hy::ZELEMS * 8), (const hy::bf16_t*)(ws + WS_HYT), (const hy::bf16_t*)(ws + WS_KT), P.conv_w, P.conv_b, P.hyena_bias,
                              (hy::cf*)fs, (hy::cf*)(fs + 256 * 1024), (hy::bf16_t*)(ws + WS_HYOT), X.tid);
        }
    }
#endif
    xcd_barrier(xbar);
    }
    for (int rep = 0; rep < REP_P4; ++rep) {
    { LOADP();
        phase5(P, X);
        for (int u = X.vcu; u < BATCH * NH * (SEQ / 256); u += X.G) {
            const int bh = u >> 5, qb = u & 31, b = bh >> 3, h = bh & 7;
#if ATTN_V2
#ifdef ATTN_PRIO
            if (X.wave < 4) __builtin_amdgcn_s_setprio(ATTN_PRIO);
#endif
            attn2::attn_unit<8>(b, h, qb, (const attn2::bf16*)(ws + WS_Q), (const attn2::bf16*)(ws + WS_KV), (const attn2::bf16*)(ws + WS_KR), (const float*)(ws + WS_CS),
                                (attn2::bf16*)(ws + WS_APRIME), (float*)(ws + WS_SSQQ), (char*)lds, X.tid);
#ifdef ATTN_PRIO
            __builtin_amdgcn_s_setprio(0);
#endif
#else
            attn::attn_unit((const attn::bf16_t*)(ws + WS_Q), (const attn::bf16_t*)(ws + WS_KV), (const attn::bf16_t*)(ws + WS_KR), (const float*)(ws + WS_CS),
                            (attn::bf16_t*)(ws + WS_AATT), h, (long)b * SEQ + qb * 256, (long)b * SEQ, SEQ, (char*)lds, X.tid);
#endif
        }
    }
    xcd_barrier(xbar);
    }
    for (int rep = 0; rep < REP_P6; ++rep) {
    { LOADP();
        pg8::Gemm g{(const pg8::bf16_t*)(ws + WS_APRIME), (const pg8::bf16_t*)(ws + WS_WTO), T, 1024, 1024, 1024, 1024, 1 << 30, 1, 0, nullptr, 0, 0};
        pg8::StaticOrder S; S.init(T, 1024, X.G, (int)blockIdx.x);
        epi::EpiOut E{(pg8::bf16_t*)(ws + WS_MIXED), 1024, (const float*)(ws + WS_SSQQ)};
        pg8::gemm_phase<epi::EpiOut, pg8::StaticOrder, P6_ALIGN, true>(ring, g, S, E, X.tid);
    }
    xcd_barrier(xbar);
    }
    for (int rep = 0; rep < REP_P7; ++rep) {
    { LOADP(); (void)ws; phase7(P, X); }
    xcd_barrier(xbar);
    }
    for (int rep = 0; rep < REP_P8; ++rep) {
    { LOADP();
#ifndef REP_TOPK
#define REP_TOPK 1
#endif
#ifndef REP_CONV
#define REP_CONV 1
#endif
        if (X.G >= 64) { if (blockIdx.x < 32) { for (int q = 0; q < REP_TOPK; ++q) topk_be(P, X, blockIdx.x); } else { for (int q = 0; q < REP_CONV; ++q) expert_weight_copies(P, X, blockIdx.x - 32, X.G - 32); } }
        else { for (int be = blockIdx.x; be < 32; be += X.G) topk_be(P, X, be); expert_weight_copies(P, X, blockIdx.x, X.G); }
    }
    xcd_barrier(xbar);
    }
    for (int rep = 0; rep < REP_P10; ++rep) {
    { LOADP();
        pg8::Gemm g{(const pg8::bf16_t*)(ws + WS_U2), (const pg8::bf16_t*)(ws + WS_WTGU), 32 * CAP, 2048, 1024, 1024, 1024, 4, 16, (size_t)2048 * 1024 * 2, (const int*)(ws + WS_IDX), 14, SEQ};
        pg8::StaticOrder S; S.init(32 * CAP, 2048, X.G, (int)blockIdx.x, EXP_WGM);
        epi::EpiGU E{(pg8::bf16_t*)(ws + WS_HB)};
        pg8::gemm_phase<epi::EpiGU, pg8::StaticOrder, true, true, true>(ring, g, S, E, X.tid);
    }
    xcd_barrier(xbar);
    }
    for (int rep = 0; rep < REP_P11; ++rep) {
    { LOADP();
        pg8::Gemm g{(const pg8::bf16_t*)(ws + WS_HB), (const pg8::bf16_t*)(ws + WS_WTD), 32 * CAP, 1024, 1024, 1024, 1024, 4, 16, (size_t)1024 * 1024 * 2, nullptr, 0, 0};
        pg8::StaticOrder S; S.init(32 * CAP, 1024, X.G, (int)blockIdx.x, EXP_WGM);
        epi::EpiDown E{(pg8::bf16_t*)(ws + WS_YE), (const float*)(ws + WS_GATE)};
        pg8::gemm_phase<epi::EpiDown, pg8::StaticOrder, true, true>(ring, g, S, E, X.tid);
    }
    xcd_barrier(xbar);
    }
#ifdef REP_SYNC
    for (int rs = 0; rs < REP_SYNC; ++rs) xcd_barrier(xbar);
#endif
    for (int rep = 0; rep < REP_P12; ++rep) {
    { LOADP(); (void)ws; phase12(P, X); }
        if (rep + 1 < REP_P12) xcd_barrier(xbar);
    }
}

extern "C" void kernel_launch(void* const* d_in, const int* in_sizes, int n_in, void* d_out, int out_size, void* d_ws, size_t ws_size, hipStream_t stream) {
    static int grid = 0;
    if (grid == 0) {
        if (n_in != 32 || in_sizes[0] != T * DM || out_size != T * DM || ws_size < WS_END) {
            fprintf(stderr, "kernel_launch: unexpected shapes: n_in %d in0 %d out %d ws %zu (need >= %zu)\n", n_in, n_in > 0 ? in_sizes[0] : -1, out_size, ws_size, (size_t)WS_END); grid = -1; return; }
        int dev = 0, cus = 0, per_cu = 0;
        hipGetDevice(&dev); hipDeviceGetAttribute(&cus, hipDeviceAttributeMultiprocessorCount, dev);
        if (hipFuncSetAttribute((const void*)fwd_megakernel, hipFuncAttributeMaxDynamicSharedMemorySize, LDS_BYTES) != hipSuccess) { fprintf(stderr, "kernel_launch: hipFuncSetAttribute failed\n"); grid = -1; return; }
        if (hipOccupancyMaxActiveBlocksPerMultiprocessor(&per_cu, (const void*)fwd_megakernel, NTHR, LDS_BYTES) != hipSuccess || per_cu < 1) { fprintf(stderr, "kernel_launch: occupancy query failed (%d)\n", per_cu); (void)hipGetLastError(); per_cu = 1; }
        grid = cus * 1;
        fprintf(stderr, "kernel_launch: cus %d per_cu %d grid %d ws %zu\n", cus, per_cu, grid, ws_size);
    }
    if (grid < 0) return;
    Params p{};
    const float** pf = (const float**)&p;
    p.x = (const float*)d_in[0]; p.c = (const float*)d_in[1]; p.positions = (const int*)d_in[2];
    p.w_ada = (const float*)d_in[3]; p.b_ada = (const float*)d_in[4]; p.w_in = (const float*)d_in[5]; p.q_norm_g = (const float*)d_in[6]; p.w_qb = (const float*)d_in[7];
    p.kv_norm_g = (const float*)d_in[8]; p.w_kvb = (const float*)d_in[9]; p.conv_w = (const float*)d_in[10]; p.conv_b = (const float*)d_in[11];
    p.filt_w1 = (const float*)d_in[12]; p.filt_b1 = (const float*)d_in[13]; p.filt_freq = (const float*)d_in[14]; p.filt_w2 = (const float*)d_in[15]; p.filt_b2 = (const float*)d_in[16];
    p.filt_w3 = (const float*)d_in[17]; p.filt_b3 = (const float*)d_in[18]; p.hyena_decay = (const float*)d_in[19]; p.hyena_bias = (const float*)d_in[20];
    p.attn_out_g = (const float*)d_in[21]; p.hyena_out_g = (const float*)d_in[22]; p.w_o = (const float*)d_in[23]; p.ln1_g = (const float*)d_in[24]; p.ln1_b = (const float*)d_in[25];
    p.w_router = (const float*)d_in[26]; p.w_gate = (const float*)d_in[27]; p.w_up = (const float*)d_in[28]; p.w_down = (const float*)d_in[29]; p.ln2_g = (const float*)d_in[30]; p.ln2_b = (const float*)d_in[31];
    p.out = (float*)d_out; p.ws = (unsigned char*)d_ws; (void)pf;
    void* args[] = {&p};
    hipError_t e = hipLaunchCooperativeKernel((const void*)fwd_megakernel, dim3(grid), dim3(NTHR), args, LDS_BYTES, stream);
    if (e != hipSuccess) fprintf(stderr, "kernel_launch: cooperative launch failed: %s (grid %d)\n", hipGetErrorString(e), grid);
}
```
